# Optimizing an MI355X kernel written in HIP

```python
import math
import jax, jax.numpy as jnp
from jax import lax
import numpy as np

D_MODEL = 2048
BATCH = 1
SEQ = 16384
DEPTH = 2

N_MIXERS = 2
N_CONV_LAYERS = (DEPTH + 1) // 2
N_ATTN_LAYERS = DEPTH // 2

CONV_WIDTH = 3

HEAD_DIM = 128
N_HEADS = D_MODEL // HEAD_DIM
Q_BLOCK = 128
FORGET_BIAS_INIT = 3.0
NEG_INF = -1e30

N_GROUPS = 4
EXPERTS_PER_GROUP = 8
N_EXPERTS = N_GROUPS * EXPERTS_PER_GROUP
TOP_K = 2
D_EXPERT = D_MODEL // 4
DISPATCH_BLOCK = 128

RMS_EPS = 1e-6

kernel_name = "hybrid_shortconv_fox_hmoe"


def rmsnorm(x, g):
    xf = x.astype(jnp.float32)
    y = xf * lax.rsqrt(jnp.mean(xf * xf, axis=-1, keepdims=True) + RMS_EPS)
    return (y * g.astype(jnp.float32)).astype(x.dtype)


def short_conv_mixer(h, w_in, conv_w, w_out):
    D = h.shape[-1]
    proj = jnp.einsum('bsd,de->bse', h, w_in)
    gate_out, gate_in, u = jnp.split(proj, 3, axis=-1)
    z = gate_in * u
    z = lax.conv_general_dilated(
        z, conv_w[:, None, :].astype(z.dtype), window_strides=(1,),
        padding=[(CONV_WIDTH - 1, 0)],
        dimension_numbers=('NWC', 'WIO', 'NWC'), feature_group_count=D)
    return jnp.einsum('bsd,de->bse', gate_out * z, w_out)


def forgetting_attention(h, w_in, b_f, w_out):
    B, S, D = h.shape
    proj = jnp.einsum('bsd,de->bse', h, w_in)
    q = proj[..., :D].reshape(B, S, N_HEADS, HEAD_DIM).transpose(0, 2, 1, 3)
    k = proj[..., D:2 * D].reshape(B, S, N_HEADS, HEAD_DIM).transpose(0, 2, 1, 3)
    v = proj[..., 2 * D:3 * D].reshape(B, S, N_HEADS, HEAD_DIM).transpose(0, 2, 1, 3)
    f_logit = proj[..., 3 * D:].astype(jnp.float32) + b_f.astype(jnp.float32)
    c = jnp.cumsum(jax.nn.log_sigmoid(f_logit), axis=1).transpose(0, 2, 1)

    n_qb = S // Q_BLOCK
    q_blocks = q.reshape(B, N_HEADS, n_qb, Q_BLOCK, HEAD_DIM).transpose(2, 0, 1, 3, 4)
    c_blocks = c.reshape(B, N_HEADS, n_qb, Q_BLOCK).transpose(2, 0, 1, 3)
    k_pos = jnp.arange(S)
    scale = 1.0 / math.sqrt(HEAD_DIM)

    def one_block(args):
        q_i, c_i, blk = args
        s = jnp.einsum('bhqd,bhkd->bhqk', q_i, k,
                       preferred_element_type=jnp.float32) * scale
        s = s + c_i[..., :, None] - c[:, :, None, :]
        q_pos = blk * Q_BLOCK + jnp.arange(Q_BLOCK)
        s = jnp.where(k_pos[None, :] <= q_pos[:, None], s, NEG_INF)
        p = jax.nn.softmax(s, axis=-1)
        return jnp.einsum('bhqk,bhkd->bhqd', p.astype(v.dtype), v)

    o = lax.map(one_block, (q_blocks, c_blocks, jnp.arange(n_qb)))
    o = o.transpose(1, 0, 3, 2, 4).reshape(B, S, D)
    return jnp.einsum('bsd,de->bse', o, w_out)


def hierarchical_moe(h, rg_w, rg_b, re_w, re_b, w_gate, w_up, w_down):
    B, S, D = h.shape
    N = B * S
    t = h.reshape(N, D)
    g_logits = jnp.einsum('nd,dg->ng', t, rg_w).astype(jnp.float32) + rg_b.astype(jnp.float32)
    g_prob = jax.nn.softmax(g_logits, axis=-1)
    _, g_sel = lax.top_k(g_logits, 1)
    p_g = jnp.take_along_axis(g_prob, g_sel, axis=1)
    e_logits = jnp.einsum('nd,gde->nge', t, re_w).astype(jnp.float32) + re_b.astype(jnp.float32)
    e_logits = jnp.take_along_axis(e_logits, g_sel[:, :, None], axis=1)[:, 0]
    top_v, top_i = lax.top_k(e_logits, TOP_K)
    gates = jax.nn.softmax(top_v, axis=-1) * p_g
    expert_idx = g_sel * EXPERTS_PER_GROUP + top_i

    A = N * TOP_K
    flat_e = expert_idx.reshape(A)
    flat_tok = jnp.repeat(jnp.arange(N), TOP_K)
    flat_w = gates.reshape(A)
    order = jnp.argsort(flat_e)
    sorted_e = flat_e[order]
    counts = jnp.bincount(flat_e, length=N_EXPERTS)
    starts = jnp.cumsum(counts) - counts
    padded = (counts + DISPATCH_BLOCK - 1) // DISPATCH_BLOCK * DISPATCH_BLOCK
    p_ends = jnp.cumsum(padded)
    p_starts = p_ends - padded
    dest = p_starts[sorted_e] + (jnp.arange(A) - starts[sorted_e])
    P = A + N_EXPERTS * DISPATCH_BLOCK
    n_blocks = P // DISPATCH_BLOCK
    slot_tok = jnp.full((P,), N, dtype=jnp.int32).at[dest].set(flat_tok[order].astype(jnp.int32))
    slot_w = jnp.zeros((P,), jnp.float32).at[dest].set(flat_w[order])
    block_e = jnp.minimum(
        jnp.searchsorted(p_ends, jnp.arange(n_blocks) * DISPATCH_BLOCK, side='right'),
        N_EXPERTS - 1)

    t_pad = jnp.concatenate([t, jnp.zeros((1, D), t.dtype)], axis=0)
    xs = t_pad[slot_tok].reshape(n_blocks, DISPATCH_BLOCK, D)

    def expert_block(args):
        xb, e = args
        hid = jax.nn.silu(xb @ w_gate[e]) * (xb @ w_up[e])
        return hid @ w_down[e]

    out = lax.map(expert_block, (xs, block_e)).reshape(P, D)
    y = jnp.zeros((N + 1, D), t.dtype).at[slot_tok].add(out * slot_w[:, None].astype(t.dtype))[:N]
    return y.reshape(B, S, D)


def setup_inputs(seed: int = 0) -> dict:
    key = jax.random.key(seed)
    ks = jax.random.split(key, 20)
    D = D_MODEL

    def nrm(k, shape, scale):
        return jax.random.normal(k, shape, jnp.float32) * scale

    return {
        "x": nrm(ks[0], (BATCH, SEQ, D), 1.0),
        "mix_norm": 1.0 + nrm(ks[1], (DEPTH, D), 0.02),
        "ffn_norm": 1.0 + nrm(ks[2], (DEPTH, D), 0.02),
        "final_norm": 1.0 + nrm(ks[3], (D,), 0.02),
        "conv_w_in": nrm(ks[4], (N_CONV_LAYERS, D, 3 * D), D ** -0.5),
        "conv_w": nrm(ks[5], (N_CONV_LAYERS, CONV_WIDTH, D), CONV_WIDTH ** -0.5),
        "conv_w_out": nrm(ks[6], (N_CONV_LAYERS, D, D), D ** -0.5),
        "attn_w_in": nrm(ks[7], (N_ATTN_LAYERS, D, 3 * D + N_HEADS), D ** -0.5),
        "attn_b_f": FORGET_BIAS_INIT + nrm(ks[8], (N_ATTN_LAYERS, N_HEADS), 1.0),
        "attn_w_out": nrm(ks[9], (N_ATTN_LAYERS, D, D), D ** -0.5),
        "router_group_w": nrm(ks[10], (DEPTH, D, N_GROUPS), D ** -0.5),
        "router_group_b": nrm(ks[11], (DEPTH, N_GROUPS), 0.01),
        "router_expert_w": nrm(ks[12], (DEPTH, N_GROUPS, D, EXPERTS_PER_GROUP), D ** -0.5),
        "router_expert_b": nrm(ks[13], (DEPTH, N_GROUPS, EXPERTS_PER_GROUP), 0.01),
        "w_gate": nrm(ks[14], (DEPTH, N_EXPERTS, D, D_EXPERT), D ** -0.5),
        "w_up": nrm(ks[15], (DEPTH, N_EXPERTS, D, D_EXPERT), D ** -0.5),
        "w_down": nrm(ks[16], (DEPTH, N_EXPERTS, D_EXPERT, D), D_EXPERT ** -0.5),
    }


def reference(x, mix_norm, ffn_norm, final_norm, conv_w_in, conv_w, conv_w_out,
              attn_w_in, attn_b_f, attn_w_out, router_group_w, router_group_b,
              router_expert_w, router_expert_b, w_gate, w_up, w_down):
    for i in range(DEPTH):
        j = i // N_MIXERS
        hn = rmsnorm(x, mix_norm[i])
        if i % N_MIXERS == 0:
            x = x + short_conv_mixer(hn, conv_w_in[j], conv_w[j], conv_w_out[j])
        else:
            x = x + forgetting_attention(hn, attn_w_in[j], attn_b_f[j], attn_w_out[j])
        hn = rmsnorm(x, ffn_norm[i])
        x = x + hierarchical_moe(hn, router_group_w[i], router_group_b[i],
                                 router_expert_w[i], router_expert_b[i],
                                 w_gate[i], w_up[i], w_down[i])
    return rmsnorm(x, final_norm)
```

```cpp
#include <hip/hip_runtime.h>
#include <cstdio>
#include <cstdint>

constexpr int SEQ = 16384, DM = 2048, NH = 16, HD = 128, NEXP = 32, NGRP = 4, EPG = 8, DEXP = 512;
constexpr float RMS_EPS = 1e-6f;
constexpr int CAP = SEQ;
constexpr int MAXT = 160;

namespace pg8 {
#define PG8_LAS __attribute__((address_space(3)))
typedef unsigned short bf16_t;
typedef short bf16x8 __attribute__((ext_vector_type(8)));
typedef float f32x4 __attribute__((ext_vector_type(4)));
typedef unsigned u32x4 __attribute__((ext_vector_type(4)));
constexpr int BM = 256, BK = 64, HALF = 128, HTB = HALF * BK * 2  , STAGE_BYTES = 8 * HTB, NXCD = 8, WGM = 8;

__host__ __device__ __forceinline__ int lds_byte(int r, int c) { const int st = (r >> 4) * 2 + (c >> 5), rr = r & 15, cc = c & 31, ob = rr * 64 + cc * 2; return st * 1024 + (ob ^ (((ob >> 9) & 1) << 5)); }
__host__ __device__ __forceinline__ void stage_rc(int b, int& R, int& C) { const int st = b / 1024, sb = b % 1024, swz = sb ^ (((sb >> 9) & 1) << 5); R = (st >> 1) * 16 + swz / 64; C = (st & 1) * 32 + (swz % 64) / 2; }
__host__ __device__ __forceinline__ int perm32(int rho) { const int n = rho >> 4, i = rho & 15; return 8 * (i >> 2) + 4 * n + (i & 3); }

struct Unit { int pm, pn; };
struct Gemm { const bf16_t* A; const bf16_t* Bt; int M, N, K; };

struct StaticOrder {
    int nM, nN, nwg, G, c;
    __host__ __device__ void init(int M, int N, int G_, int c_) { nM = M / BM; nN = N / BM; nwg = nM * nN; G = G_; c = c_; }
    __host__ __device__ bool next(int i, Unit& u) const {
        const long L = (long)i * G + c; if (L >= nwg) return false;
        int wgid = (int)L; { const int q = nwg / NXCD, r = nwg % NXCD, xcd = wgid % NXCD, off = wgid / NXCD; wgid = (xcd < r ? xcd * (q + 1) : r * (q + 1) + (xcd - r) * q) + off; }
        const int nig = WGM * nN, gid = wgid / nig, fm = gid * WGM, gsz = (nM - fm) < WGM ? (nM - fm) : WGM;
        u.pm = fm + ((wgid % nig) % gsz); u.pn = (wgid % nig) / gsz; return true;
    }
    __device__ __forceinline__ void a_ready(const Unit&) const {}
    __device__ __forceinline__ void done(const Unit&) const {}
};
__device__ __forceinline__ unsigned cvt_pk_bf16(float lo, float hi) { unsigned r; asm volatile("v_cvt_pk_bf16_f32 %0, %1, %2" : "=v"(r) : "v"(lo), "v"(hi)); return r; }
__device__ __forceinline__ u32x4 pack8(f32x4 v0, f32x4 v1) { u32x4 w; w.x = cvt_pk_bf16(v0[0], v0[1]); w.y = cvt_pk_bf16(v0[2], v0[3]); w.z = cvt_pk_bf16(v1[0], v1[1]); w.w = cvt_pk_bf16(v1[2], v1[3]); return w; }
__device__ __forceinline__ float silu_f(float g) { return g * __builtin_amdgcn_rcpf(1.0f + __builtin_amdgcn_exp2f(g * -1.4426950408889634f)); }

struct EpiConvIn {
    static constexpr bool PERM = true, AFTER_DRAIN = false;
    bf16_t* Z; bf16_t* GO;
    __device__ __forceinline__ void operator()(const f32x4 (&acc)[2][2][4][2], const Unit& u, int wr, int wc, int fr, int fq) const {
        const int row0 = u.pm * BM + wr * 64 + fr;
        if (u.pn < 16) {
            const int col0 = u.pn * 128 + wc * 32 + 8 * fq;
#pragma unroll
            for (int ai = 0; ai < 2; ++ai)
#pragma unroll
                for (int m = 0; m < 4; ++m) { bf16_t* rowp = Z + (size_t)(row0 + ai * HALF + m * 16) * 2048 + col0;
                    *(u32x4*)rowp = pack8(acc[ai][0][m][0] * acc[ai][1][m][0], acc[ai][0][m][1] * acc[ai][1][m][1]); }
        } else {
            const int col0 = (u.pn - 16) * 256 + wc * 32 + 8 * fq;
#pragma unroll
            for (int ai = 0; ai < 2; ++ai)
#pragma unroll
                for (int m = 0; m < 4; ++m) { bf16_t* rowp = GO + (size_t)(row0 + ai * HALF + m * 16) * 2048 + col0;
#pragma unroll
                    for (int bj = 0; bj < 2; ++bj) *(u32x4*)(rowp + bj * HALF) = pack8(acc[ai][bj][m][0], acc[ai][bj][m][1]); }
        }
    }
};
struct EpiResF32 {
    static constexpr bool PERM = false, AFTER_DRAIN = false;
    const float* R; float* C;
    __device__ __forceinline__ void operator()(const f32x4 (&acc)[2][2][4][2], const Unit& u, int wr, int wc, int fr, int fq) const {
        const int row0 = u.pm * BM + wr * 64 + fr, col0 = u.pn * BM + wc * 32 + 4 * fq;
#pragma unroll
        for (int ai = 0; ai < 2; ++ai)
#pragma unroll
            for (int m = 0; m < 4; ++m) { const size_t ro = (size_t)(row0 + ai * HALF + m * 16) * 2048 + col0;
#pragma unroll
                for (int bj = 0; bj < 2; ++bj)
#pragma unroll
                    for (int n = 0; n < 2; ++n) { const size_t o = ro + bj * HALF + n * 16; *(f32x4*)(C + o) = *(const f32x4*)(R + o) + acc[ai][bj][m][n]; } }
    }
};
struct EpiGateUp {
    static constexpr bool PERM = true, AFTER_DRAIN = false;
    bf16_t* H;
    __device__ __forceinline__ void operator()(const f32x4 (&acc)[2][2][4][2], const Unit& u, int wr, int wc, int fr, int fq) const {
        const int row0 = u.pm * BM + wr * 64 + fr, col0 = (u.pn & 3) * 128 + wc * 32 + 8 * fq;
#pragma unroll
        for (int ai = 0; ai < 2; ++ai)
#pragma unroll
            for (int m = 0; m < 4; ++m) { bf16_t* rowp = H + (size_t)(row0 + ai * HALF + m * 16) * 512 + col0;
                f32x4 v0, v1;
#pragma unroll
                for (int j = 0; j < 4; ++j) { v0[j] = silu_f(acc[ai][0][m][0][j]) * acc[ai][1][m][0][j]; v1[j] = silu_f(acc[ai][0][m][1][j]) * acc[ai][1][m][1][j]; }
                *(u32x4*)rowp = pack8(v0, v1); }
    }
};
struct EpiDown {
    static constexpr bool PERM = true, AFTER_DRAIN = false;
    bf16_t* O;
    __device__ __forceinline__ void operator()(const f32x4 (&acc)[2][2][4][2], const Unit& u, int wr, int wc, int fr, int fq) const {
        const int row0 = u.pm * BM + wr * 64 + fr, col0 = (u.pn & 7) * 256 + wc * 32 + 8 * fq;
#pragma unroll
        for (int ai = 0; ai < 2; ++ai)
#pragma unroll
            for (int m = 0; m < 4; ++m) { bf16_t* rowp = O + (size_t)(row0 + ai * HALF + m * 16) * 2048 + col0;
#pragma unroll
                for (int bj = 0; bj < 2; ++bj) *(u32x4*)(rowp + bj * HALF) = pack8(acc[ai][bj][m][0], acc[ai][bj][m][1]); }
    }
};
struct EpiQKV {
    static constexpr bool PERM = true, AFTER_DRAIN = false;
    bf16_t* Q; size_t tstride;
    __device__ __forceinline__ void operator()(const f32x4 (&acc)[2][2][4][2], const Unit& u, int wr, int wc, int fr, int fq) const {
        const int which = u.pn >> 3, hp = u.pn & 7; bf16_t* base = Q + (size_t)which * tstride;
        const int row0 = u.pm * BM + wr * 64 + fr, col0 = wc * 32 + 8 * fq;
#pragma unroll
        for (int bj = 0; bj < 2; ++bj) { bf16_t* hb = base + (size_t)(2 * hp + bj) * SEQ * 128 + col0;
#pragma unroll
            for (int ai = 0; ai < 2; ++ai)
#pragma unroll
                for (int m = 0; m < 4; ++m) *(u32x4*)(hb + (size_t)(row0 + ai * HALF + m * 16) * 128) = pack8(acc[ai][bj][m][0], acc[ai][bj][m][1]); }
    }
};
struct ExpertOrder {
    const PG8_LAS int* tile_e; int n_units, nN, G, c;
    __device__ __forceinline__ bool next(int i, Unit& u) const {
        const int L = i * G + c; if (L >= n_units) return false;
        const int t = L / nN, j = L - t * nN; u.pm = t; u.pn = tile_e[t] * nN + j; return true;
    }
    __device__ __forceinline__ void a_ready(const Unit&) const {}
    __device__ __forceinline__ void done(const Unit&) const {}
};

template <class Epi, class Sched, bool ALIGN_EPI = false, bool SP2 = false>
__device__ __forceinline__ void gemm_phase(PG8_LAS unsigned char* lds, const Gemm g, const Sched& S, const Epi& E) {
    const int tid = threadIdx.x, wid = __builtin_amdgcn_readfirstlane(tid >> 6), lane = tid & 63, wr = wid >> 2, wc = wid & 3, fr = lane & 15, fq = lane >> 4;
    const int K = g.K, nt = K / BK;
    unsigned voffA[2], voffB[2];
#pragma unroll
    for (int i = 0; i < 2; ++i) { int R, C; stage_rc(tid * 16 + i * 8192, R, C); const int Rb = Epi::PERM ? ((R & ~31) + perm32(R & 31)) : R;
        voffA[i] = (unsigned)(R * K + C) * 2u; voffB[i] = (unsigned)(Rb * K + C) * 2u; }
    const size_t kstep = (size_t)(BK * 2);
    const size_t hstep = (size_t)HALF * K * 2;
    const size_t tstep = 2 * hstep;
    const unsigned ldsw = (unsigned)wid * 1024u;
    const int aoff = lds_byte(wr * 64 + fr, fq * 8), boff = lds_byte(wc * 32 + fr, fq * 8);
#define PG8_SA(b, h) (((b) * 2 + (h)) * HTB)
#define PG8_SB(b, h) ((4 + (b) * 2 + (h)) * HTB)
#define PG8_STAGE(bufoff, gbase, voff) do { _Pragma("unroll") for (int _i = 0; _i < 2; ++_i) \
        __builtin_amdgcn_global_load_lds((const unsigned*)((const char*)(gbase) + (voff)[_i]), (PG8_LAS unsigned*)(lds + (bufoff) + ldsw + _i * 8192), 16, 0, 0); } while (0)
#define PG8_LDA(dst, b, h) do { _Pragma("unroll") for (int m = 0; m < 4; ++m) _Pragma("unroll") for (int k = 0; k < 2; ++k) dst[m][k] = *(const PG8_LAS bf16x8*)(lds + PG8_SA(b, h) + aoff + m * 2048 + k * 1024); } while (0)
#define PG8_LDB(dst, b, h) do { _Pragma("unroll") for (int n = 0; n < 2; ++n) _Pragma("unroll") for (int k = 0; k < 2; ++k) dst[n][k] = *(const PG8_LAS bf16x8*)(lds + PG8_SB(b, h) + boff + n * 2048 + k * 1024); } while (0)
#define PG8_MMA(ai, bj, At, Bt) do { __builtin_amdgcn_s_setprio(1); _Pragma("unroll") for (int m = 0; m < 4; ++m) _Pragma("unroll") for (int n = 0; n < 2; ++n) _Pragma("unroll") for (int k = 0; k < 2; ++k) \
        acc[ai][bj][m][n] = __builtin_amdgcn_mfma_f32_16x16x32_bf16(Bt[n][k], At[m][k], acc[ai][bj][m][n], 0, 0, 0); __builtin_amdgcn_s_setprio(0); } while (0)
#define PG8_WAIT_V(n) asm volatile("s_waitcnt vmcnt(" #n ")" ::: "memory")
#define PG8_WAIT_L(n) asm volatile("s_waitcnt lgkmcnt(" #n ")" ::: "memory")
#define PG8_BAR __builtin_amdgcn_s_barrier()
#define PG8_SCHED __builtin_amdgcn_sched_barrier(0)
    Unit cur, nxt; int ui = 0;
    if (!S.next(0, cur)) return;
    f32x4 acc[2][2][4][2];
#pragma unroll
    for (int a = 0; a < 2; ++a)
#pragma unroll
        for (int b = 0; b < 2; ++b)
#pragma unroll
            for (int m = 0; m < 4; ++m)
#pragma unroll
                for (int n = 0; n < 2; ++n) acc[a][b][m][n] = (f32x4){0.f, 0.f, 0.f, 0.f};
    bf16x8 At[4][2], B0[2][2], B1[2][2];
    const char* cA = (const char*)g.A + (size_t)cur.pm * tstep; const char* cB = (const char*)g.Bt + (size_t)cur.pn * tstep;
    S.a_ready(cur);
    if constexpr (SP2) {
        PG8_STAGE(PG8_SB(0, 0), cB, voffB); PG8_STAGE(PG8_SB(0, 1), cB + hstep, voffB); PG8_STAGE(PG8_SA(0, 0), cA, voffA); PG8_STAGE(PG8_SA(0, 1), cA + hstep, voffA);
        if (wr == 1) PG8_BAR;
        PG8_WAIT_V(2); PG8_BAR;
        PG8_STAGE(PG8_SB(1, 0), cB + kstep, voffB); PG8_STAGE(PG8_SA(1, 0), cA + kstep, voffA); PG8_STAGE(PG8_SB(1, 1), cB + hstep + kstep, voffB);
        PG8_WAIT_V(6); PG8_BAR;
    } else {
        PG8_STAGE(PG8_SB(0, 0), cB, voffB); PG8_STAGE(PG8_SA(0, 0), cA, voffA); PG8_STAGE(PG8_SB(0, 1), cB + hstep, voffB); PG8_STAGE(PG8_SA(0, 1), cA + hstep, voffA);
        if (wr == 1) PG8_BAR;
        PG8_WAIT_V(4); PG8_BAR;
        PG8_STAGE(PG8_SB(1, 0), cB + kstep, voffB); PG8_STAGE(PG8_SA(1, 0), cA + kstep, voffA); PG8_STAGE(PG8_SB(1, 1), cB + hstep + kstep, voffB);
        PG8_WAIT_V(6); PG8_BAR;
    }
    for (;;) {
        const bool has_next = S.next(ui + 1, nxt);
        const char* nA = has_next ? (const char*)g.A + (size_t)nxt.pm * tstep : cA; const char* nB = has_next ? (const char*)g.Bt + (size_t)nxt.pn * tstep : cB;
        for (int t = 0; t < nt; t += 2) {
            const bool last = (t == nt - 2);
            const char* a1 = cA + (size_t)(t + 1) * kstep;
            const char* a2 = last ? nA : cA + (size_t)(t + 2) * kstep; const char* b2 = last ? nB : cB + (size_t)(t + 2) * kstep;
            const char* a3 = a2 + kstep; const char* b3 = b2 + kstep;
            if (last && has_next) S.a_ready(nxt);
            if constexpr (SP2) {
            PG8_LDB(B0, 0, 0); PG8_LDB(B1, 0, 1); PG8_SCHED; PG8_LDA(At, 0, 0); PG8_STAGE(PG8_SA(1, 1), a1 + hstep, voffA);
            PG8_WAIT_V(8); PG8_WAIT_L(0); PG8_BAR; PG8_MMA(0, 0, At, B0); PG8_MMA(0, 1, At, B1); PG8_BAR; PG8_SCHED;
            PG8_LDA(At, 0, 1); PG8_STAGE(PG8_SB(0, 0), b2, voffB); PG8_STAGE(PG8_SB(0, 1), b2 + hstep, voffB); PG8_STAGE(PG8_SA(0, 0), a2, voffA);
            PG8_WAIT_V(8); PG8_WAIT_L(0); PG8_BAR; PG8_MMA(1, 0, At, B0); PG8_MMA(1, 1, At, B1); PG8_BAR; PG8_SCHED;
            PG8_LDB(B0, 1, 0); PG8_LDB(B1, 1, 1); PG8_SCHED; PG8_LDA(At, 1, 0); PG8_STAGE(PG8_SA(0, 1), a2 + hstep, voffA);
            PG8_WAIT_V(8); PG8_WAIT_L(0); PG8_BAR; PG8_MMA(0, 0, At, B0); PG8_MMA(0, 1, At, B1); PG8_BAR; PG8_SCHED;
            PG8_LDA(At, 1, 1); PG8_STAGE(PG8_SB(1, 0), b3, voffB); PG8_STAGE(PG8_SB(1, 1), b3 + hstep, voffB); PG8_STAGE(PG8_SA(1, 0), a3, voffA);
            PG8_WAIT_V(8); PG8_WAIT_L(0); PG8_BAR; PG8_MMA(1, 0, At, B0); PG8_MMA(1, 1, At, B1); PG8_BAR; PG8_SCHED;
            } else {
            PG8_LDB(B0, 0, 0); PG8_SCHED; PG8_LDA(At, 0, 0); PG8_STAGE(PG8_SA(1, 1), a1 + hstep, voffA);
            PG8_WAIT_L(8); PG8_BAR; PG8_WAIT_L(0); PG8_MMA(0, 0, At, B0); PG8_BAR; PG8_SCHED;
            PG8_LDB(B1, 0, 1); PG8_STAGE(PG8_SB(0, 0), b2, voffB);
            PG8_BAR; PG8_WAIT_L(0); PG8_MMA(0, 1, At, B1); PG8_BAR;
            PG8_LDA(At, 0, 1); PG8_STAGE(PG8_SA(0, 0), a2, voffA);
            PG8_BAR; PG8_WAIT_L(0); PG8_MMA(1, 0, At, B0); PG8_BAR; PG8_SCHED;
            PG8_STAGE(PG8_SB(0, 1), b2 + hstep, voffB);
            PG8_WAIT_V(6); PG8_BAR; PG8_MMA(1, 1, At, B1); PG8_BAR;
            PG8_LDB(B0, 1, 0); PG8_SCHED; PG8_LDA(At, 1, 0); PG8_STAGE(PG8_SA(0, 1), a2 + hstep, voffA);
            PG8_WAIT_L(8); PG8_BAR; PG8_WAIT_L(0); PG8_MMA(0, 0, At, B0); PG8_BAR; PG8_SCHED;
            PG8_LDB(B1, 1, 1); PG8_STAGE(PG8_SB(1, 0), b3, voffB);
            PG8_BAR; PG8_WAIT_L(0); PG8_MMA(0, 1, At, B1); PG8_BAR;
            PG8_LDA(At, 1, 1); PG8_STAGE(PG8_SA(1, 0), a3, voffA);
            PG8_BAR; PG8_WAIT_L(0); PG8_MMA(1, 0, At, B0); PG8_BAR; PG8_SCHED;
            PG8_STAGE(PG8_SB(1, 1), b3 + hstep, voffB);
            PG8_WAIT_V(6); PG8_BAR; PG8_MMA(1, 1, At, B1); PG8_BAR;
            }
        }
        if constexpr (ALIGN_EPI) { if (wr == 0) PG8_BAR; }
        if constexpr (!Epi::AFTER_DRAIN) { E(acc, cur, wr, wc, fr, fq); S.done(cur); }
        if (!has_next) break;
#pragma unroll
        for (int a = 0; a < 2; ++a)
#pragma unroll
            for (int b = 0; b < 2; ++b)
#pragma unroll
                for (int m = 0; m < 4; ++m)
#pragma unroll
                    for (int n = 0; n < 2; ++n) acc[a][b][m][n] = (f32x4){0.f, 0.f, 0.f, 0.f};
        cur = nxt; cA = nA; cB = nB; ++ui;
        if constexpr (ALIGN_EPI) { if (wr == 1) PG8_BAR; }
    }
    PG8_WAIT_V(0);
    if constexpr (!ALIGN_EPI) { if (wr == 0) PG8_BAR; }
    PG8_BAR;
    if constexpr (Epi::AFTER_DRAIN) { E.fused(acc, cur, wr, wc, fr, fq, lds, wid, lane); S.done(cur); }
#undef PG8_SA
#undef PG8_SB
#undef PG8_STAGE
#undef PG8_LDA
#undef PG8_LDB
#undef PG8_MMA
#undef PG8_WAIT_V
#undef PG8_WAIT_L
#undef PG8_BAR
#undef PG8_SCHED
}
}
namespace fox {
#define FOX_LAS __attribute__((address_space(3)))
typedef unsigned short bf16;
typedef short bf16x8 __attribute__((ext_vector_type(8)));
typedef short s16x4 __attribute__((ext_vector_type(4)));
typedef float f32x16 __attribute__((ext_vector_type(16)));
typedef float f32x4 __attribute__((ext_vector_type(4)));
typedef unsigned u32x4 __attribute__((ext_vector_type(4)));
constexpr int D = 128, OPITCH = 2048;
constexpr float SCALE = 0.08838834764831845f;
constexpr float THR = 8.f;
constexpr int NW = 8, QBLK = 32, KVBLK = 64, QB = NW * QBLK;
constexpr int SHM_V = KVBLK * D * 2, SHM_K = KVBLK * D * 2, SHM_X = KVBLK * 16 * 2;
constexpr int LDS_WS_OFF = 2 * SHM_V + 2 * SHM_K, LDS_X_OFF = LDS_WS_OFF + NW * 64 * 4, LDS_BYTES = LDS_X_OFF + 2 * SHM_X;

#define KSWZ(row, colB) ((row) * 256 + ((colB) ^ (((row) & 7) << 4)))
#define SBAR() __builtin_amdgcn_sched_barrier(0)
__device__ __forceinline__ int v_st(int k, int c) { const int kk = (k & ~0xC) | ((k & 4) << 1) | ((k & 8) >> 1); return ((kk >> 3) * 4 + (c >> 5)) * 512 + ((kk & 7) * 32 + (c & 31)) * 2; }
__device__ __forceinline__ int v_rd_base(int lane) { return ((lane & 3) << 3) | (((lane >> 2) & 3) << 6) | (((lane >> 4) & 1) << 5) | (((lane >> 5) & 1) << 8); }
constexpr int v_rd_off(int d0, int ks, int half) { return d0 * 512 + ks * 4096 + half * 2048; }
__device__ __forceinline__ int crow(int r, int hi) { return (r & 3) + 8 * (r >> 2) + 4 * hi; }
__device__ __forceinline__ unsigned cvtpk(float lo, float hi) { unsigned r; asm volatile("v_cvt_pk_bf16_f32 %0, %1, %2" : "=v"(r) : "v"(lo), "v"(hi)); return r; }
__device__ __forceinline__ bf16x8 load8(const bf16* p) { return *reinterpret_cast<const bf16x8*>(p); }
__device__ __forceinline__ void glds16(const void* gsrc, unsigned lds_dst) { unsigned keep;
    asm volatile("s_mov_b32 %0, m0\n\ts_mov_b32 m0, %2\n\ts_nop 0\n\tglobal_load_lds_dwordx4 %1, off\n\ts_mov_b32 m0, %0" : "=&s"(keep) : "v"(gsrc), "s"(lds_dst) : "memory"); }
__device__ __forceinline__ void mask_tile(f32x16& p0, f32x16& p1, int dq) {
    const float NEG = -__builtin_inff();
#pragma unroll
    for (int r = 0; r < 16; ++r) {
        const int c = (r & 3) + 8 * (r >> 2);
        if (dq - c < 0) p0[r] = NEG;
        if (dq - c - 32 < 0) p1[r] = NEG;
    }
}
__device__ __forceinline__ void partialSM(f32x16& p0, f32x16& p1, float& m_reg, float& mn, float& alpha) {
    float pmax = p0[0]; for (int r = 1; r < 16; ++r) pmax = fmaxf(pmax, p0[r]); for (int r = 0; r < 16; ++r) pmax = fmaxf(pmax, p1[r]);
    { auto rr = __builtin_amdgcn_permlane32_swap(__float_as_uint(pmax), __float_as_uint(pmax), false, false);
      pmax = fmaxf(__uint_as_float(rr[0]), __uint_as_float(rr[1])); }
    constexpr float C2 = 1.4426950408889634f * SCALE;
    if (__builtin_expect(__all((pmax - m_reg) * SCALE <= THR), 1)) { mn = m_reg; alpha = 1.f; }
    else { mn = fmaxf(m_reg, pmax); alpha = __builtin_amdgcn_exp2f((m_reg - mn) * C2); m_reg = mn; }
    const float mnL = -mn * C2;
    for (int r = 0; r < 16; ++r) p0[r] = fmaf(p0[r], C2, mnL); for (int r = 0; r < 16; ++r) p1[r] = fmaf(p1[r], C2, mnL);
    for (int r = 0; r < 16; ++r) p0[r] = __builtin_amdgcn_exp2f(p0[r]);
}
__device__ __forceinline__ void finishSM(f32x16& p0, f32x16& p1, float alpha, float& l_reg, bf16x8& pa0, bf16x8& pa1, bf16x8& pa2, bf16x8& pa3) {
    for (int r = 0; r < 16; ++r) p1[r] = __builtin_amdgcn_exp2f(p1[r]);
    float ps = 0; for (int r = 0; r < 16; ++r) ps += p0[r]; for (int r = 0; r < 16; ++r) ps += p1[r];
    { auto rr = __builtin_amdgcn_permlane32_swap(__float_as_uint(ps), __float_as_uint(ps), false, false);
      ps = __uint_as_float(rr[0]) + __uint_as_float(rr[1]); }
    l_reg = l_reg * alpha + ps;
#define PK4(P, B_, OUT) do { unsigned a0 = cvtpk(P[B_+0], P[B_+1]), a1 = cvtpk(P[B_+2], P[B_+3]);                          \
        unsigned b0 = cvtpk(P[B_+4], P[B_+5]), b1 = cvtpk(P[B_+6], P[B_+7]);                                             \
        auto r0 = __builtin_amdgcn_permlane32_swap(a0, b0, false, false); auto r1 = __builtin_amdgcn_permlane32_swap(a1, b1, false, false); \
        u32x4 w = {r0[0], r1[0], r0[1], r1[1]}; OUT = *reinterpret_cast<bf16x8*>(&w); } while (0)
    PK4(p0, 0, pa0); PK4(p0, 8, pa1); PK4(p1, 0, pa2); PK4(p1, 8, pa3);
#undef PK4
}
template <int KB>
__device__ __forceinline__ void qkt(f32x16& p0, f32x16& p1, const char* K_lds, const char* X_lds, int r32, int hi, const bf16x8* qr, bf16x8 qx) {
    p0 = f32x16{}; p1 = f32x16{};
    const char* kb[4];
#pragma unroll
    for (int dd = 0; dd < 4; ++dd) kb[dd] = K_lds + KB * SHM_K + KSWZ(r32, (dd * 16 + hi * 8) * 2);
#pragma unroll
    for (int d0 = 0; d0 < 8; ++d0) { const char* a = kb[d0 & 3] + (d0 >> 2) * 128;
        bf16x8 b0 = *reinterpret_cast<const bf16x8*>(a);
        bf16x8 b1 = *reinterpret_cast<const bf16x8*>(a + 32 * 256);
        p0 = __builtin_amdgcn_mfma_f32_32x32x16_bf16(b0, qr[d0], p0, 0, 0, 0);
        p1 = __builtin_amdgcn_mfma_f32_32x32x16_bf16(b1, qr[d0], p1, 0, 0, 0); }
    { const char* a = X_lds + KB * SHM_X + r32 * 32 + hi * 16;
        bf16x8 x0 = *reinterpret_cast<const bf16x8*>(a);
        bf16x8 x1 = *reinterpret_cast<const bf16x8*>(a + 32 * 32);
        p0 = __builtin_amdgcn_mfma_f32_32x32x16_bf16(x0, qx, p0, 0, 0, 0);
        p1 = __builtin_amdgcn_mfma_f32_32x32x16_bf16(x1, qx, p1, 0, 0, 0); }
}
template <int VB>
__device__ __forceinline__ void pv_tile(f32x16* o, int vb0, bf16x8 pa0, bf16x8 pa1, bf16x8 pa2, bf16x8 pa3) {
#define TRRD(dst, off) asm volatile("ds_read_b64_tr_b16 %0, %1 offset:%2" : "=&v"(dst) : "v"(vb0), "i"(off) : "memory")
#define PV_D0(d0) do { s16x4 l0, l1, l2, l3, h0, h1, h2, h3; constexpr int b_ = VB * SHM_V + v_rd_off(d0, 0, 0);     \
        TRRD(l0, b_); TRRD(h0, b_ + 2048); TRRD(l1, b_ + 4096); TRRD(h1, b_ + 6144); TRRD(l2, b_ + 8192); TRRD(h2, b_ + 10240); TRRD(l3, b_ + 12288); TRRD(h3, b_ + 14336); \
        asm volatile("s_waitcnt lgkmcnt(0)" ::: "memory"); SBAR();                                                        \
        o[d0] = __builtin_amdgcn_mfma_f32_32x32x16_bf16(pa0, (bf16x8){l0[0], l0[1], l0[2], l0[3], h0[0], h0[1], h0[2], h0[3]}, o[d0], 0, 0, 0);   \
        o[d0] = __builtin_amdgcn_mfma_f32_32x32x16_bf16(pa1, (bf16x8){l1[0], l1[1], l1[2], l1[3], h1[0], h1[1], h1[2], h1[3]}, o[d0], 0, 0, 0);   \
        o[d0] = __builtin_amdgcn_mfma_f32_32x32x16_bf16(pa2, (bf16x8){l2[0], l2[1], l2[2], l2[3], h2[0], h2[1], h2[2], h2[3]}, o[d0], 0, 0, 0);   \
        o[d0] = __builtin_amdgcn_mfma_f32_32x32x16_bf16(pa3, (bf16x8){l3[0], l3[1], l3[2], l3[3], h3[0], h3[1], h3[2], h3[3]}, o[d0], 0, 0, 0); } while (0)
    PV_D0(0); PV_D0(1); PV_D0(2); PV_D0(3);
#undef PV_D0
#undef TRRD
}
struct Bases { const bf16* Q; const bf16* K; const bf16* V; const bf16* KX; bf16* O; };
struct BlockRef { int h, qb, jlo; };
constexpr int SEQL = 16384;
#define REF_Q(B_, r) ((B_).Q + ((size_t)(r).h * SEQL + (size_t)(r).qb * QB) * D)
#define REF_K(B_, r) ((B_).K + (size_t)(r).h * SEQL * D)
#define REF_V(B_, r) ((B_).V + (size_t)(r).h * SEQL * D)
#define REF_X(B_, r) ((B_).KX + (size_t)(r).h * SEQL * 16)
#define REF_O(B_, r) ((B_).O + (size_t)(r).qb * QB * OPITCH + (r).h * D)
struct Seam { bf16x8 qr[8]; bf16x8 st_v0, st_v1, st_k0, st_k1; };
#define ROW(p, k0, rr) ((p) + (size_t)((k0) + (rr)) * D + sc)
#define VMW() asm volatile("s_waitcnt vmcnt(0)" ::: "memory")
#define VMWN(n) asm volatile("s_waitcnt vmcnt(%0)" :: "i"(n) : "memory")
#define SLOAD_H(Kp, Vp, k0) do { S.st_v0 = load8(ROW(Vp, k0, sr)); S.st_v1 = load8(ROW(Vp, k0, 32 + sr));              \
                         S.st_k0 = load8(ROW(Kp, k0, sr)); S.st_k1 = load8(ROW(Kp, k0, 32 + sr)); } while (0)
#define XDMA(Xp, k0, bf) do { if (wid < 2) glds16((Xp) + (size_t)(k0) * 16 + tid * 8, x_l32 + (bf) * SHM_X + wid * 1024); } while (0)
#define SWRITE_HK(bf) do { *(bf16x8*)(K_lds + (bf) * SHM_K + kws) = S.st_k0; *(bf16x8*)(K_lds + (bf) * SHM_K + kws + 32 * 256) = S.st_k1; } while (0)
#define SWRITE_HV(bf) do { *(bf16x8*)(V_lds + (bf) * SHM_V + vst0) = S.st_v0; *(bf16x8*)(V_lds + (bf) * SHM_V + vst1) = S.st_v1; } while (0)
#define SWRITE_H(bf) do { SWRITE_HV(bf); SWRITE_HK(bf); } while (0)
__device__ __forceinline__ void fox_prime(const Bases& BS, const BlockRef& cur, char* lds, unsigned lds32, Seam& S) {
    const int tid = threadIdx.x, wid = __builtin_amdgcn_readfirstlane(tid >> 6), lane = tid & 63, r32 = lane & 31, hi = lane >> 5;
    const int sr = tid >> 4, sc = (tid & 15) * 8, kws = KSWZ(sr, sc * 2); char* K_lds = lds + 2 * SHM_V; const unsigned x_l32 = lds32 + LDS_X_OFF;
    const int kb0 = cur.jlo * KVBLK;
    for (int d0 = 0; d0 < 8; ++d0) S.qr[d0] = load8(REF_Q(BS, cur) + (size_t)(wid * QBLK + r32) * D + d0 * 16 + hi * 8);
    SLOAD_H(REF_K(BS, cur), REF_V(BS, cur), kb0); XDMA(REF_X(BS, cur), kb0, 0); VMW(); SWRITE_HK(0);
    __syncthreads();
}
__device__ __forceinline__ void fox_block(const Bases& BS, const BlockRef& cur, const BlockRef& nxt, char* lds, unsigned lds32, Seam& S) {
    const int tid = threadIdx.x, wid = __builtin_amdgcn_readfirstlane(tid >> 6), lane = tid & 63, r32 = lane & 31, hi = lane >> 5;
    const int j_lo = cur.jlo;
    const int P0 = cur.qb * QB;
    const int j_hi = (P0 + QB - 1) / KVBLK + 1;
    const int NT = j_hi - j_lo;
    const int kbn = nxt.jlo * KVBLK;
    const int qlo = P0 + wid * QBLK, qm = qlo + r32 - 4 * hi;
    char* V_lds = lds; char* K_lds = lds + 2 * SHM_V; const char* X_lds = lds + LDS_X_OFF; const unsigned x_l32 = lds32 + LDS_X_OFF;
    float* ws = (float*)(lds + LDS_WS_OFF) + wid * 64; float* li_l = ws, * al_l = ws + 32;
    float m_reg = -1e30f, l_reg = 0; f32x16 o[4] = {};
    const int sr = tid >> 4, sc = (tid & 15) * 8, vst0 = v_st(sr, sc), vst1 = v_st(32 + sr, sc), kws = KSWZ(sr, sc * 2);
    const int vb0 = (int)lds32 + v_rd_base(lane);
    const bf16* Kh = REF_K(BS, cur); const bf16* Vh = REF_V(BS, cur); const bf16* Xh = REF_X(BS, cur);
    bf16x8 qx; { const short one = hi == 0 ? (short)0x3F80 : (short)0; qx = (bf16x8){one, one, one, 0, 0, 0, 0, 0}; }
#define RESC(a) do { if (__any((a) < 1.f)) { if (hi == 0) al_l[r32] = (a); asm volatile("s_waitcnt lgkmcnt(0)" ::: "memory");              \
                     for (int d_ = 0; d_ < 4; ++d_) for (int r = 0; r < 16; ++r) o[d_][r] *= al_l[crow(r, hi)]; } } while (0)
#define KBASE(t) ((j_lo + (t)) * KVBLK)
#define MASKT(P0_, P1_, t) do { const int kb_ = KBASE(t); if (kb_ + KVBLK - 1 > qlo) mask_tile(P0_, P1_, qm - kb_); } while (0)
    constexpr int NQL = 8;
#define SEAM_K0() do { VMWN(NQL); SWRITE_HK(0); SBAR(); } while (0)
    f32x16 pA0, pA1, pB0, pB1; float mnA, mnB, alA, alB; bf16x8 pa0, pa1, pa2, pa3;
    SWRITE_HV(0); SBAR();
    if (NT > 1) { SLOAD_H(Kh, Vh, KBASE(1)); XDMA(Xh, KBASE(1), 1); }
    SBAR(); qkt<0>(pA0, pA1, K_lds, X_lds, r32, hi, S.qr, qx);
    MASKT(pA0, pA1, 0); partialSM(pA0, pA1, m_reg, mnA, alA);
    if (NT > 1) { VMW(); SWRITE_H(1); }
    __syncthreads();
#define HALF_STEP(PX0, PX1, mnX, alX, PY0, PY1, alY, t, KB, VB, SB) do {                                                      \
        SBAR(); qkt<KB>(PX0, PX1, K_lds, X_lds, r32, hi, S.qr, qx);                                                           \
        finishSM(PY0, PY1, alY, l_reg, pa0, pa1, pa2, pa3); SBAR();                                                           \
        if ((t) + 1 < NT) { SLOAD_H(Kh, Vh, KBASE((t) + 1)); XDMA(Xh, KBASE((t) + 1), SB); SBAR(); }                          \
        pv_tile<VB>(o, vb0, pa0, pa1, pa2, pa3); MASKT(PX0, PX1, (t)); partialSM(PX0, PX1, m_reg, mnX, alX);                  \
        __syncthreads();                                                                                                      \
        if ((t) + 1 < NT) { VMW(); SWRITE_H(SB); }                                                                            \
        RESC(alX); __syncthreads(); } while (0)
    for (int t = 1; t + 1 < NT; t += 2) {
        HALF_STEP(pB0, pB1, mnB, alB, pA0, pA1, alA, t, 1, 0, 0);
        HALF_STEP(pA0, pA1, mnA, alA, pB0, pB1, alB, t + 1, 0, 1, 1);
    }
    const bool even = (NT & 1) == 0;
    if (even) { SBAR(); qkt<1>(pB0, pB1, K_lds, X_lds, r32, hi, S.qr, qx); SBAR(); }
    SLOAD_H(REF_K(BS, nxt), REF_V(BS, nxt), kbn); XDMA(REF_X(BS, nxt), kbn, 0); SBAR();
#pragma unroll
    for (int d0 = 0; d0 < 8; ++d0) S.qr[d0] = load8(REF_Q(BS, nxt) + (size_t)(wid * QBLK + r32) * D + d0 * 16 + hi * 8);
    SBAR();
    finishSM(pA0, pA1, alA, l_reg, pa0, pa1, pa2, pa3); SBAR();
    pv_tile<0>(o, vb0, pa0, pa1, pa2, pa3);
    if (even) { MASKT(pB0, pB1, NT - 1); partialSM(pB0, pB1, m_reg, mnB, alB); __syncthreads(); RESC(alB);
        finishSM(pB0, pB1, alB, l_reg, pa0, pa1, pa2, pa3); SBAR(); pv_tile<1>(o, vb0, pa0, pa1, pa2, pa3); }
    SBAR(); SEAM_K0();
    if (hi == 0) li_l[r32] = l_reg; asm volatile("s_waitcnt lgkmcnt(0)" ::: "memory");
    float rli[16];
#pragma unroll
    for (int r = 0; r < 16; ++r) rli[r] = __builtin_amdgcn_rcpf(li_l[crow(r, hi)]);
    bf16* Ow = REF_O(BS, cur) + (size_t)(wid * QBLK) * OPITCH;
#pragma unroll
    for (int r = 0; r < 16; ++r) { const int orow = crow(r, hi);
#pragma unroll
        for (int d0 = 0; d0 < 4; ++d0) { const float v = o[d0][r] * rli[r];
            const float vn = __shfl_xor(v, 1);
            if ((r32 & 1) == 0) *(unsigned*)(Ow + (size_t)orow * OPITCH + d0 * 32 + r32) = cvtpk(v, vn); } }
    __syncthreads();
#undef RESC
#undef KBASE
#undef MASKT
#undef SEAM_K0
#undef HALF_STEP
}
#undef REF_Q
#undef REF_K
#undef REF_V
#undef REF_X
#undef REF_O
#undef ROW
#undef VMW
#undef VMWN
#undef SLOAD_H
#undef XDMA
#undef SWRITE_HK
#undef SWRITE_HV
#undef SWRITE_H
#undef KSWZ
#undef SBAR
}

constexpr int NWAVES = 8;
#ifndef MK_N_LAUNCHES
#define MK_N_LAUNCHES 0
#endif
constexpr int N_PHASES = 17;

constexpr size_t MiB = 1u << 20;
constexpr size_t WS_CTL = 0, CTL_ZERO_BYTES = 64 * 1024;
constexpr size_t WS_TOKE = 1 * MiB, WS_TOKW0 = WS_TOKE + 65536, WS_TOKW1 = WS_TOKW0 + 65536, WS_TOKP0 = WS_TOKW1 + 65536, WS_TOKP1 = WS_TOKP0 + 65536;
constexpr size_t WS_SLOT = 2 * MiB;
constexpr size_t WS_LC = 4 * MiB;
constexpr size_t WS_CT = 5 * MiB;
constexpr size_t WS_WR = 5 * MiB + 512 * 1024;
constexpr size_t WS_WF = 6 * MiB;
constexpr size_t WS_KX = 8 * MiB;
constexpr size_t WS_WCIN = 16 * MiB, WS_WCOUT = 40 * MiB, WS_WAIN = 48 * MiB, WS_WAOUT = 72 * MiB;
constexpr size_t WS_WGU = 80 * MiB;
constexpr size_t WS_WD = 336 * MiB;
constexpr size_t WS_HN = 464 * MiB;
constexpr size_t WS_X = 528 * MiB;
constexpr size_t WS_STAGE = 656 * MiB;
constexpr size_t WS_Z = WS_STAGE, WS_GO = WS_STAGE + 64 * MiB;
constexpr size_t WS_XS = WS_STAGE, WS_H = WS_STAGE + 160 * MiB;
constexpr size_t WS_Q = WS_STAGE, WS_K = WS_STAGE + 64 * MiB, WS_V = WS_STAGE + 128 * MiB;
constexpr size_t WS_END = 856 * MiB;
constexpr int CW_CNT = 64;
constexpr int CW_BAR = 4096;
constexpr int RING_OFF = 0, RING_BYTES = 131072;
constexpr int TILE_OFF = RING_BYTES;
constexpr int TST_OFF = TILE_OFF + 1024;
constexpr int MISC_OFF = TST_OFF + 512;
constexpr int LDS_BYTES = 147456;
static_assert(MISC_OFF + 128 <= LDS_BYTES && fox::LDS_BYTES <= RING_BYTES, "LDS map");

#define GAS __attribute__((address_space(1)))
#define LAS __attribute__((address_space(3)))
typedef unsigned short bf16;
typedef unsigned v4u __attribute__((ext_vector_type(4)));
typedef unsigned v2u __attribute__((ext_vector_type(2)));
typedef float f32x4 __attribute__((ext_vector_type(4)));
typedef float f32x16 __attribute__((ext_vector_type(16)));
typedef short bf16x8 __attribute__((ext_vector_type(8)));
typedef GAS unsigned gu32;
#define RLX_AGENT __ATOMIC_RELAXED, __HIP_MEMORY_SCOPE_AGENT
#define LDS_WAIT() asm volatile("s_waitcnt lgkmcnt(0)" ::: "memory")
#define VM_WAIT() asm volatile("s_waitcnt vmcnt(0)" ::: "memory")
__device__ __forceinline__ unsigned f2bf(float f) { unsigned u = __builtin_bit_cast(unsigned, f); return (u + 0x7fffu + ((u >> 16) & 1u)) >> 16; }
__device__ __forceinline__ unsigned pk2(float lo, float hi) { return f2bf(lo) | (f2bf(hi) << 16); }
__device__ __forceinline__ float bf_lo(unsigned w) { return __builtin_bit_cast(float, w << 16); }
__device__ __forceinline__ float bf_hi(unsigned w) { return __builtin_bit_cast(float, w & 0xffff0000u); }
__device__ __forceinline__ float wave_sum(float v) {
#pragma unroll
    for (int o = 1; o < 64; o <<= 1) v += __shfl_xor(v, o);
    return v;
}

#define XB_TMO      128
#define XB_XCNT(j)  (256  + 64 * (j))
#define XB_XSUB(j)  (1280 + 64 * (j))
#define XB_XGEN(j)  (2304 + 64 * (j))
#define XB_TOP      3328
#define XB_TOPGEN   3392
#define XCD_BAR_WORDS 3456
#define XB_SPIN_CAP (1u << 18)

__device__ __forceinline__ unsigned xb_ld(unsigned* p)              { return __hip_atomic_load(p, __ATOMIC_RELAXED, __HIP_MEMORY_SCOPE_AGENT); }
__device__ __forceinline__ unsigned xb_add(unsigned* p, unsigned v) { return __hip_atomic_fetch_add(p, v, __ATOMIC_RELAXED, __HIP_MEMORY_SCOPE_AGENT); }
__device__ __forceinline__ unsigned xb_xcc_id() { return (unsigned)__builtin_amdgcn_s_getreg((3 << 11) | 20) & 0xFu; }
#define XB_SPIN(cond, bar) do { unsigned _sp = 0; while (cond) { __builtin_amdgcn_s_sleep(1); \
    if ((++_sp & 255u) == 0u) { if (xb_ld(&(bar)[XB_TMO])) break; if (_sp > XB_SPIN_CAP) { atomicAdd(&(bar)[XB_TMO], 1u); break; } } } } while (0)

struct XcdBarrier {
    unsigned* bar; unsigned x;
    volatile LAS unsigned* st;
};

__device__ __forceinline__ XcdBarrier xcd_barrier_post(unsigned* bar, volatile LAS unsigned* st) {
    XcdBarrier b; b.bar = bar; b.x = xb_xcc_id(); b.st = st;
    if (threadIdx.x == 0) (void)xb_add(&bar[XB_XCNT(b.x)], 1u);
    return b;
}
__device__ __forceinline__ void xcd_barrier_complete(unsigned* bar, unsigned x, unsigned& nloc, unsigned& nx) {
    const unsigned G = gridDim.x * gridDim.y * gridDim.z;
    unsigned sum, cnt, mine, sp = 0u;
    for (;;) {
        sum = 0u; cnt = 0u; mine = 0u;
#pragma unroll
        for (unsigned j = 0; j < 16; ++j) { const unsigned c = xb_ld(&bar[XB_XCNT(j)]); sum += c; cnt += (c > 0u) ? 1u : 0u; mine = (j == x) ? c : mine; }
        if (sum == G) break;
        __builtin_amdgcn_s_sleep(1);
        if ((++sp & 255u) == 0u) { if (xb_ld(&bar[XB_TMO])) break; if (sp > XB_SPIN_CAP) { atomicAdd(&bar[XB_TMO], 1u); break; } }
    }
    nloc = mine > 0u ? mine : 1u; nx = cnt > 0u ? cnt : 1u;
}

__device__ __forceinline__ void xcd_barrier(const XcdBarrier& b) {
    asm volatile("s_waitcnt vmcnt(0)" ::: "memory");
    __syncthreads();
    if (threadIdx.x == 0) {
        unsigned* bar = b.bar;
        __builtin_amdgcn_s_waitcnt(0);
        unsigned nloc = b.st[0], nx = b.st[1];
        if (nloc == 0u) { xcd_barrier_complete(bar, b.x, nloc, nx); b.st[0] = nloc; b.st[1] = nx; }
        const unsigned old = xb_add(&bar[XB_XSUB(b.x)], 1u);
        const unsigned gen = old / nloc;
        if (old + 1u == (gen + 1u) * nloc) {
            __builtin_amdgcn_fence(__ATOMIC_RELEASE, "agent");
            asm volatile("s_waitcnt vmcnt(0)" ::: "memory");
            const unsigned og = xb_add(&bar[XB_TOP], 1u);
            const unsigned tg = og / nx;
            if (og + 1u == (tg + 1u) * nx) xb_add(&bar[XB_TOPGEN], 1u);
            else XB_SPIN(xb_ld(&bar[XB_TOPGEN]) == tg, bar);
            __builtin_amdgcn_fence(__ATOMIC_ACQUIRE, "agent");
            xb_add(&bar[XB_XGEN(b.x)], 1u);
            asm volatile("s_waitcnt vmcnt(0)" ::: "memory");
        } else {
            XB_SPIN(xb_ld(&bar[XB_XGEN(b.x)]) == gen, bar);
            __builtin_amdgcn_fence(__ATOMIC_ACQUIRE, "agent");
            asm volatile("s_waitcnt vmcnt(0)" ::: "memory");
        }
    }
    __syncthreads();
}

struct Frame {
    LAS unsigned char* lds;
    volatile LAS unsigned* MISC;
    gu32* ctl;
    int tid, lane, wave;
    int vcu, G;
    const float *x, *mix_norm, *ffn_norm, *final_norm, *conv_w_in, *conv_w, *conv_w_out, *attn_w_in, *attn_b_f, *attn_w_out, *rg_w, *rg_b, *re_w, *re_b, *w_gate, *w_up, *w_down;
    float* out; unsigned char* ws;
};
#define WSP(T, off) ((T*)(F.ws + (off)))

struct TrItem { const float* src; bf16* dst; int ldw, ldd; };
__device__ __forceinline__ bool tr_decode(const Frame& F, int it, TrItem& d) {
    if (it < 6144) { const int kb = it / 192, nb = it % 192, n0 = nb * 32; d.src = F.conv_w_in + (size_t)(kb * 64) * 6144 + n0; d.ldw = 6144; d.ldd = 2048;
        int dr; if (n0 < 2048) dr = 4096 + n0; else if (n0 < 4096) { const int i = n0 - 2048; dr = 256 * (i >> 7) + (i & 127); } else { const int i = n0 - 4096; dr = 256 * (i >> 7) + 128 + (i & 127); }
        d.dst = WSP(bf16, WS_WCIN) + (size_t)dr * 2048 + kb * 64; return true; }
    it -= 6144;
    if (it < 2048) { const int kb = it / 64, nb = it % 64; d.src = F.conv_w_out + (size_t)(kb * 64) * 2048 + nb * 32; d.ldw = 2048; d.ldd = 2048; d.dst = WSP(bf16, WS_WCOUT) + (size_t)(nb * 32) * 2048 + kb * 64; return true; }
    it -= 2048;
    if (it < 6144) { const int kb = it / 192, nb = it % 192; d.src = F.attn_w_in + (size_t)(kb * 64) * 6160 + nb * 32; d.ldw = 6160; d.ldd = 2048; d.dst = WSP(bf16, WS_WAIN) + (size_t)(nb * 32) * 2048 + kb * 64; return true; }
    it -= 6144;
    if (it < 2048) { const int kb = it / 64, nb = it % 64; d.src = F.attn_w_out + (size_t)(kb * 64) * 2048 + nb * 32; d.ldw = 2048; d.ldd = 2048; d.dst = WSP(bf16, WS_WAOUT) + (size_t)(nb * 32) * 2048 + kb * 64; return true; }
    it -= 2048;
    if (it < 65536) { const int up = it >> 15, r = it & 32767, le = r >> 9, q = r & 511, kb = q >> 4, nb = q & 15, n0 = nb * 32;
        d.src = (up ? F.w_up : F.w_gate) + (size_t)le * 2048 * 512 + (size_t)(kb * 64) * 512 + n0; d.ldw = 512; d.ldd = 2048;
        const int dr = 256 * (n0 >> 7) + 128 * up + (n0 & 127);
        d.dst = WSP(bf16, WS_WGU) + ((size_t)le * 1024 + dr) * 2048 + kb * 64; return true; }
    it -= 65536;
    if (it < 32768) { const int le = it >> 9, q = it & 511, kb = q >> 6, nb = q & 63;
        d.src = F.w_down + (size_t)le * 512 * 2048 + (size_t)(kb * 64) * 2048 + nb * 32; d.ldw = 2048; d.ldd = 512;
        d.dst = WSP(bf16, WS_WD) + ((size_t)le * 2048 + nb * 32) * 512 + kb * 64; return true; }
    return false;
}
constexpr int TR_NITEMS = 6144 + 2048 + 6144 + 2048 + 65536 + 32768;
__device__ __forceinline__ void p0_prologue(Frame& F) {
    LAS float* scr = (LAS float*)(F.lds + RING_OFF + F.wave * 16384);
    const int gw = F.vcu * NWAVES + F.wave, NGW = F.G * NWAVES, lane = F.lane;
    float v[32]; TrItem cur, nx; int it = gw;
    bool have = tr_decode(F, it, cur);
    if (have) {
#pragma unroll
        for (int i = 0; i < 32; ++i) v[i] = cur.src[(size_t)(2 * i + (lane >> 5)) * cur.ldw + (lane & 31)];
    }
    while (have) {
#pragma unroll
        for (int i = 0; i < 32; ++i) scr[(2 * i + (lane >> 5)) * 33 + (lane & 31)] = v[i];
        it += NGW; const bool hn = tr_decode(F, it, nx);
        if (hn) {
#pragma unroll
            for (int i = 0; i < 32; ++i) v[i] = nx.src[(size_t)(2 * i + (lane >> 5)) * nx.ldw + (lane & 31)];
        }
        LDS_WAIT(); asm volatile("" ::: "memory");
        const int c = lane & 7;
#pragma unroll
        for (int j = 0; j < 4; ++j) { const int n = (lane >> 3) + 8 * j; const LAS float* s = scr + (8 * c) * 33 + n;
            v4u o; o.x = pk2(s[0 * 33], s[1 * 33]); o.y = pk2(s[2 * 33], s[3 * 33]); o.z = pk2(s[4 * 33], s[5 * 33]); o.w = pk2(s[6 * 33], s[7 * 33]);
            *(GAS v4u*)(cur.dst + (size_t)n * cur.ldd + 8 * c) = o; }
        LDS_WAIT(); asm volatile("" ::: "memory");
        cur = nx; have = hn;
    }
    const int gt = (F.vcu * NWAVES + F.wave) * 64 + lane, NGT = F.G * NWAVES * 64;
    for (int i = gt; i < 2 * 64 * 2048; i += NGT) { const int l = i >> 17, r = (i >> 11) & 63, k = i & 2047; float w = 0.f;
        if (r < 4) w = F.rg_w[((size_t)l * 2048 + k) * 4 + r];
        else if (r < 36) { const int g = (r - 4) >> 3, e = (r - 4) & 7; w = F.re_w[(((size_t)l * 4 + g) * 2048 + k) * 8 + e]; }
        WSP(bf16, WS_WR)[i] = (bf16)f2bf(w); }
    for (int i = gt; i < 32 * 2048; i += NGT) { const int r = i >> 11, k = i & 2047; const float w = r < 16 ? F.attn_w_in[(size_t)k * 6160 + 6144 + r] : 0.f; WSP(bf16, WS_WF)[i] = (bf16)f2bf(w); }
}

template <int NB>
__device__ __forceinline__ void small_gemm(const Frame& F, const bf16* hn_rows, const bf16* Wt, LAS float* lg) {
    constexpr int NC = NB * 32, NE = 64 * NC, PER = NE / 512;
    const int lane = F.lane, r32 = lane & 31, hi = lane >> 5, kw = F.wave * 256;
    f32x16 acc[2][NB];
#pragma unroll
    for (int a = 0; a < 2; ++a)
#pragma unroll
        for (int b = 0; b < NB; ++b) acc[a][b] = f32x16{};
    const bf16* ap = hn_rows + (size_t)r32 * 2048 + kw + hi * 8; const bf16* bp = Wt + (size_t)r32 * 2048 + kw + hi * 8;
#pragma unroll 4
    for (int ks = 0; ks < 16; ++ks) {
        const bf16x8 a0 = *(const bf16x8*)(ap + ks * 16), a1 = *(const bf16x8*)(ap + 32 * 2048 + ks * 16);
#pragma unroll
        for (int b = 0; b < NB; ++b) { const bf16x8 bv = *(const bf16x8*)(bp + (size_t)b * 32 * 2048 + ks * 16);
            acc[0][b] = __builtin_amdgcn_mfma_f32_32x32x16_bf16(a0, bv, acc[0][b], 0, 0, 0);
            acc[1][b] = __builtin_amdgcn_mfma_f32_32x32x16_bf16(a1, bv, acc[1][b], 0, 0, 0); }
    }
    LAS float* part = lg + F.wave * NE;
#pragma unroll
    for (int a = 0; a < 2; ++a)
#pragma unroll
        for (int b = 0; b < NB; ++b)
#pragma unroll
            for (int r = 0; r < 16; ++r) { const int row = a * 32 + (r & 3) + 8 * (r >> 2) + 4 * hi; part[row * NC + b * 32 + r32] = acc[a][b][r]; }
    LDS_WAIT(); __syncthreads();
    float s[PER];
#pragma unroll
    for (int q = 0; q < PER; ++q) { const int i = F.tid + 512 * q; float t = lg[i];
#pragma unroll
        for (int w = 1; w < 8; ++w) t += lg[w * NE + i];
        s[q] = t; }
    LDS_WAIT(); __syncthreads();
#pragma unroll
    for (int q = 0; q < PER; ++q) { const int i = F.tid + 512 * q; lg[(i / NC) * (NC + 1) + (i % NC)] = s[q]; }
    LDS_WAIT(); __syncthreads();
}
__device__ __forceinline__ int build_tiles(Frame& F, int layer) {
    LAS int* tile_e = (LAS int*)(F.lds + TILE_OFF); LAS int* tst = (LAS int*)(F.lds + TST_OFF);
    __syncthreads();
    if (F.tid < 64) {
        const int c = F.tid < 32 ? (int)__hip_atomic_load(F.ctl + CW_CNT + 32 * layer + F.tid, RLX_AGENT) : 0;
        const int nt = (c + 255) >> 8; int inc = nt;
#pragma unroll
        for (int o = 1; o < 32; o <<= 1) { const int t = __shfl_up(inc, o); if ((F.tid & 63) >= o) inc += t; }
        const int st = inc - nt;
        if (F.tid < 32) { tst[F.tid] = st; tst[32 + F.tid] = c; for (int t = 0; t < nt; ++t) tile_e[st + t] = F.tid; }
        if (F.tid == 31) tst[64] = inc;
    }
    __syncthreads();
    return tst[64];
}
template <int MODE>
__device__ __forceinline__ void row_phase(Frame& F, int layer) {
    const int lane = F.lane, wave = F.wave, tid = F.tid;
    const float* gain = MODE == 0 ? F.mix_norm : (MODE == 1 ? F.ffn_norm + layer * DM : (MODE == 2 ? F.mix_norm + DM : F.final_norm));
    f32x4 g[8];
#pragma unroll
    for (int j = 0; j < 4; ++j) { g[2 * j] = *(const f32x4*)(gain + 512 * j + 8 * lane); g[2 * j + 1] = *(const f32x4*)(gain + 512 * j + 8 * lane + 4); }
    LAS float* lg = (LAS float*)(F.lds + RING_OFF);
    LAS int* hist = (LAS int*)(F.lds + TILE_OFF);
    LAS int* tst = (LAS int*)(F.lds + TST_OFF);
    if (MODE >= 2) (void)build_tiles(F, MODE == 2 ? 0 : 1);
    const float* xin = MODE == 0 ? F.x : WSP(float, WS_X);
    bf16* HN = WSP(bf16, WS_HN);
    for (int chunk = F.vcu; chunk < SEQ / 64; chunk += F.G) {
        const int row0 = chunk * 64;
        if (MODE == 1) { if (tid < 64) hist[tid] = 0; }
        for (int i = 0; i < 8; ++i) {
            const int row = row0 + wave * 8 + i;
            const float* xr = xin + (size_t)row * DM + 8 * lane;
            f32x4 v[8];
#pragma unroll
            for (int j = 0; j < 4; ++j) { v[2 * j] = *(const f32x4*)(xr + 512 * j); v[2 * j + 1] = *(const f32x4*)(xr + 512 * j + 4); }
            if (MODE >= 2) {
                const unsigned ee = WSP(unsigned, WS_TOKE)[row]; const int e0 = ee & 255, e1 = (ee >> 8) & 255;
                const int r0 = tst[e0] * 256 + WSP(int, WS_TOKP0)[row], r1 = tst[e1] * 256 + WSP(int, WS_TOKP1)[row];
                const float w0 = WSP(float, WS_TOKW0)[row], w1 = WSP(float, WS_TOKW1)[row];
                const bf16* o0 = WSP(bf16, WS_XS) + (size_t)r0 * DM + 8 * lane; const bf16* o1 = WSP(bf16, WS_XS) + (size_t)r1 * DM + 8 * lane;
#pragma unroll
                for (int j = 0; j < 4; ++j) { const v4u a = *(const v4u*)(o0 + 512 * j), b = *(const v4u*)(o1 + 512 * j);
                    v[2 * j][0] += w0 * bf_lo(a.x) + w1 * bf_lo(b.x); v[2 * j][1] += w0 * bf_hi(a.x) + w1 * bf_hi(b.x);
                    v[2 * j][2] += w0 * bf_lo(a.y) + w1 * bf_lo(b.y); v[2 * j][3] += w0 * bf_hi(a.y) + w1 * bf_hi(b.y);
                    v[2 * j + 1][0] += w0 * bf_lo(a.z) + w1 * bf_lo(b.z); v[2 * j + 1][1] += w0 * bf_hi(a.z) + w1 * bf_hi(b.z);
                    v[2 * j + 1][2] += w0 * bf_lo(a.w) + w1 * bf_lo(b.w); v[2 * j + 1][3] += w0 * bf_hi(a.w) + w1 * bf_hi(b.w); }
            }
            float ss = 0.f;
#pragma unroll
            for (int j = 0; j < 8; ++j) ss += (v[j][0] * v[j][0] + v[j][1] * v[j][1]) + (v[j][2] * v[j][2] + v[j][3] * v[j][3]);
            const float rstd = 1.0f / sqrtf(wave_sum(ss) * (1.0f / DM) + RMS_EPS);
            if (MODE == 2) { float* xw = WSP(float, WS_X) + (size_t)row * DM + 8 * lane;
#pragma unroll
                for (int j = 0; j < 4; ++j) { *(f32x4*)(xw + 512 * j) = v[2 * j]; *(f32x4*)(xw + 512 * j + 4) = v[2 * j + 1]; } }
            if (MODE == 3) { float* ow = F.out + (size_t)row * DM + 8 * lane;
#pragma unroll
                for (int j = 0; j < 4; ++j) { *(f32x4*)(ow + 512 * j) = v[2 * j] * rstd * g[2 * j]; *(f32x4*)(ow + 512 * j + 4) = v[2 * j + 1] * rstd * g[2 * j + 1]; } }
            else { bf16* hw = HN + (size_t)row * DM + 8 * lane;
#pragma unroll
                for (int j = 0; j < 4; ++j) { const f32x4 a = v[2 * j] * rstd * g[2 * j], b = v[2 * j + 1] * rstd * g[2 * j + 1];
                    v4u o; o.x = pk2(a[0], a[1]); o.y = pk2(a[2], a[3]); o.z = pk2(b[0], b[1]); o.w = pk2(b[2], b[3]); *(v4u*)(hw + 512 * j) = o; } }
        }
        if (MODE == 1 || MODE == 2) {
            VM_WAIT(); __syncthreads();
            if (MODE == 1) small_gemm<2>(F, HN + (size_t)row0 * DM, WSP(bf16, WS_WR) + (size_t)layer * 64 * 2048, lg);
            else small_gemm<1>(F, HN + (size_t)row0 * DM, WSP(bf16, WS_WF), lg);
            if (MODE == 1) {
                int e0 = 0, e1 = 0, rk0 = 0, rk1 = 0; float w0 = 0.f, w1 = 0.f;
                if (tid < 64) {
                    const LAS float* l = lg + tid * 65; const float* gb = F.rg_b + layer * 4; const float* eb = F.re_b + layer * 32;
                    float gl[4]; for (int j = 0; j < 4; ++j) gl[j] = l[j] + gb[j];
                    int gs = 0; float gm = gl[0]; for (int j = 1; j < 4; ++j) if (gl[j] > gm) { gm = gl[j]; gs = j; }
                    float den = 0.f; for (int j = 0; j < 4; ++j) den += __expf(gl[j] - gm);
                    const float pg = 1.0f / den;
                    float el[8]; for (int j = 0; j < 8; ++j) el[j] = l[4 + gs * 8 + j] + eb[gs * 8 + j];
                    int i1 = 0; float v1 = el[0]; for (int j = 1; j < 8; ++j) if (el[j] > v1) { v1 = el[j]; i1 = j; }
                    int i2 = -1; float v2 = -3.0e38f; for (int j = 0; j < 8; ++j) if (j != i1 && el[j] > v2) { v2 = el[j]; i2 = j; }
                    const float s = 1.0f / (1.0f + __expf(v2 - v1));
                    w0 = pg * s; w1 = pg * (1.0f - s); e0 = gs * 8 + i1; e1 = gs * 8 + i2;
                    rk0 = __hip_atomic_fetch_add(hist + e0, 1, __ATOMIC_RELAXED, __HIP_MEMORY_SCOPE_WORKGROUP);
                    rk1 = __hip_atomic_fetch_add(hist + e1, 1, __ATOMIC_RELAXED, __HIP_MEMORY_SCOPE_WORKGROUP);
                    LDS_WAIT(); asm volatile("" ::: "memory");
                    if (tid < 32) { const int c = hist[tid]; hist[32 + tid] = c ? (int)__hip_atomic_fetch_add(F.ctl + CW_CNT + 32 * layer + tid, (unsigned)c, RLX_AGENT) : 0; }
                    LDS_WAIT(); asm volatile("" ::: "memory");
                    const int p0 = hist[32 + e0] + rk0, p1 = hist[32 + e1] + rk1, row = row0 + tid;
                    WSP(int, WS_SLOT)[e0 * CAP + p0] = row; WSP(int, WS_SLOT)[e1 * CAP + p1] = row;
                    WSP(unsigned, WS_TOKE)[row] = (unsigned)e0 | ((unsigned)e1 << 8);
                    WSP(int, WS_TOKP0)[row] = p0; WSP(int, WS_TOKP1)[row] = p1; WSP(float, WS_TOKW0)[row] = w0; WSP(float, WS_TOKW1)[row] = w1;
                }
            } else {
                if (tid < 16) {
                    const float bfh = F.attn_b_f[tid]; float run = 0.f; float* lc = WSP(float, WS_LC) + (size_t)row0 * 16 + tid;
                    for (int r = 0; r < 64; ++r) { const float xv = lg[r * 33 + tid] + bfh; const float ls = fminf(xv, 0.f) - log1pf(__expf(-fabsf(xv))); run += ls; lc[r * 16] = run; }
                    WSP(float, WS_CT)[chunk * 16 + tid] = run;
                }
            }
            __syncthreads();
        }
    }
}
__device__ __forceinline__ void c_finalize(Frame& F) {
    LAS float* part = (LAS float*)(F.lds + RING_OFF);
    const int tid = F.tid;
    for (int chunk = F.vcu; chunk < SEQ / 64; chunk += F.G) {
        __syncthreads();
        { const int h = tid & 15, p = tid >> 4; float s = 0.f; const float* ct = WSP(float, WS_CT);
            for (int c = p * 8; c < p * 8 + 8; ++c) if (c < chunk) s += ct[c * 16 + h];
            part[p * 16 + h] = s; }
        __syncthreads();
        if (tid < 16) { float s = 0.f; for (int p = 0; p < 32; ++p) s += part[p * 16 + tid]; part[512 + tid] = s; }
        __syncthreads();
        for (int i = tid; i < 64 * 16; i += 512) { const int r = i >> 4, h = i & 15, row = chunk * 64 + r;
            const float cv = WSP(float, WS_LC)[(size_t)row * 16 + h] + part[512 + h];
            const float c64 = -cv * 11.313708498984761f;
            const unsigned b1 = f2bf(c64); const float r1 = c64 - __builtin_bit_cast(float, b1 << 16);
            const unsigned b2 = f2bf(r1); const float r2 = r1 - __builtin_bit_cast(float, b2 << 16);
            const unsigned b3 = f2bf(r2);
            v4u* dst = (v4u*)(WSP(bf16, WS_KX) + ((size_t)h * SEQ + row) * 16);
            dst[0] = (v4u){b1 | (b2 << 16), b3, 0u, 0u}; dst[1] = (v4u){0u, 0u, 0u, 0u}; }
    }
    __syncthreads();
}
__device__ __forceinline__ void conv_phase(Frame& F) {
    const int tid = F.tid, c8 = (tid & 255) * 8, half = tid >> 8;
    float w[3][8];
#pragma unroll
    for (int k = 0; k < 3; ++k)
#pragma unroll
        for (int j = 0; j < 8; ++j) w[k][j] = F.conv_w[k * DM + c8 + j];
    const bf16* Z = WSP(bf16, WS_Z); const bf16* GO = WSP(bf16, WS_GO); bf16* A = WSP(bf16, WS_HN);
    for (int chunk = F.vcu; chunk < SEQ / 64; chunk += F.G) {
        const int t0 = chunk * 64 + half * 32;
        v4u zm2 = (v4u){0u, 0u, 0u, 0u}, zm1 = zm2;
        if (t0 >= 2) { zm2 = *(const v4u*)(Z + (size_t)(t0 - 2) * DM + c8); zm1 = *(const v4u*)(Z + (size_t)(t0 - 1) * DM + c8); }
#pragma unroll 4
        for (int t = t0; t < t0 + 32; ++t) {
            const v4u z0 = *(const v4u*)(Z + (size_t)t * DM + c8), go = *(const v4u*)(GO + (size_t)t * DM + c8);
            v4u o;
#define CV(q, j) (w[0][j] * (((j) & 1) ? bf_hi(zm2.q) : bf_lo(zm2.q)) + w[1][j] * (((j) & 1) ? bf_hi(zm1.q) : bf_lo(zm1.q)) + w[2][j] * (((j) & 1) ? bf_hi(z0.q) : bf_lo(z0.q)))
            o.x = pk2(bf_lo(go.x) * CV(x, 0), bf_hi(go.x) * CV(x, 1)); o.y = pk2(bf_lo(go.y) * CV(y, 2), bf_hi(go.y) * CV(y, 3));
            o.z = pk2(bf_lo(go.z) * CV(z, 4), bf_hi(go.z) * CV(z, 5)); o.w = pk2(bf_lo(go.w) * CV(w, 6), bf_hi(go.w) * CV(w, 7));
#undef CV
            *(v4u*)(A + (size_t)t * DM + c8) = o;
            zm2 = zm1; zm1 = z0;
        }
    }
}
__device__ __forceinline__ void gather_phase(Frame& F, int layer) {
    const int ntile = build_tiles(F, layer);
    const LAS int* tile_e = (const LAS int*)(F.lds + TILE_OFF); const LAS int* tst = (const LAS int*)(F.lds + TST_OFF);
    const int gw = F.vcu * NWAVES + F.wave, NGW = F.G * NWAVES, lane = F.lane;
    const bf16* HN = WSP(bf16, WS_HN); bf16* XS = WSP(bf16, WS_XS);
    for (int r = gw; r < ntile * 256; r += NGW) {
        const int t = r >> 8, e = tile_e[t], pos = r - tst[e] * 256;
        if (pos < tst[32 + e]) { const int tok = WSP(int, WS_SLOT)[e * CAP + pos];
            const v4u* s = (const v4u*)(HN + (size_t)tok * DM) + lane; v4u* d = (v4u*)(XS + (size_t)r * DM) + lane;
            const v4u a = s[0], b = s[64], c = s[128], dd = s[192]; d[0] = a; d[64] = b; d[128] = c; d[192] = dd; }
    }
}

#define IN(k) (lo <= (k) && (k) < hi)
#ifndef EN_MASK
#define EN_MASK 0xFFFF
#endif
#define EN(b) (((EN_MASK) >> (b)) & 1)
#define SEAM(k) do { if (MK_N_LAUNCHES == 1 && IN(k) && IN((k) + 1)) xcd_barrier(bar); } while (0)
template <int layer>
__device__ __forceinline__ void layer_phases(Frame& F, const XcdBarrier& bar, unsigned char* lds, const int lo, const int hi) {
    const unsigned lds32 = (unsigned)(size_t)F.lds;
        const int pb = 1 + 8 * layer;
        if (IN(pb + 0) && EN(1)) {
            if constexpr (layer == 0) {
                pg8::Gemm g{WSP(bf16, WS_HN), WSP(bf16, WS_WCIN), SEQ, 3 * DM, DM}; pg8::StaticOrder S; S.init(SEQ, 3 * DM, F.G, (int)blockIdx.x);
                pg8::EpiConvIn E{WSP(bf16, WS_Z), WSP(bf16, WS_GO)};
                pg8::gemm_phase<pg8::EpiConvIn, pg8::StaticOrder, true, true>(F.lds + RING_OFF, g, S, E);
            } else {
                c_finalize(F);
                pg8::Gemm g{WSP(bf16, WS_HN), WSP(bf16, WS_WAIN), SEQ, 3 * DM, DM}; pg8::StaticOrder S; S.init(SEQ, 3 * DM, F.G, (int)blockIdx.x);
                pg8::EpiQKV E{WSP(bf16, WS_Q), (size_t)(WS_K - WS_Q) / 2};
                pg8::gemm_phase<pg8::EpiQKV, pg8::StaticOrder, true, true>(F.lds + RING_OFF, g, S, E);
            }
        }
        SEAM(pb + 0);
        if (IN(pb + 1)) {
            if constexpr (layer == 0) { if (EN(2)) conv_phase(F); }
            else if (EN(3)) {
                const fox::Bases BS{WSP(fox::bf16, WS_Q), WSP(fox::bf16, WS_K), WSP(fox::bf16, WS_V), WSP(fox::bf16, WS_KX), WSP(fox::bf16, WS_HN)};
                const int total = NH * 32, stride = F.G;
                int L = blockIdx.x;
                if (L < total) {
#define FOX_REF(r, L_, pass_) do { (r).h = (L_) >> 5; (r).qb = (pass_) ? 63 - ((L_) & 31) : ((L_) & 31); (r).jlo = 0; } while (0)
                    fox::BlockRef cur, nxt; int pass = 0; FOX_REF(cur, L, 0);
                    fox::Seam S;
                    fox::fox_prime(BS, cur, (char*)lds + RING_OFF, lds32 + RING_OFF, S);
                    for (;;) {
                        const bool more_pass = pass == 0, more_item = L + stride < total, last = !more_pass && !more_item;
                        int passn = pass + 1, Ln = L;
                        if (!more_pass) { passn = 0; Ln = more_item ? L + stride : L; }
                        if (last) nxt = cur; else FOX_REF(nxt, Ln, passn);
                        fox::fox_block(BS, cur, nxt, (char*)lds + RING_OFF, lds32 + RING_OFF, S);
                        if (last) break;
                        cur = nxt; pass = passn; L = Ln;
                    }
#undef FOX_REF
                }
            }
        }
        SEAM(pb + 1);
        if (IN(pb + 2) && EN(4)) {
            pg8::Gemm g{WSP(bf16, WS_HN), layer == 0 ? WSP(bf16, WS_WCOUT) : WSP(bf16, WS_WAOUT), SEQ, DM, DM}; pg8::StaticOrder S; S.init(SEQ, DM, F.G, (int)blockIdx.x);
            pg8::EpiResF32 E{layer == 0 ? F.x : WSP(float, WS_X), WSP(float, WS_X)};
            pg8::gemm_phase<pg8::EpiResF32, pg8::StaticOrder, true, true>(F.lds + RING_OFF, g, S, E);
        }
        SEAM(pb + 2);
        if (IN(pb + 3) && EN(5)) row_phase<1>(F, layer);
        SEAM(pb + 3);
        if (IN(pb + 4) && EN(6)) gather_phase(F, layer);
        SEAM(pb + 4);
        if (IN(pb + 5) && EN(7)) {
            const int ntile = build_tiles(F, layer);
            pg8::Gemm g{WSP(bf16, WS_XS), WSP(bf16, WS_WGU) + (size_t)layer * 32 * 1024 * 2048, MAXT * 256, 32 * 1024, DM};
            pg8::ExpertOrder S{(const LAS int*)(F.lds + TILE_OFF), ntile * 4, 4, F.G, F.vcu};
            pg8::EpiGateUp E{WSP(bf16, WS_H)};
            pg8::gemm_phase<pg8::EpiGateUp, pg8::ExpertOrder, true, true>(F.lds + RING_OFF, g, S, E);
        }
        SEAM(pb + 5);
        if (IN(pb + 6) && EN(8)) {
            const int ntile = build_tiles(F, layer);
            pg8::Gemm g{WSP(bf16, WS_H), WSP(bf16, WS_WD) + (size_t)layer * 32 * 2048 * 512, MAXT * 256, 32 * 2048, DEXP};
            pg8::ExpertOrder S{(const LAS int*)(F.lds + TILE_OFF), ntile * 8, 8, F.G, F.vcu};
            pg8::EpiDown E{WSP(bf16, WS_XS)};
            pg8::gemm_phase<pg8::EpiDown, pg8::ExpertOrder, true, true>(F.lds + RING_OFF, g, S, E);
        }
        SEAM(pb + 6);
        if (IN(pb + 7) && EN(9)) { if (layer == 0) row_phase<2>(F, 0); else row_phase<3>(F, 1); }
        if (layer == 0) SEAM(pb + 7);
}

struct Args { const float* in[17]; float* out; unsigned char* ws; int ph_lo, ph_hi; };
__global__ void __launch_bounds__(NWAVES * 64, 2) trunk_fwd(Args args) {
    extern __shared__ __attribute__((aligned(16))) unsigned char lds[];
    Frame F;
    F.lds = (LAS unsigned char*)lds;
    F.MISC = (volatile LAS unsigned*)(F.lds + MISC_OFF);
    F.tid = threadIdx.x; F.lane = F.tid & 63; F.wave = __builtin_amdgcn_readfirstlane(F.tid >> 6);
    F.G = gridDim.x; { const int bx = blockIdx.x; F.vcu = (F.G % 8 == 0) ? (bx % 8) * (F.G / 8) + bx / 8 : bx; }
    F.ws = args.ws; F.out = args.out; F.ctl = (gu32*)(args.ws + WS_CTL);
    F.x = args.in[0]; F.mix_norm = args.in[1]; F.ffn_norm = args.in[2]; F.final_norm = args.in[3]; F.conv_w_in = args.in[4]; F.conv_w = args.in[5]; F.conv_w_out = args.in[6];
    F.attn_w_in = args.in[7]; F.attn_b_f = args.in[8]; F.attn_w_out = args.in[9]; F.rg_w = args.in[10]; F.rg_b = args.in[11]; F.re_w = args.in[12]; F.re_b = args.in[13];
    F.w_gate = args.in[14]; F.w_up = args.in[15]; F.w_down = args.in[16];
    if (F.tid < 32) F.MISC[F.tid] = 0u;
    __syncthreads();
    XcdBarrier bar; bar.bar = (unsigned*)(F.ctl + CW_BAR); bar.x = 0; bar.st = nullptr;
    if (MK_N_LAUNCHES == 1) bar = xcd_barrier_post((unsigned*)(F.ctl + CW_BAR), F.MISC + 8);
    const int lo = args.ph_lo, hi = args.ph_hi;

    if (IN(0) && EN(0)) { p0_prologue(F); row_phase<0>(F, 0); }
    SEAM(0);
    layer_phases<0>(F, bar, lds, lo, hi);
    layer_phases<1>(F, bar, lds, lo, hi);
}
#undef IN
#undef SEAM

extern "C" void kernel_launch(void* const* d_in, const int* in_sizes, int n_in, void* d_out, int out_size, void* d_ws, size_t ws_size, hipStream_t stream) {
    static int grid = 0;
    if (grid == 0) {
        if (n_in != 17 || in_sizes[0] != SEQ * DM || out_size != SEQ * DM || ws_size < WS_END) { fprintf(stderr, "kernel_launch: unexpected shapes (n_in %d, in0 %d, out %d, ws %zu < %zu); nothing launched\n", n_in, n_in > 0 ? in_sizes[0] : -1, out_size, ws_size, (size_t)WS_END); grid = -1; return; }
        int dev = 0, cus = 0, per_cu = 0;
        if (hipGetDevice(&dev) != hipSuccess || hipDeviceGetAttribute(&cus, hipDeviceAttributeMultiprocessorCount, dev) != hipSuccess) { fprintf(stderr, "kernel_launch: device query failed\n"); grid = -1; return; }
        if (hipFuncSetAttribute((const void*)trunk_fwd, hipFuncAttributeMaxDynamicSharedMemorySize, LDS_BYTES) != hipSuccess) { fprintf(stderr, "kernel_launch: hipFuncSetAttribute failed\n"); grid = -1; return; }
        if (hipOccupancyMaxActiveBlocksPerMultiprocessor(&per_cu, (const void*)trunk_fwd, NWAVES * 64, LDS_BYTES) != hipSuccess || per_cu < 1) { fprintf(stderr, "kernel_launch: occupancy query reports %d workgroups per CU\n", per_cu); (void)hipGetLastError(); grid = -1; return; }
        grid = cus;
    }
    if (grid < 0) return;
    if (hipMemsetAsync((char*)d_ws + WS_CTL, 0, CTL_ZERO_BYTES, stream) != hipSuccess) { fprintf(stderr, "kernel_launch: hipMemsetAsync failed\n"); return; }
    Args a{};
    for (int i = 0; i < 17; ++i) a.in[i] = (const float*)d_in[i];
    a.out = (float*)d_out; a.ws = (unsigned char*)d_ws;
#if MK_N_LAUNCHES == 1
    a.ph_lo = 0; a.ph_hi = N_PHASES;
    hipLaunchKernelGGL(trunk_fwd, dim3(grid), dim3(NWAVES * 64), LDS_BYTES, stream, a);
#else
    for (int p = 0; p < N_PHASES; ++p) { a.ph_lo = p; a.ph_hi = p + 1; hipLaunchKernelGGL(trunk_fwd, dim3(grid), dim3(NWAVES * 64), LDS_BYTES, stream, a); }
#endif
    const hipError_t le = hipPeekAtLastError();
    if (le != hipSuccess) fprintf(stderr, "kernel_launch: launch failed: %s\n", hipGetErrorName(le));
}
```

```cpp
#include <hip/hip_runtime.h>
#include <cstdio>
#include <cstdint>

constexpr int SEQ = 16384, DM = 2048, NH = 16, HD = 128, NEXP = 32, NGRP = 4, EPG = 8, DEXP = 512;
constexpr float RMS_EPS = 1e-6f;
constexpr int CAP = SEQ;
constexpr int MAXT = 160;

namespace pg8 {
#define PG8_LAS __attribute__((address_space(3)))
typedef unsigned short bf16_t;
typedef short bf16x8 __attribute__((ext_vector_type(8)));
typedef float f32x4 __attribute__((ext_vector_type(4)));
typedef unsigned u32x4 __attribute__((ext_vector_type(4)));
constexpr int BM = 256, BK = 64, HALF = 128, HTB = HALF * BK * 2  , STAGE_BYTES = 8 * HTB, NXCD = 8, WGM = 8;

__host__ __device__ __forceinline__ int lds_byte(int r, int c) { const int st = (r >> 4) * 2 + (c >> 5), rr = r & 15, cc = c & 31, ob = rr * 64 + cc * 2; return st * 1024 + (ob ^ (((ob >> 9) & 1) << 5)); }
__host__ __device__ __forceinline__ void stage_rc(int b, int& R, int& C) { const int st = b / 1024, sb = b % 1024, swz = sb ^ (((sb >> 9) & 1) << 5); R = (st >> 1) * 16 + swz / 64; C = (st & 1) * 32 + (swz % 64) / 2; }
__host__ __device__ __forceinline__ int perm32(int rho) { const int n = rho >> 4, i = rho & 15; return 8 * (i >> 2) + 4 * n + (i & 3); }

struct Unit { int pm, pn; };
struct Gemm { const bf16_t* A; const bf16_t* Bt; int M, N, K; };

struct StaticOrder {
    int nM, nN, nwg, G, c;
    __host__ __device__ void init(int M, int N, int G_, int c_) { nM = M / BM; nN = N / BM; nwg = nM * nN; G = G_; c = c_; }
    __host__ __device__ bool next(int i, Unit& u) const {
        const long L = (long)i * G + c; if (L >= nwg) return false;
        int wgid = (int)L; { const int q = nwg / NXCD, r = nwg % NXCD, xcd = wgid % NXCD, off = wgid / NXCD; wgid = (xcd < r ? xcd * (q + 1) : r * (q + 1) + (xcd - r) * q) + off; }
        const int nig = WGM * nN, gid = wgid / nig, fm = gid * WGM, gsz = (nM - fm) < WGM ? (nM - fm) : WGM;
        u.pm = fm + ((wgid % nig) % gsz); u.pn = (wgid % nig) / gsz; return true;
    }
    __device__ __forceinline__ void a_ready(const Unit&) const {}
    __device__ __forceinline__ void done(const Unit&) const {}
};
__device__ __forceinline__ unsigned cvt_pk_bf16(float lo, float hi) { unsigned r; asm volatile("v_cvt_pk_bf16_f32 %0, %1, %2" : "=v"(r) : "v"(lo), "v"(hi)); return r; }
__device__ __forceinline__ u32x4 pack8(f32x4 v0, f32x4 v1) { u32x4 w; w.x = cvt_pk_bf16(v0[0], v0[1]); w.y = cvt_pk_bf16(v0[2], v0[3]); w.z = cvt_pk_bf16(v1[0], v1[1]); w.w = cvt_pk_bf16(v1[2], v1[3]); return w; }
__device__ __forceinline__ float silu_f(float g) { return g * __builtin_amdgcn_rcpf(1.0f + __builtin_amdgcn_exp2f(g * -1.4426950408889634f)); }

struct EpiConvIn {
    static constexpr bool PERM = true, AFTER_DRAIN = false;
    bf16_t* Z; bf16_t* GO;
    __device__ __forceinline__ void operator()(const f32x4 (&acc)[2][2][4][2], const Unit& u, int wr, int wc, int fr, int fq) const {
        const int row0 = u.pm * BM + wr * 64 + fr;
        if (u.pn < 16) {
            const int col0 = u.pn * 128 + wc * 32 + 8 * fq;
#pragma unroll
            for (int ai = 0; ai < 2; ++ai)
#pragma unroll
                for (int m = 0; m < 4; ++m) { bf16_t* rowp = Z + (size_t)(row0 + ai * HALF + m * 16) * 2048 + col0;
                    *(u32x4*)rowp = pack8(acc[ai][0][m][0] * acc[ai][1][m][0], acc[ai][0][m][1] * acc[ai][1][m][1]); }
        } else {
            const int col0 = (u.pn - 16) * 256 + wc * 32 + 8 * fq;
#pragma unroll
            for (int ai = 0; ai < 2; ++ai)
#pragma unroll
                for (int m = 0; m < 4; ++m) { bf16_t* rowp = GO + (size_t)(row0 + ai * HALF + m * 16) * 2048 + col0;
#pragma unroll
                    for (int bj = 0; bj < 2; ++bj) *(u32x4*)(rowp + bj * HALF) = pack8(acc[ai][bj][m][0], acc[ai][bj][m][1]); }
        }
    }
};
struct EpiResF32 {
    static constexpr bool PERM = false, AFTER_DRAIN = false;
    const float* R; float* C;
    __device__ __forceinline__ void operator()(const f32x4 (&acc)[2][2][4][2], const Unit& u, int wr, int wc, int fr, int fq) const {
        const int row0 = u.pm * BM + wr * 64 + fr, col0 = u.pn * BM + wc * 32 + 4 * fq;
#pragma unroll
        for (int ai = 0; ai < 2; ++ai)
#pragma unroll
            for (int m = 0; m < 4; ++m) { const size_t ro = (size_t)(row0 + ai * HALF + m * 16) * 2048 + col0;
#pragma unroll
                for (int bj = 0; bj < 2; ++bj)
#pragma unroll
                    for (int n = 0; n < 2; ++n) { const size_t o = ro + bj * HALF + n * 16; *(f32x4*)(C + o) = *(const f32x4*)(R + o) + acc[ai][bj][m][n]; } }
    }
};
struct EpiGateUp {
    static constexpr bool PERM = true, AFTER_DRAIN = false;
    bf16_t* H;
    __device__ __forceinline__ void operator()(const f32x4 (&acc)[2][2][4][2], const Unit& u, int wr, int wc, int fr, int fq) const {
        const int row0 = u.pm * BM + wr * 64 + fr, col0 = (u.pn & 3) * 128 + wc * 32 + 8 * fq;
#pragma unroll
        for (int ai = 0; ai < 2; ++ai)
#pragma unroll
            for (int m = 0; m < 4; ++m) { bf16_t* rowp = H + (size_t)(row0 + ai * HALF + m * 16) * 512 + col0;
                f32x4 v0, v1;
#pragma unroll
                for (int j = 0; j < 4; ++j) { v0[j] = silu_f(acc[ai][0][m][0][j]) * acc[ai][1][m][0][j]; v1[j] = silu_f(acc[ai][0][m][1][j]) * acc[ai][1][m][1][j]; }
                *(u32x4*)rowp = pack8(v0, v1); }
    }
};
struct EpiDown {
    static constexpr bool PERM = true, AFTER_DRAIN = false;
    bf16_t* O;
    __device__ __forceinline__ void operator()(const f32x4 (&acc)[2][2][4][2], const Unit& u, int wr, int wc, int fr, int fq) const {
        const int row0 = u.pm * BM + wr * 64 + fr, col0 = (u.pn & 7) * 256 + wc * 32 + 8 * fq;
#pragma unroll
        for (int ai = 0; ai < 2; ++ai)
#pragma unroll
            for (int m = 0; m < 4; ++m) { bf16_t* rowp = O + (size_t)(row0 + ai * HALF + m * 16) * 2048 + col0;
#pragma unroll
                for (int bj = 0; bj < 2; ++bj) *(u32x4*)(rowp + bj * HALF) = pack8(acc[ai][bj][m][0], acc[ai][bj][m][1]); }
    }
};
struct EpiQKV {
    static constexpr bool PERM = true, AFTER_DRAIN = false;
    bf16_t* Q; size_t tstride;
    __device__ __forceinline__ void operator()(const f32x4 (&acc)[2][2][4][2], const Unit& u, int wr, int wc, int fr, int fq) const {
        const int which = u.pn >> 3, hp = u.pn & 7; bf16_t* base = Q + (size_t)which * tstride;
        const int row0 = u.pm * BM + wr * 64 + fr, col0 = wc * 32 + 8 * fq;
#pragma unroll
        for (int bj = 0; bj < 2; ++bj) { bf16_t* hb = base + (size_t)(2 * hp + bj) * SEQ * 128 + col0;
#pragma unroll
            for (int ai = 0; ai < 2; ++ai)
#pragma unroll
                for (int m = 0; m < 4; ++m) *(u32x4*)(hb + (size_t)(row0 + ai * HALF + m * 16) * 128) = pack8(acc[ai][bj][m][0], acc[ai][bj][m][1]); }
    }
};
struct ExpertOrder {
    const PG8_LAS int* tile_e; int n_units, nN, G, c;
    __device__ __forceinline__ bool next(int i, Unit& u) const {
        const int L = i * G + c; if (L >= n_units) return false;
        const int t = L / nN, j = L - t * nN; u.pm = t; u.pn = tile_e[t] * nN + j; return true;
    }
    __device__ __forceinline__ void a_ready(const Unit&) const {}
    __device__ __forceinline__ void done(const Unit&) const {}
};

template <class Epi, class Sched, bool ALIGN_EPI = false, bool SP2 = false>
__device__ __forceinline__ void gemm_phase(PG8_LAS unsigned char* lds, const Gemm g, const Sched& S, const Epi& E) {
    const int tid = threadIdx.x, wid = __builtin_amdgcn_readfirstlane(tid >> 6), lane = tid & 63, wr = wid >> 2, wc = wid & 3, fr = lane & 15, fq = lane >> 4;
    const int K = g.K, nt = K / BK;
    unsigned voffA[2], voffB[2];
#pragma unroll
    for (int i = 0; i < 2; ++i) { int R, C; stage_rc(tid * 16 + i * 8192, R, C); const int Rb = Epi::PERM ? ((R & ~31) + perm32(R & 31)) : R;
        voffA[i] = (unsigned)(R * K + C) * 2u; voffB[i] = (unsigned)(Rb * K + C) * 2u; }
    const size_t kstep = (size_t)(BK * 2);
    const size_t hstep = (size_t)HALF * K * 2;
    const size_t tstep = 2 * hstep;
    const unsigned ldsw = (unsigned)wid * 1024u;
    const int aoff = lds_byte(wr * 64 + fr, fq * 8), boff = lds_byte(wc * 32 + fr, fq * 8);
#define PG8_SA(b, h) (((b) * 2 + (h)) * HTB)
#define PG8_SB(b, h) ((4 + (b) * 2 + (h)) * HTB)
#define PG8_STAGE(bufoff, gbase, voff) do { _Pragma("unroll") for (int _i = 0; _i < 2; ++_i) \
        __builtin_amdgcn_global_load_lds((const unsigned*)((const char*)(gbase) + (voff)[_i]), (PG8_LAS unsigned*)(lds + (bufoff) + ldsw + _i * 8192), 16, 0, 0); } while (0)
#define PG8_LDA(dst, b, h) do { _Pragma("unroll") for (int m = 0; m < 4; ++m) _Pragma("unroll") for (int k = 0; k < 2; ++k) dst[m][k] = *(const PG8_LAS bf16x8*)(lds + PG8_SA(b, h) + aoff + m * 2048 + k * 1024); } while (0)
#define PG8_LDB(dst, b, h) do { _Pragma("unroll") for (int n = 0; n < 2; ++n) _Pragma("unroll") for (int k = 0; k < 2; ++k) dst[n][k] = *(const PG8_LAS bf16x8*)(lds + PG8_SB(b, h) + boff + n * 2048 + k * 1024); } while (0)
#define PG8_MMA(ai, bj, At, Bt) do { __builtin_amdgcn_s_setprio(1); _Pragma("unroll") for (int m = 0; m < 4; ++m) _Pragma("unroll") for (int n = 0; n < 2; ++n) _Pragma("unroll") for (int k = 0; k < 2; ++k) \
        acc[ai][bj][m][n] = __builtin_amdgcn_mfma_f32_16x16x32_bf16(Bt[n][k], At[m][k], acc[ai][bj][m][n], 0, 0, 0); __builtin_amdgcn_s_setprio(0); } while (0)
#define PG8_WAIT_V(n) asm volatile("s_waitcnt vmcnt(" #n ")" ::: "memory")
#define PG8_WAIT_L(n) asm volatile("s_waitcnt lgkmcnt(" #n ")" ::: "memory")
#define PG8_BAR __builtin_amdgcn_s_barrier()
#define PG8_SCHED __builtin_amdgcn_sched_barrier(0)
    Unit cur, nxt; int ui = 0;
    if (!S.next(0, cur)) return;
    f32x4 acc[2][2][4][2];
#pragma unroll
    for (int a = 0; a < 2; ++a)
#pragma unroll
        for (int b = 0; b < 2; ++b)
#pragma unroll
            for (int m = 0; m < 4; ++m)
#pragma unroll
                for (int n = 0; n < 2; ++n) acc[a][b][m][n] = (f32x4){0.f, 0.f, 0.f, 0.f};
    bf16x8 At[4][2], B0[2][2], B1[2][2];
    const char* cA = (const char*)g.A + (size_t)cur.pm * tstep; const char* cB = (const char*)g.Bt + (size_t)cur.pn * tstep;
    S.a_ready(cur);
    if constexpr (SP2) {
        PG8_STAGE(PG8_SB(0, 0), cB, voffB); PG8_STAGE(PG8_SB(0, 1), cB + hstep, voffB); PG8_STAGE(PG8_SA(0, 0), cA, voffA); PG8_STAGE(PG8_SA(0, 1), cA + hstep, voffA);
        if (wr == 1) PG8_BAR;
        PG8_WAIT_V(2); PG8_BAR;
        PG8_STAGE(PG8_SB(1, 0), cB + kstep, voffB); PG8_STAGE(PG8_SA(1, 0), cA + kstep, voffA); PG8_STAGE(PG8_SB(1, 1), cB + hstep + kstep, voffB);
        PG8_WAIT_V(6); PG8_BAR;
    } else {
        PG8_STAGE(PG8_SB(0, 0), cB, voffB); PG8_STAGE(PG8_SA(0, 0), cA, voffA); PG8_STAGE(PG8_SB(0, 1), cB + hstep, voffB); PG8_STAGE(PG8_SA(0, 1), cA + hstep, voffA);
        if (wr == 1) PG8_BAR;
        PG8_WAIT_V(4); PG8_BAR;
        PG8_STAGE(PG8_SB(1, 0), cB + kstep, voffB); PG8_STAGE(PG8_SA(1, 0), cA + kstep, voffA); PG8_STAGE(PG8_SB(1, 1), cB + hstep + kstep, voffB);
        PG8_WAIT_V(6); PG8_BAR;
    }
    for (;;) {
        const bool has_next = S.next(ui + 1, nxt);
        const char* nA = has_next ? (const char*)g.A + (size_t)nxt.pm * tstep : cA; const char* nB = has_next ? (const char*)g.Bt + (size_t)nxt.pn * tstep : cB;
        for (int t = 0; t < nt; t += 2) {
            const bool last = (t == nt - 2);
            const char* a1 = cA + (size_t)(t + 1) * kstep;
            const char* a2 = last ? nA : cA + (size_t)(t + 2) * kstep; const char* b2 = last ? nB : cB + (size_t)(t + 2) * kstep;
            const char* a3 = a2 + kstep; const char* b3 = b2 + kstep;
            if (last && has_next) S.a_ready(nxt);
            if constexpr (SP2) {
            PG8_LDB(B0, 0, 0); PG8_LDB(B1, 0, 1); PG8_SCHED; PG8_LDA(At, 0, 0); PG8_STAGE(PG8_SA(1, 1), a1 + hstep, voffA);
            PG8_WAIT_V(8); PG8_WAIT_L(0); PG8_BAR; PG8_MMA(0, 0, At, B0); PG8_MMA(0, 1, At, B1); PG8_BAR; PG8_SCHED;
            PG8_LDA(At, 0, 1); PG8_STAGE(PG8_SB(0, 0), b2, voffB); PG8_STAGE(PG8_SB(0, 1), b2 + hstep, voffB); PG8_STAGE(PG8_SA(0, 0), a2, voffA);
            PG8_WAIT_V(8); PG8_WAIT_L(0); PG8_BAR; PG8_MMA(1, 0, At, B0); PG8_MMA(1, 1, At, B1); PG8_BAR; PG8_SCHED;
            PG8_LDB(B0, 1, 0); PG8_LDB(B1, 1, 1); PG8_SCHED; PG8_LDA(At, 1, 0); PG8_STAGE(PG8_SA(0, 1), a2 + hstep, voffA);
            PG8_WAIT_V(8); PG8_WAIT_L(0); PG8_BAR; PG8_MMA(0, 0, At, B0); PG8_MMA(0, 1, At, B1); PG8_BAR; PG8_SCHED;
            PG8_LDA(At, 1, 1); PG8_STAGE(PG8_SB(1, 0), b3, voffB); PG8_STAGE(PG8_SB(1, 1), b3 + hstep, voffB); PG8_STAGE(PG8_SA(1, 0), a3, voffA);
            PG8_WAIT_V(8); PG8_WAIT_L(0); PG8_BAR; PG8_MMA(1, 0, At, B0); PG8_MMA(1, 1, At, B1); PG8_BAR; PG8_SCHED;
            } else {
            PG8_LDB(B0, 0, 0); PG8_SCHED; PG8_LDA(At, 0, 0); PG8_STAGE(PG8_SA(1, 1), a1 + hstep, voffA);
            PG8_WAIT_L(8); PG8_BAR; PG8_WAIT_L(0); PG8_MMA(0, 0, At, B0); PG8_BAR; PG8_SCHED;
            PG8_LDB(B1, 0, 1); PG8_STAGE(PG8_SB(0, 0), b2, voffB);
            PG8_BAR; PG8_WAIT_L(0); PG8_MMA(0, 1, At, B1); PG8_BAR;
            PG8_LDA(At, 0, 1); PG8_STAGE(PG8_SA(0, 0), a2, voffA);
            PG8_BAR; PG8_WAIT_L(0); PG8_MMA(1, 0, At, B0); PG8_BAR; PG8_SCHED;
            PG8_STAGE(PG8_SB(0, 1), b2 + hstep, voffB);
            PG8_WAIT_V(6); PG8_BAR; PG8_MMA(1, 1, At, B1); PG8_BAR;
            PG8_LDB(B0, 1, 0); PG8_SCHED; PG8_LDA(At, 1, 0); PG8_STAGE(PG8_SA(0, 1), a2 + hstep, voffA);
            PG8_WAIT_L(8); PG8_BAR; PG8_WAIT_L(0); PG8_MMA(0, 0, At, B0); PG8_BAR; PG8_SCHED;
            PG8_LDB(B1, 1, 1); PG8_STAGE(PG8_SB(1, 0), b3, voffB);
            PG8_BAR; PG8_WAIT_L(0); PG8_MMA(0, 1, At, B1); PG8_BAR;
            PG8_LDA(At, 1, 1); PG8_STAGE(PG8_SA(1, 0), a3, voffA);
            PG8_BAR; PG8_WAIT_L(0); PG8_MMA(1, 0, At, B0); PG8_BAR; PG8_SCHED;
            PG8_STAGE(PG8_SB(1, 1), b3 + hstep, voffB);
            PG8_WAIT_V(6); PG8_BAR; PG8_MMA(1, 1, At, B1); PG8_BAR;
            }
        }
        if constexpr (ALIGN_EPI) { if (wr == 0) PG8_BAR; }
        if constexpr (!Epi::AFTER_DRAIN) { E(acc, cur, wr, wc, fr, fq); S.done(cur); }
        if (!has_next) break;
#pragma unroll
        for (int a = 0; a < 2; ++a)
#pragma unroll
            for (int b = 0; b < 2; ++b)
#pragma unroll
                for (int m = 0; m < 4; ++m)
#pragma unroll
                    for (int n = 0; n < 2; ++n) acc[a][b][m][n] = (f32x4){0.f, 0.f, 0.f, 0.f};
        cur = nxt; cA = nA; cB = nB; ++ui;
        if constexpr (ALIGN_EPI) { if (wr == 1) PG8_BAR; }
    }
    PG8_WAIT_V(0);
    if constexpr (!ALIGN_EPI) { if (wr == 0) PG8_BAR; }
    PG8_BAR;
    if constexpr (Epi::AFTER_DRAIN) { E.fused(acc, cur, wr, wc, fr, fq, lds, wid, lane); S.done(cur); }
#undef PG8_SA
#undef PG8_SB
#undef PG8_STAGE
#undef PG8_LDA
#undef PG8_LDB
#undef PG8_MMA
#undef PG8_WAIT_V
#undef PG8_WAIT_L
#undef PG8_BAR
#undef PG8_SCHED
}
}
namespace fox {
#define FOX_LAS __attribute__((address_space(3)))
typedef unsigned short bf16;
typedef short bf16x8 __attribute__((ext_vector_type(8)));
typedef short s16x4 __attribute__((ext_vector_type(4)));
typedef float f32x16 __attribute__((ext_vector_type(16)));
typedef float f32x4 __attribute__((ext_vector_type(4)));
typedef unsigned u32x4 __attribute__((ext_vector_type(4)));
constexpr int D = 128, OPITCH = 2048;
constexpr float SCALE = 0.08838834764831845f;
constexpr float THR = 8.f;
constexpr int NW = 8, QBLK = 32, KVBLK = 64, QB = NW * QBLK;
constexpr int SHM_V = KVBLK * D * 2, SHM_K = KVBLK * D * 2, SHM_X = KVBLK * 16 * 2;
constexpr int LDS_WS_OFF = 2 * SHM_V + 2 * SHM_K, LDS_X_OFF = LDS_WS_OFF + NW * 64 * 4, LDS_BYTES = LDS_X_OFF + 2 * SHM_X;

#define KSWZ(row, colB) ((row) * 256 + ((colB) ^ (((row) & 7) << 4)))
#define SBAR() __builtin_amdgcn_sched_barrier(0)
__device__ __forceinline__ int v_st(int k, int c) { const int kk = (k & ~0xC) | ((k & 4) << 1) | ((k & 8) >> 1); return ((kk >> 3) * 4 + (c >> 5)) * 512 + ((kk & 7) * 32 + (c & 31)) * 2; }
__device__ __forceinline__ int v_rd_base(int lane) { return ((lane & 3) << 3) | (((lane >> 2) & 3) << 6) | (((lane >> 4) & 1) << 5) | (((lane >> 5) & 1) << 8); }
constexpr int v_rd_off(int d0, int ks, int half) { return d0 * 512 + ks * 4096 + half * 2048; }
__device__ __forceinline__ int crow(int r, int hi) { return (r & 3) + 8 * (r >> 2) + 4 * hi; }
__device__ __forceinline__ unsigned cvtpk(float lo, float hi) { unsigned r; asm volatile("v_cvt_pk_bf16_f32 %0, %1, %2" : "=v"(r) : "v"(lo), "v"(hi)); return r; }
__device__ __forceinline__ bf16x8 load8(const bf16* p) { return *reinterpret_cast<const bf16x8*>(p); }
__device__ __forceinline__ void glds16(const void* gsrc, unsigned lds_dst) { unsigned keep;
    asm volatile("s_mov_b32 %0, m0\n\ts_mov_b32 m0, %2\n\ts_nop 0\n\tglobal_load_lds_dwordx4 %1, off\n\ts_mov_b32 m0, %0" : "=&s"(keep) : "v"(gsrc), "s"(lds_dst) : "memory"); }
__device__ __forceinline__ void mask_tile(f32x16& p0, f32x16& p1, int dq) {
    const float NEG = -__builtin_inff();
#pragma unroll
    for (int r = 0; r < 16; ++r) {
        const int c = (r & 3) + 8 * (r >> 2);
        if (dq - c < 0) p0[r] = NEG;
        if (dq - c - 32 < 0) p1[r] = NEG;
    }
}
__device__ __forceinline__ void partialSM(f32x16& p0, f32x16& p1, float& m_reg, float& mn, float& alpha) {
    float pmax = p0[0]; for (int r = 1; r < 16; ++r) pmax = fmaxf(pmax, p0[r]); for (int r = 0; r < 16; ++r) pmax = fmaxf(pmax, p1[r]);
    { auto rr = __builtin_amdgcn_permlane32_swap(__float_as_uint(pmax), __float_as_uint(pmax), false, false);
      pmax = fmaxf(__uint_as_float(rr[0]), __uint_as_float(rr[1])); }
    constexpr float C2 = 1.4426950408889634f * SCALE;
    if (__builtin_expect(__all((pmax - m_reg) * SCALE <= THR), 1)) { mn = m_reg; alpha = 1.f; }
    else { mn = fmaxf(m_reg, pmax); alpha = __builtin_amdgcn_exp2f((m_reg - mn) * C2); m_reg = mn; }
    const float mnL = -mn * C2;
    for (int r = 0; r < 16; ++r) p0[r] = fmaf(p0[r], C2, mnL); for (int r = 0; r < 16; ++r) p1[r] = fmaf(p1[r], C2, mnL);
    for (int r = 0; r < 16; ++r) p0[r] = __builtin_amdgcn_exp2f(p0[r]);
}
__device__ __forceinline__ void finishSM(f32x16& p0, f32x16& p1, float alpha, float& l_reg, bf16x8& pa0, bf16x8& pa1, bf16x8& pa2, bf16x8& pa3) {
    for (int r = 0; r < 16; ++r) p1[r] = __builtin_amdgcn_exp2f(p1[r]);
    float ps = 0; for (int r = 0; r < 16; ++r) ps += p0[r]; for (int r = 0; r < 16; ++r) ps += p1[r];
    { auto rr = __builtin_amdgcn_permlane32_swap(__float_as_uint(ps), __float_as_uint(ps), false, false);
      ps = __uint_as_float(rr[0]) + __uint_as_float(rr[1]); }
    l_reg = l_reg * alpha + ps;
#define PK4(P, B_, OUT) do { unsigned a0 = cvtpk(P[B_+0], P[B_+1]), a1 = cvtpk(P[B_+2], P[B_+3]);                          \
        unsigned b0 = cvtpk(P[B_+4], P[B_+5]), b1 = cvtpk(P[B_+6], P[B_+7]);                                             \
        auto r0 = __builtin_amdgcn_permlane32_swap(a0, b0, false, false); auto r1 = __builtin_amdgcn_permlane32_swap(a1, b1, false, false); \
        u32x4 w = {r0[0], r1[0], r0[1], r1[1]}; OUT = *reinterpret_cast<bf16x8*>(&w); } while (0)
    PK4(p0, 0, pa0); PK4(p0, 8, pa1); PK4(p1, 0, pa2); PK4(p1, 8, pa3);
#undef PK4
}
template <int KB>
__device__ __forceinline__ void qkt(f32x16& p0, f32x16& p1, const char* K_lds, const char* X_lds, int r32, int hi, const bf16x8* qr, bf16x8 qx) {
    p0 = f32x16{}; p1 = f32x16{};
    const char* kb[4];
#pragma unroll
    for (int dd = 0; dd < 4; ++dd) kb[dd] = K_lds + KB * SHM_K + KSWZ(r32, (dd * 16 + hi * 8) * 2);
#pragma unroll
    for (int d0 = 0; d0 < 8; ++d0) { const char* a = kb[d0 & 3] + (d0 >> 2) * 128;
        bf16x8 b0 = *reinterpret_cast<const bf16x8*>(a);
        bf16x8 b1 = *reinterpret_cast<const bf16x8*>(a + 32 * 256);
        p0 = __builtin_amdgcn_mfma_f32_32x32x16_bf16(b0, qr[d0], p0, 0, 0, 0);
        p1 = __builtin_amdgcn_mfma_f32_32x32x16_bf16(b1, qr[d0], p1, 0, 0, 0); }
    { const char* a = X_lds + KB * SHM_X + r32 * 32 + hi * 16;
        bf16x8 x0 = *reinterpret_cast<const bf16x8*>(a);
        bf16x8 x1 = *reinterpret_cast<const bf16x8*>(a + 32 * 32);
        p0 = __builtin_amdgcn_mfma_f32_32x32x16_bf16(x0, qx, p0, 0, 0, 0);
        p1 = __builtin_amdgcn_mfma_f32_32x32x16_bf16(x1, qx, p1, 0, 0, 0); }
}
template <int VB>
__device__ __forceinline__ void pv_tile(f32x16* o, int vb0, bf16x8 pa0, bf16x8 pa1, bf16x8 pa2, bf16x8 pa3) {
#define TRRD(dst, off) asm volatile("ds_read_b64_tr_b16 %0, %1 offset:%2" : "=&v"(dst) : "v"(vb0), "i"(off) : "memory")
#define PV_D0(d0) do { s16x4 l0, l1, l2, l3, h0, h1, h2, h3; constexpr int b_ = VB * SHM_V + v_rd_off(d0, 0, 0);     \
        TRRD(l0, b_); TRRD(h0, b_ + 2048); TRRD(l1, b_ + 4096); TRRD(h1, b_ + 6144); TRRD(l2, b_ + 8192); TRRD(h2, b_ + 10240); TRRD(l3, b_ + 12288); TRRD(h3, b_ + 14336); \
        asm volatile("s_waitcnt lgkmcnt(0)" ::: "memory"); SBAR();                                                        \
        o[d0] = __builtin_amdgcn_mfma_f32_32x32x16_bf16(pa0, (bf16x8){l0[0], l0[1], l0[2], l0[3], h0[0], h0[1], h0[2], h0[3]}, o[d0], 0, 0, 0);   \
        o[d0] = __builtin_amdgcn_mfma_f32_32x32x16_bf16(pa1, (bf16x8){l1[0], l1[1], l1[2], l1[3], h1[0], h1[1], h1[2], h1[3]}, o[d0], 0, 0, 0);   \
        o[d0] = __builtin_amdgcn_mfma_f32_32x32x16_bf16(pa2, (bf16x8){l2[0], l2[1], l2[2], l2[3], h2[0], h2[1], h2[2], h2[3]}, o[d0], 0, 0, 0);   \
        o[d0] = __builtin_amdgcn_mfma_f32_32x32x16_bf16(pa3, (bf16x8){l3[0], l3[1], l3[2], l3[3], h3[0], h3[1], h3[2], h3[3]}, o[d0], 0, 0, 0); } while (0)
    PV_D0(0); PV_D0(1); PV_D0(2); PV_D0(3);
#undef PV_D0
#undef TRRD
}
struct Bases { const bf16* Q; const bf16* K; const bf16* V; const bf16* KX; bf16* O; };
struct BlockRef { int h, qb, jlo; };
constexpr int SEQL = 16384;
#define REF_Q(B_, r) ((B_).Q + ((size_t)(r).h * SEQL + (size_t)(r).qb * QB) * D)
#define REF_K(B_, r) ((B_).K + (size_t)(r).h * SEQL * D)
#define REF_V(B_, r) ((B_).V + (size_t)(r).h * SEQL * D)
#define REF_X(B_, r) ((B_).KX + (size_t)(r).h * SEQL * 16)
#define REF_O(B_, r) ((B_).O + (size_t)(r).qb * QB * OPITCH + (r).h * D)
struct Seam { bf16x8 qr[8]; bf16x8 st_v0, st_v1, st_k0, st_k1; };
#define ROW(p, k0, rr) ((p) + (size_t)((k0) + (rr)) * D + sc)
#define VMW() asm volatile("s_waitcnt vmcnt(0)" ::: "memory")
#define VMWN(n) asm volatile("s_waitcnt vmcnt(%0)" :: "i"(n) : "memory")
#define SLOAD_H(Kp, Vp, k0) do { S.st_v0 = load8(ROW(Vp, k0, sr)); S.st_v1 = load8(ROW(Vp, k0, 32 + sr));              \
                         S.st_k0 = load8(ROW(Kp, k0, sr)); S.st_k1 = load8(ROW(Kp, k0, 32 + sr)); } while (0)
#define XDMA(Xp, k0, bf) do { if (wid < 2) glds16((Xp) + (size_t)(k0) * 16 + tid * 8, x_l32 + (bf) * SHM_X + wid * 1024); } while (0)
#define SWRITE_HK(bf) do { *(bf16x8*)(K_lds + (bf) * SHM_K + kws) = S.st_k0; *(bf16x8*)(K_lds + (bf) * SHM_K + kws + 32 * 256) = S.st_k1; } while (0)
#define SWRITE_HV(bf) do { *(bf16x8*)(V_lds + (bf) * SHM_V + vst0) = S.st_v0; *(bf16x8*)(V_lds + (bf) * SHM_V + vst1) = S.st_v1; } while (0)
#define SWRITE_H(bf) do { SWRITE_HV(bf); SWRITE_HK(bf); } while (0)
__device__ __forceinline__ void fox_prime(const Bases& BS, const BlockRef& cur, char* lds, unsigned lds32, Seam& S) {
    const int tid = threadIdx.x, wid = __builtin_amdgcn_readfirstlane(tid >> 6), lane = tid & 63, r32 = lane & 31, hi = lane >> 5;
    const int sr = tid >> 4, sc = (tid & 15) * 8, kws = KSWZ(sr, sc * 2); char* K_lds = lds + 2 * SHM_V; const unsigned x_l32 = lds32 + LDS_X_OFF;
    const int kb0 = cur.jlo * KVBLK;
    for (int d0 = 0; d0 < 8; ++d0) S.qr[d0] = load8(REF_Q(BS, cur) + (size_t)(wid * QBLK + r32) * D + d0 * 16 + hi * 8);
    SLOAD_H(REF_K(BS, cur), REF_V(BS, cur), kb0); XDMA(REF_X(BS, cur), kb0, 0); VMW(); SWRITE_HK(0);
    __syncthreads();
}
__device__ __forceinline__ void fox_block(const Bases& BS, const BlockRef& cur, const BlockRef& nxt, char* lds, unsigned lds32, Seam& S) {
    const int tid = threadIdx.x, wid = __builtin_amdgcn_readfirstlane(tid >> 6), lane = tid & 63, r32 = lane & 31, hi = lane >> 5;
    const int j_lo = cur.jlo;
    const int P0 = cur.qb * QB;
    const int j_hi = (P0 + QB - 1) / KVBLK + 1;
    const int NT = j_hi - j_lo;
    const int kbn = nxt.jlo * KVBLK;
    const int qlo = P0 + wid * QBLK, qm = qlo + r32 - 4 * hi;
    char* V_lds = lds; char* K_lds = lds + 2 * SHM_V; const char* X_lds = lds + LDS_X_OFF; const unsigned x_l32 = lds32 + LDS_X_OFF;
    float* ws = (float*)(lds + LDS_WS_OFF) + wid * 64; float* li_l = ws, * al_l = ws + 32;
    float m_reg = -1e30f, l_reg = 0; f32x16 o[4] = {};
    const int sr = tid >> 4, sc = (tid & 15) * 8, vst0 = v_st(sr, sc), vst1 = v_st(32 + sr, sc), kws = KSWZ(sr, sc * 2);
    const int vb0 = (int)lds32 + v_rd_base(lane);
    const bf16* Kh = REF_K(BS, cur); const bf16* Vh = REF_V(BS, cur); const bf16* Xh = REF_X(BS, cur);
    bf16x8 qx; { const short one = hi == 0 ? (short)0x3F80 : (short)0; qx = (bf16x8){one, one, one, 0, 0, 0, 0, 0}; }
#define RESC(a) do { if (__any((a) < 1.f)) { if (hi == 0) al_l[r32] = (a); asm volatile("s_waitcnt lgkmcnt(0)" ::: "memory");              \
                     for (int d_ = 0; d_ < 4; ++d_) for (int r = 0; r < 16; ++r) o[d_][r] *= al_l[crow(r, hi)]; } } while (0)
#define KBASE(t) ((j_lo + (t)) * KVBLK)
#define MASKT(P0_, P1_, t) do { const int kb_ = KBASE(t); if (kb_ + KVBLK - 1 > qlo) mask_tile(P0_, P1_, qm - kb_); } while (0)
    constexpr int NQL = 8;
#define SEAM_K0() do { VMWN(NQL); SWRITE_HK(0); SBAR(); } while (0)
    f32x16 pA0, pA1, pB0, pB1; float mnA, mnB, alA, alB; bf16x8 pa0, pa1, pa2, pa3;
    SWRITE_HV(0); SBAR();
    if (NT > 1) { SLOAD_H(Kh, Vh, KBASE(1)); XDMA(Xh, KBASE(1), 1); }
    SBAR(); qkt<0>(pA0, pA1, K_lds, X_lds, r32, hi, S.qr, qx);
    MASKT(pA0, pA1, 0); partialSM(pA0, pA1, m_reg, mnA, alA);
    if (NT > 1) { VMW(); SWRITE_H(1); }
    __syncthreads();
#define HALF_STEP(PX0, PX1, mnX, alX, PY0, PY1, alY, t, KB, VB, SB) do {                                                      \
        SBAR(); qkt<KB>(PX0, PX1, K_lds, X_lds, r32, hi, S.qr, qx);                                                           \
        finishSM(PY0, PY1, alY, l_reg, pa0, pa1, pa2, pa3); SBAR();                                                           \
        if ((t) + 1 < NT) { SLOAD_H(Kh, Vh, KBASE((t) + 1)); XDMA(Xh, KBASE((t) + 1), SB); SBAR(); }                          \
        pv_tile<VB>(o, vb0, pa0, pa1, pa2, pa3); MASKT(PX0, PX1, (t)); partialSM(PX0, PX1, m_reg, mnX, alX);                  \
        __syncthreads();                                                                                                      \
        if ((t) + 1 < NT) { VMW(); SWRITE_H(SB); }                                                                            \
        RESC(alX); __syncthreads(); } while (0)
    for (int t = 1; t + 1 < NT; t += 2) {
        HALF_STEP(pB0, pB1, mnB, alB, pA0, pA1, alA, t, 1, 0, 0);
        HALF_STEP(pA0, pA1, mnA, alA, pB0, pB1, alB, t + 1, 0, 1, 1);
    }
    const bool even = (NT & 1) == 0;
    if (even) { SBAR(); qkt<1>(pB0, pB1, K_lds, X_lds, r32, hi, S.qr, qx); SBAR(); }
    SLOAD_H(REF_K(BS, nxt), REF_V(BS, nxt), kbn); XDMA(REF_X(BS, nxt), kbn, 0); SBAR();
#pragma unroll
    for (int d0 = 0; d0 < 8; ++d0) S.qr[d0] = load8(REF_Q(BS, nxt) + (size_t)(wid * QBLK + r32) * D + d0 * 16 + hi * 8);
    SBAR();
    finishSM(pA0, pA1, alA, l_reg, pa0, pa1, pa2, pa3); SBAR();
    pv_tile<0>(o, vb0, pa0, pa1, pa2, pa3);
    if (even) { MASKT(pB0, pB1, NT - 1); partialSM(pB0, pB1, m_reg, mnB, alB); __syncthreads(); RESC(alB);
        finishSM(pB0, pB1, alB, l_reg, pa0, pa1, pa2, pa3); SBAR(); pv_tile<1>(o, vb0, pa0, pa1, pa2, pa3); }
    SBAR(); SEAM_K0();
    if (hi == 0) li_l[r32] = l_reg; asm volatile("s_waitcnt lgkmcnt(0)" ::: "memory");
    float rli[16];
#pragma unroll
    for (int r = 0; r < 16; ++r) rli[r] = __builtin_amdgcn_rcpf(li_l[crow(r, hi)]);
    bf16* Ow = REF_O(BS, cur) + (size_t)(wid * QBLK) * OPITCH;
#pragma unroll
    for (int r = 0; r < 16; ++r) { const int orow = crow(r, hi);
#pragma unroll
        for (int d0 = 0; d0 < 4; ++d0) { const float v = o[d0][r] * rli[r];
            const float vn = __shfl_xor(v, 1);
            if ((r32 & 1) == 0) *(unsigned*)(Ow + (size_t)orow * OPITCH + d0 * 32 + r32) = cvtpk(v, vn); } }
    __syncthreads();
#undef RESC
#undef KBASE
#undef MASKT
#undef SEAM_K0
#undef HALF_STEP
}
#undef REF_Q
#undef REF_K
#undef REF_V
#undef REF_X
#undef REF_O
#undef ROW
#undef VMW
#undef VMWN
#undef SLOAD_H
#undef XDMA
#undef SWRITE_HK
#undef SWRITE_HV
#undef SWRITE_H
#undef KSWZ
#undef SBAR
}

constexpr int NWAVES = 8;
#ifndef MK_N_LAUNCHES
#define MK_N_LAUNCHES 1
#endif
constexpr int N_PHASES = 17;

constexpr size_t MiB = 1u << 20;
constexpr size_t WS_CTL = 0, CTL_ZERO_BYTES = 64 * 1024;
constexpr size_t WS_TOKE = 1 * MiB, WS_TOKW0 = WS_TOKE + 65536, WS_TOKW1 = WS_TOKW0 + 65536, WS_TOKP0 = WS_TOKW1 + 65536, WS_TOKP1 = WS_TOKP0 + 65536;
constexpr size_t WS_SLOT = 2 * MiB;
constexpr size_t WS_LC = 4 * MiB;
constexpr size_t WS_CT = 5 * MiB;
constexpr size_t WS_WR = 5 * MiB + 512 * 1024;
constexpr size_t WS_WF = 6 * MiB;
constexpr size_t WS_KX = 8 * MiB;
constexpr size_t WS_WCIN = 16 * MiB, WS_WCOUT = 40 * MiB, WS_WAIN = 48 * MiB, WS_WAOUT = 72 * MiB;
constexpr size_t WS_WGU = 80 * MiB;
constexpr size_t WS_WD = 336 * MiB;
constexpr size_t WS_HN = 464 * MiB;
constexpr size_t WS_X = 528 * MiB;
constexpr size_t WS_STAGE = 656 * MiB;
constexpr size_t WS_Z = WS_STAGE, WS_GO = WS_STAGE + 64 * MiB;
constexpr size_t WS_XS = WS_STAGE, WS_H = WS_STAGE + 160 * MiB;
constexpr size_t WS_Q = WS_STAGE, WS_K = WS_STAGE + 64 * MiB, WS_V = WS_STAGE + 128 * MiB;
constexpr size_t WS_END = 856 * MiB;
constexpr int CW_CNT = 64;
constexpr int CW_BAR = 4096;
constexpr int RING_OFF = 0, RING_BYTES = 131072;
constexpr int TILE_OFF = RING_BYTES;
constexpr int TST_OFF = TILE_OFF + 1024;
constexpr int MISC_OFF = TST_OFF + 512;
constexpr int LDS_BYTES = 147456;
static_assert(MISC_OFF + 128 <= LDS_BYTES && fox::LDS_BYTES <= RING_BYTES, "LDS map");

#define GAS __attribute__((address_space(1)))
#define LAS __attribute__((address_space(3)))
typedef unsigned short bf16;
typedef unsigned v4u __attribute__((ext_vector_type(4)));
typedef unsigned v2u __attribute__((ext_vector_type(2)));
typedef float f32x4 __attribute__((ext_vector_type(4)));
typedef float f32x16 __attribute__((ext_vector_type(16)));
typedef short bf16x8 __attribute__((ext_vector_type(8)));
typedef GAS unsigned gu32;
#define RLX_AGENT __ATOMIC_RELAXED, __HIP_MEMORY_SCOPE_AGENT
#define LDS_WAIT() asm volatile("s_waitcnt lgkmcnt(0)" ::: "memory")
#define VM_WAIT() asm volatile("s_waitcnt vmcnt(0)" ::: "memory")
__device__ __forceinline__ unsigned f2bf(float f) { unsigned u = __builtin_bit_cast(unsigned, f); return (u + 0x7fffu + ((u >> 16) & 1u)) >> 16; }
__device__ __forceinline__ unsigned pk2(float lo, float hi) { return f2bf(lo) | (f2bf(hi) << 16); }
__device__ __forceinline__ float bf_lo(unsigned w) { return __builtin_bit_cast(float, w << 16); }
__device__ __forceinline__ float bf_hi(unsigned w) { return __builtin_bit_cast(float, w & 0xffff0000u); }
__device__ __forceinline__ float wave_sum(float v) {
#pragma unroll
    for (int o = 1; o < 64; o <<= 1) v += __shfl_xor(v, o);
    return v;
}

#define XB_TMO      128
#define XB_XCNT(j)  (256  + 64 * (j))
#define XB_XSUB(j)  (1280 + 64 * (j))
#define XB_XGEN(j)  (2304 + 64 * (j))
#define XB_TOP      3328
#define XB_TOPGEN   3392
#define XCD_BAR_WORDS 3456
#define XB_SPIN_CAP (1u << 18)

__device__ __forceinline__ unsigned xb_ld(unsigned* p)              { return __hip_atomic_load(p, __ATOMIC_RELAXED, __HIP_MEMORY_SCOPE_AGENT); }
__device__ __forceinline__ unsigned xb_add(unsigned* p, unsigned v) { return __hip_atomic_fetch_add(p, v, __ATOMIC_RELAXED, __HIP_MEMORY_SCOPE_AGENT); }
__device__ __forceinline__ unsigned xb_xcc_id() { return (unsigned)__builtin_amdgcn_s_getreg((3 << 11) | 20) & 0xFu; }
#define XB_SPIN(cond, bar) do { unsigned _sp = 0; while (cond) { __builtin_amdgcn_s_sleep(1); \
    if ((++_sp & 255u) == 0u) { if (xb_ld(&(bar)[XB_TMO])) break; if (_sp > XB_SPIN_CAP) { atomicAdd(&(bar)[XB_TMO], 1u); break; } } } } while (0)

struct XcdBarrier {
    unsigned* bar; unsigned x;
    volatile LAS unsigned* st;
};

__device__ __forceinline__ XcdBarrier xcd_barrier_post(unsigned* bar, volatile LAS unsigned* st) {
    XcdBarrier b; b.bar = bar; b.x = xb_xcc_id(); b.st = st;
    if (threadIdx.x == 0) (void)xb_add(&bar[XB_XCNT(b.x)], 1u);
    return b;
}
__device__ __forceinline__ void xcd_barrier_complete(unsigned* bar, unsigned x, unsigned& nloc, unsigned& nx) {
    const unsigned G = gridDim.x * gridDim.y * gridDim.z;
    unsigned sum, cnt, mine, sp = 0u;
    for (;;) {
        sum = 0u; cnt = 0u; mine = 0u;
#pragma unroll
        for (unsigned j = 0; j < 16; ++j) { const unsigned c = xb_ld(&bar[XB_XCNT(j)]); sum += c; cnt += (c > 0u) ? 1u : 0u; mine = (j == x) ? c : mine; }
        if (sum == G) break;
        __builtin_amdgcn_s_sleep(1);
        if ((++sp & 255u) == 0u) { if (xb_ld(&bar[XB_TMO])) break; if (sp > XB_SPIN_CAP) { atomicAdd(&bar[XB_TMO], 1u); break; } }
    }
    nloc = mine > 0u ? mine : 1u; nx = cnt > 0u ? cnt : 1u;
}

__device__ __forceinline__ void xcd_barrier(const XcdBarrier& b) {
    asm volatile("s_waitcnt vmcnt(0)" ::: "memory");
    __syncthreads();
    if (threadIdx.x == 0) {
        unsigned* bar = b.bar;
        __builtin_amdgcn_s_waitcnt(0);
        unsigned nloc = b.st[0], nx = b.st[1];
        if (nloc == 0u) { xcd_barrier_complete(bar, b.x, nloc, nx); b.st[0] = nloc; b.st[1] = nx; }
        const unsigned old = xb_add(&bar[XB_XSUB(b.x)], 1u);
        const unsigned gen = old / nloc;
        if (old + 1u == (gen + 1u) * nloc) {
            __builtin_amdgcn_fence(__ATOMIC_RELEASE, "agent");
            asm volatile("s_waitcnt vmcnt(0)" ::: "memory");
            const unsigned og = xb_add(&bar[XB_TOP], 1u);
            const unsigned tg = og / nx;
            if (og + 1u == (tg + 1u) * nx) xb_add(&bar[XB_TOPGEN], 1u);
            else XB_SPIN(xb_ld(&bar[XB_TOPGEN]) == tg, bar);
            __builtin_amdgcn_fence(__ATOMIC_ACQUIRE, "agent");
            xb_add(&bar[XB_XGEN(b.x)], 1u);
            asm volatile("s_waitcnt vmcnt(0)" ::: "memory");
        } else {
            XB_SPIN(xb_ld(&bar[XB_XGEN(b.x)]) == gen, bar);
            __builtin_amdgcn_fence(__ATOMIC_ACQUIRE, "agent");
            asm volatile("s_waitcnt vmcnt(0)" ::: "memory");
        }
    }
    __syncthreads();
}

struct Frame {
    LAS unsigned char* lds;
    volatile LAS unsigned* MISC;
    gu32* ctl;
    int tid, lane, wave;
    int vcu, G;
    const float *x, *mix_norm, *ffn_norm, *final_norm, *conv_w_in, *conv_w, *conv_w_out, *attn_w_in, *attn_b_f, *attn_w_out, *rg_w, *rg_b, *re_w, *re_b, *w_gate, *w_up, *w_down;
    float* out; unsigned char* ws;
};
#define WSP(T, off) ((T*)(F.ws + (off)))

struct TrItem { const float* src; bf16* dst; int ldw, ldd; };
__device__ __forceinline__ bool tr_decode(const Frame& F, int it, TrItem& d) {
    if (it < 6144) { const int kb = it / 192, nb = it % 192, n0 = nb * 32; d.src = F.conv_w_in + (size_t)(kb * 64) * 6144 + n0; d.ldw = 6144; d.ldd = 2048;
        int dr; if (n0 < 2048) dr = 4096 + n0; else if (n0 < 4096) { const int i = n0 - 2048; dr = 256 * (i >> 7) + (i & 127); } else { const int i = n0 - 4096; dr = 256 * (i >> 7) + 128 + (i & 127); }
        d.dst = WSP(bf16, WS_WCIN) + (size_t)dr * 2048 + kb * 64; return true; }
    it -= 6144;
    if (it < 2048) { const int kb = it / 64, nb = it % 64; d.src = F.conv_w_out + (size_t)(kb * 64) * 2048 + nb * 32; d.ldw = 2048; d.ldd = 2048; d.dst = WSP(bf16, WS_WCOUT) + (size_t)(nb * 32) * 2048 + kb * 64; return true; }
    it -= 2048;
    if (it < 6144) { const int kb = it / 192, nb = it % 192; d.src = F.attn_w_in + (size_t)(kb * 64) * 6160 + nb * 32; d.ldw = 6160; d.ldd = 2048; d.dst = WSP(bf16, WS_WAIN) + (size_t)(nb * 32) * 2048 + kb * 64; return true; }
    it -= 6144;
    if (it < 2048) { const int kb = it / 64, nb = it % 64; d.src = F.attn_w_out + (size_t)(kb * 64) * 2048 + nb * 32; d.ldw = 2048; d.ldd = 2048; d.dst = WSP(bf16, WS_WAOUT) + (size_t)(nb * 32) * 2048 + kb * 64; return true; }
    it -= 2048;
    if (it < 65536) { const int up = it >> 15, r = it & 32767, le = r >> 9, q = r & 511, kb = q >> 4, nb = q & 15, n0 = nb * 32;
        d.src = (up ? F.w_up : F.w_gate) + (size_t)le * 2048 * 512 + (size_t)(kb * 64) * 512 + n0; d.ldw = 512; d.ldd = 2048;
        const int dr = 256 * (n0 >> 7) + 128 * up + (n0 & 127);
        d.dst = WSP(bf16, WS_WGU) + ((size_t)le * 1024 + dr) * 2048 + kb * 64; return true; }
    it -= 65536;
    if (it < 32768) { const int le = it >> 9, q = it & 511, kb = q >> 6, nb = q & 63;
        d.src = F.w_down + (size_t)le * 512 * 2048 + (size_t)(kb * 64) * 2048 + nb * 32; d.ldw = 2048; d.ldd = 512;
        d.dst = WSP(bf16, WS_WD) + ((size_t)le * 2048 + nb * 32) * 512 + kb * 64; return true; }
    return false;
}
constexpr int TR_NITEMS = 6144 + 2048 + 6144 + 2048 + 65536 + 32768;
__device__ __forceinline__ void p0_prologue(Frame& F) {
    LAS float* scr = (LAS float*)(F.lds + RING_OFF + F.wave * 16384);
    const int gw = F.vcu * NWAVES + F.wave, NGW = F.G * NWAVES, lane = F.lane;
    float v[32]; TrItem cur, nx; int it = gw;
    bool have = tr_decode(F, it, cur);
    if (have) {
#pragma unroll
        for (int i = 0; i < 32; ++i) v[i] = cur.src[(size_t)(2 * i + (lane >> 5)) * cur.ldw + (lane & 31)];
    }
    while (have) {
#pragma unroll
        for (int i = 0; i < 32; ++i) scr[(2 * i + (lane >> 5)) * 33 + (lane & 31)] = v[i];
        it += NGW; const bool hn = tr_decode(F, it, nx);
        if (hn) {
#pragma unroll
            for (int i = 0; i < 32; ++i) v[i] = nx.src[(size_t)(2 * i + (lane >> 5)) * nx.ldw + (lane & 31)];
        }
        LDS_WAIT(); asm volatile("" ::: "memory");
        const int c = lane & 7;
#pragma unroll
        for (int j = 0; j < 4; ++j) { const int n = (lane >> 3) + 8 * j; const LAS float* s = scr + (8 * c) * 33 + n;
            v4u o; o.x = pk2(s[0 * 33], s[1 * 33]); o.y = pk2(s[2 * 33], s[3 * 33]); o.z = pk2(s[4 * 33], s[5 * 33]); o.w = pk2(s[6 * 33], s[7 * 33]);
            *(GAS v4u*)(cur.dst + (size_t)n * cur.ldd + 8 * c) = o; }
        LDS_WAIT(); asm volatile("" ::: "memory");
        cur = nx; have = hn;
    }
    const int gt = (F.vcu * NWAVES + F.wave) * 64 + lane, NGT = F.G * NWAVES * 64;
    for (int i = gt; i < 2 * 64 * 2048; i += NGT) { const int l = i >> 17, r = (i >> 11) & 63, k = i & 2047; float w = 0.f;
        if (r < 4) w = F.rg_w[((size_t)l * 2048 + k) * 4 + r];
        else if (r < 36) { const int g = (r - 4) >> 3, e = (r - 4) & 7; w = F.re_w[(((size_t)l * 4 + g) * 2048 + k) * 8 + e]; }
        WSP(bf16, WS_WR)[i] = (bf16)f2bf(w); }
    for (int i = gt; i < 32 * 2048; i += NGT) { const int r = i >> 11, k = i & 2047; const float w = r < 16 ? F.attn_w_in[(size_t)k * 6160 + 6144 + r] : 0.f; WSP(bf16, WS_WF)[i] = (bf16)f2bf(w); }
}

template <int NB>
__device__ __forceinline__ void small_gemm(const Frame& F, const bf16* hn_rows, const bf16* Wt, LAS float* lg) {
    constexpr int NC = NB * 32, NE = 64 * NC, PER = NE / 512;
    const int lane = F.lane, r32 = lane & 31, hi = lane >> 5, kw = F.wave * 256;
    f32x16 acc[2][NB];
#pragma unroll
    for (int a = 0; a < 2; ++a)
#pragma unroll
        for (int b = 0; b < NB; ++b) acc[a][b] = f32x16{};
    const bf16* ap = hn_rows + (size_t)r32 * 2048 + kw + hi * 8; const bf16* bp = Wt + (size_t)r32 * 2048 + kw + hi * 8;
#pragma unroll 4
    for (int ks = 0; ks < 16; ++ks) {
        const bf16x8 a0 = *(const bf16x8*)(ap + ks * 16), a1 = *(const bf16x8*)(ap + 32 * 2048 + ks * 16);
#pragma unroll
        for (int b = 0; b < NB; ++b) { const bf16x8 bv = *(const bf16x8*)(bp + (size_t)b * 32 * 2048 + ks * 16);
            acc[0][b] = __builtin_amdgcn_mfma_f32_32x32x16_bf16(a0, bv, acc[0][b], 0, 0, 0);
            acc[1][b] = __builtin_amdgcn_mfma_f32_32x32x16_bf16(a1, bv, acc[1][b], 0, 0, 0); }
    }
    LAS float* part = lg + F.wave * NE;
#pragma unroll
    for (int a = 0; a < 2; ++a)
#pragma unroll
        for (int b = 0; b < NB; ++b)
#pragma unroll
            for (int r = 0; r < 16; ++r) { const int row = a * 32 + (r & 3) + 8 * (r >> 2) + 4 * hi; part[row * NC + b * 32 + r32] = acc[a][b][r]; }
    LDS_WAIT(); __syncthreads();
    float s[PER];
#pragma unroll
    for (int q = 0; q < PER; ++q) { const int i = F.tid + 512 * q; float t = lg[i];
#pragma unroll
        for (int w = 1; w < 8; ++w) t += lg[w * NE + i];
        s[q] = t; }
    LDS_WAIT(); __syncthreads();
#pragma unroll
    for (int q = 0; q < PER; ++q) { const int i = F.tid + 512 * q; lg[(i / NC) * (NC + 1) + (i % NC)] = s[q]; }
    LDS_WAIT(); __syncthreads();
}
__device__ __forceinline__ int build_tiles(Frame& F, int layer) {
    LAS int* tile_e = (LAS int*)(F.lds + TILE_OFF); LAS int* tst = (LAS int*)(F.lds + TST_OFF);
    __syncthreads();
    if (F.tid < 64) {
        const int c = F.tid < 32 ? (int)__hip_atomic_load(F.ctl + CW_CNT + 32 * layer + F.tid, RLX_AGENT) : 0;
        const int nt = (c + 255) >> 8; int inc = nt;
#pragma unroll
        for (int o = 1; o < 32; o <<= 1) { const int t = __shfl_up(inc, o); if ((F.tid & 63) >= o) inc += t; }
        const int st = inc - nt;
        if (F.tid < 32) { tst[F.tid] = st; tst[32 + F.tid] = c; for (int t = 0; t < nt; ++t) tile_e[st + t] = F.tid; }
        if (F.tid == 31) tst[64] = inc;
    }
    __syncthreads();
    return tst[64];
}
template <int MODE>
__device__ __forceinline__ void row_phase(Frame& F, int layer) {
    const int lane = F.lane, wave = F.wave, tid = F.tid;
    const float* gain = MODE == 0 ? F.mix_norm : (MODE == 1 ? F.ffn_norm + layer * DM : (MODE == 2 ? F.mix_norm + DM : F.final_norm));
    f32x4 g[8];
#pragma unroll
    for (int j = 0; j < 4; ++j) { g[2 * j] = *(const f32x4*)(gain + 512 * j + 8 * lane); g[2 * j + 1] = *(const f32x4*)(gain + 512 * j + 8 * lane + 4); }
    LAS float* lg = (LAS float*)(F.lds + RING_OFF);
    LAS int* hist = (LAS int*)(F.lds + TILE_OFF);
    LAS int* tst = (LAS int*)(F.lds + TST_OFF);
    if (MODE >= 2) (void)build_tiles(F, MODE == 2 ? 0 : 1);
    const float* xin = MODE == 0 ? F.x : WSP(float, WS_X);
    bf16* HN = WSP(bf16, WS_HN);
    for (int chunk = F.vcu; chunk < SEQ / 64; chunk += F.G) {
        const int row0 = chunk * 64;
        if (MODE == 1) { if (tid < 64) hist[tid] = 0; }
        for (int i = 0; i < 8; ++i) {
            const int row = row0 + wave * 8 + i;
            const float* xr = xin + (size_t)row * DM + 8 * lane;
            f32x4 v[8];
#pragma unroll
            for (int j = 0; j < 4; ++j) { v[2 * j] = *(const f32x4*)(xr + 512 * j); v[2 * j + 1] = *(const f32x4*)(xr + 512 * j + 4); }
            if (MODE >= 2) {
                const unsigned ee = WSP(unsigned, WS_TOKE)[row]; const int e0 = ee & 255, e1 = (ee >> 8) & 255;
                const int r0 = tst[e0] * 256 + WSP(int, WS_TOKP0)[row], r1 = tst[e1] * 256 + WSP(int, WS_TOKP1)[row];
                const float w0 = WSP(float, WS_TOKW0)[row], w1 = WSP(float, WS_TOKW1)[row];
                const bf16* o0 = WSP(bf16, WS_XS) + (size_t)r0 * DM + 8 * lane; const bf16* o1 = WSP(bf16, WS_XS) + (size_t)r1 * DM + 8 * lane;
#pragma unroll
                for (int j = 0; j < 4; ++j) { const v4u a = *(const v4u*)(o0 + 512 * j), b = *(const v4u*)(o1 + 512 * j);
                    v[2 * j][0] += w0 * bf_lo(a.x) + w1 * bf_lo(b.x); v[2 * j][1] += w0 * bf_hi(a.x) + w1 * bf_hi(b.x);
                    v[2 * j][2] += w0 * bf_lo(a.y) + w1 * bf_lo(b.y); v[2 * j][3] += w0 * bf_hi(a.y) + w1 * bf_hi(b.y);
                    v[2 * j + 1][0] += w0 * bf_lo(a.z) + w1 * bf_lo(b.z); v[2 * j + 1][1] += w0 * bf_hi(a.z) + w1 * bf_hi(b.z);
                    v[2 * j + 1][2] += w0 * bf_lo(a.w) + w1 * bf_lo(b.w); v[2 * j + 1][3] += w0 * bf_hi(a.w) + w1 * bf_hi(b.w); }
            }
            float ss = 0.f;
#pragma unroll
            for (int j = 0; j < 8; ++j) ss += (v[j][0] * v[j][0] + v[j][1] * v[j][1]) + (v[j][2] * v[j][2] + v[j][3] * v[j][3]);
            const float rstd = 1.0f / sqrtf(wave_sum(ss) * (1.0f / DM) + RMS_EPS);
            if (MODE == 2) { float* xw = WSP(float, WS_X) + (size_t)row * DM + 8 * lane;
#pragma unroll
                for (int j = 0; j < 4; ++j) { *(f32x4*)(xw + 512 * j) = v[2 * j]; *(f32x4*)(xw + 512 * j + 4) = v[2 * j + 1]; } }
            if (MODE == 3) { float* ow = F.out + (size_t)row * DM + 8 * lane;
#pragma unroll
                for (int j = 0; j < 4; ++j) { *(f32x4*)(ow + 512 * j) = v[2 * j] * rstd * g[2 * j]; *(f32x4*)(ow + 512 * j + 4) = v[2 * j + 1] * rstd * g[2 * j + 1]; } }
            else { bf16* hw = HN + (size_t)row * DM + 8 * lane;
#pragma unroll
                for (int j = 0; j < 4; ++j) { const f32x4 a = v[2 * j] * rstd * g[2 * j], b = v[2 * j + 1] * rstd * g[2 * j + 1];
                    v4u o; o.x = pk2(a[0], a[1]); o.y = pk2(a[2], a[3]); o.z = pk2(b[0], b[1]); o.w = pk2(b[2], b[3]); *(v4u*)(hw + 512 * j) = o; } }
        }
        if (MODE == 1 || MODE == 2) {
            VM_WAIT(); __syncthreads();
            if (MODE == 1) small_gemm<2>(F, HN + (size_t)row0 * DM, WSP(bf16, WS_WR) + (size_t)layer * 64 * 2048, lg);
            else small_gemm<1>(F, HN + (size_t)row0 * DM, WSP(bf16, WS_WF), lg);
            if (MODE == 1) {
                int e0 = 0, e1 = 0, rk0 = 0, rk1 = 0; float w0 = 0.f, w1 = 0.f;
                if (tid < 64) {
                    const LAS float* l = lg + tid * 65; const float* gb = F.rg_b + layer * 4; const float* eb = F.re_b + layer * 32;
                    float gl[4]; for (int j = 0; j < 4; ++j) gl[j] = l[j] + gb[j];
                    int gs = 0; float gm = gl[0]; for (int j = 1; j < 4; ++j) if (gl[j] > gm) { gm = gl[j]; gs = j; }
                    float den = 0.f; for (int j = 0; j < 4; ++j) den += __expf(gl[j] - gm);
                    const float pg = 1.0f / den;
                    float el[8]; for (int j = 0; j < 8; ++j) el[j] = l[4 + gs * 8 + j] + eb[gs * 8 + j];
                    int i1 = 0; float v1 = el[0]; for (int j = 1; j < 8; ++j) if (el[j] > v1) { v1 = el[j]; i1 = j; }
                    int i2 = -1; float v2 = -3.0e38f; for (int j = 0; j < 8; ++j) if (j != i1 && el[j] > v2) { v2 = el[j]; i2 = j; }
                    const float s = 1.0f / (1.0f + __expf(v2 - v1));
                    w0 = pg * s; w1 = pg * (1.0f - s); e0 = gs * 8 + i1; e1 = gs * 8 + i2;
                    rk0 = __hip_atomic_fetch_add(hist + e0, 1, __ATOMIC_RELAXED, __HIP_MEMORY_SCOPE_WORKGROUP);
                    rk1 = __hip_atomic_fetch_add(hist + e1, 1, __ATOMIC_RELAXED, __HIP_MEMORY_SCOPE_WORKGROUP);
                    LDS_WAIT(); asm volatile("" ::: "memory");
                    if (tid < 32) { const int c = hist[tid]; hist[32 + tid] = c ? (int)__hip_atomic_fetch_add(F.ctl + CW_CNT + 32 * layer + tid, (unsigned)c, RLX_AGENT) : 0; }
                    LDS_WAIT(); asm volatile("" ::: "memory");
                    const int p0 = hist[32 + e0] + rk0, p1 = hist[32 + e1] + rk1, row = row0 + tid;
                    WSP(int, WS_SLOT)[e0 * CAP + p0] = row; WSP(int, WS_SLOT)[e1 * CAP + p1] = row;
                    WSP(unsigned, WS_TOKE)[row] = (unsigned)e0 | ((unsigned)e1 << 8);
                    WSP(int, WS_TOKP0)[row] = p0; WSP(int, WS_TOKP1)[row] = p1; WSP(float, WS_TOKW0)[row] = w0; WSP(float, WS_TOKW1)[row] = w1;
                }
            } else {
                if (tid < 16) {
                    const float bfh = F.attn_b_f[tid]; float run = 0.f; float* lc = WSP(float, WS_LC) + (size_t)row0 * 16 + tid;
                    for (int r = 0; r < 64; ++r) { const float xv = lg[r * 33 + tid] + bfh; const float ls = fminf(xv, 0.f) - log1pf(__expf(-fabsf(xv))); run += ls; lc[r * 16] = run; }
                    WSP(float, WS_CT)[chunk * 16 + tid] = run;
                }
            }
            __syncthreads();
        }
    }
}
__device__ __forceinline__ void c_finalize(Frame& F) {
    LAS float* part = (LAS float*)(F.lds + RING_OFF);
    const int tid = F.tid;
    for (int chunk = F.vcu; chunk < SEQ / 64; chunk += F.G) {
        __syncthreads();
        { const int h = tid & 15, p = tid >> 4; float s = 0.f; const float* ct = WSP(float, WS_CT);
            for (int c = p * 8; c < p * 8 + 8; ++c) if (c < chunk) s += ct[c * 16 + h];
            part[p * 16 + h] = s; }
        __syncthreads();
        if (tid < 16) { float s = 0.f; for (int p = 0; p < 32; ++p) s += part[p * 16 + tid]; part[512 + tid] = s; }
        __syncthreads();
        for (int i = tid; i < 64 * 16; i += 512) { const int r = i >> 4, h = i & 15, row = chunk * 64 + r;
            const float cv = WSP(float, WS_LC)[(size_t)row * 16 + h] + part[512 + h];
            const float c64 = -cv * 11.313708498984761f;
            const unsigned b1 = f2bf(c64); const float r1 = c64 - __builtin_bit_cast(float, b1 << 16);
            const unsigned b2 = f2bf(r1); const float r2 = r1 - __builtin_bit_cast(float, b2 << 16);
            const unsigned b3 = f2bf(r2);
            v4u* dst = (v4u*)(WSP(bf16, WS_KX) + ((size_t)h * SEQ + row) * 16);
            dst[0] = (v4u){b1 | (b2 << 16), b3, 0u, 0u}; dst[1] = (v4u){0u, 0u, 0u, 0u}; }
    }
    __syncthreads();
}
__device__ __forceinline__ void conv_phase(Frame& F) {
    const int tid = F.tid, c8 = (tid & 255) * 8, half = tid >> 8;
    float w[3][8];
#pragma unroll
    for (int k = 0; k < 3; ++k)
#pragma unroll
        for (int j = 0; j < 8; ++j) w[k][j] = F.conv_w[k * DM + c8 + j];
    const bf16* Z = WSP(bf16, WS_Z); const bf16* GO = WSP(bf16, WS_GO); bf16* A = WSP(bf16, WS_HN);
    for (int chunk = F.vcu; chunk < SEQ / 64; chunk += F.G) {
        const int t0 = chunk * 64 + half * 32;
        v4u zm2 = (v4u){0u, 0u, 0u, 0u}, zm1 = zm2;
        if (t0 >= 2) { zm2 = *(const v4u*)(Z + (size_t)(t0 - 2) * DM + c8); zm1 = *(const v4u*)(Z + (size_t)(t0 - 1) * DM + c8); }
#pragma unroll 4
        for (int t = t0; t < t0 + 32; ++t) {
            const v4u z0 = *(const v4u*)(Z + (size_t)t * DM + c8), go = *(const v4u*)(GO + (size_t)t * DM + c8);
            v4u o;
#define CV(q, j) (w[0][j] * (((j) & 1) ? bf_hi(zm2.q) : bf_lo(zm2.q)) + w[1][j] * (((j) & 1) ? bf_hi(zm1.q) : bf_lo(zm1.q)) + w[2][j] * (((j) & 1) ? bf_hi(z0.q) : bf_lo(z0.q)))
            o.x = pk2(bf_lo(go.x) * CV(x, 0), bf_hi(go.x) * CV(x, 1)); o.y = pk2(bf_lo(go.y) * CV(y, 2), bf_hi(go.y) * CV(y, 3));
            o.z = pk2(bf_lo(go.z) * CV(z, 4), bf_hi(go.z) * CV(z, 5)); o.w = pk2(bf_lo(go.w) * CV(w, 6), bf_hi(go.w) * CV(w, 7));
#undef CV
            *(v4u*)(A + (size_t)t * DM + c8) = o;
            zm2 = zm1; zm1 = z0;
        }
    }
}
__device__ __forceinline__ void gather_phase(Frame& F, int layer) {
    const int ntile = build_tiles(F, layer);
    const LAS int* tile_e = (const LAS int*)(F.lds + TILE_OFF); const LAS int* tst = (const LAS int*)(F.lds + TST_OFF);
    const int gw = F.vcu * NWAVES + F.wave, NGW = F.G * NWAVES, lane = F.lane;
    const bf16* HN = WSP(bf16, WS_HN); bf16* XS = WSP(bf16, WS_XS);
    for (int r = gw; r < ntile * 256; r += NGW) {
        const int t = r >> 8, e = tile_e[t], pos = r - tst[e] * 256;
        if (pos < tst[32 + e]) { const int tok = WSP(int, WS_SLOT)[e * CAP + pos];
            const v4u* s = (const v4u*)(HN + (size_t)tok * DM) + lane; v4u* d = (v4u*)(XS + (size_t)r * DM) + lane;
            const v4u a = s[0], b = s[64], c = s[128], dd = s[192]; d[0] = a; d[64] = b; d[128] = c; d[192] = dd; }
    }
}

#define IN(k) (lo <= (k) && (k) < hi)
#ifndef EN_MASK
#define EN_MASK 0xFFFF
#endif
#define EN(b) (((EN_MASK) >> (b)) & 1)
#define SEAM(k) do { if (MK_N_LAUNCHES == 1 && IN(k) && IN((k) + 1)) xcd_barrier(bar); } while (0)
template <int layer>
__device__ __forceinline__ void layer_phases(Frame& F, const XcdBarrier& bar, unsigned char* lds, const int lo, const int hi) {
    const unsigned lds32 = (unsigned)(size_t)F.lds;
        const int pb = 1 + 8 * layer;
        if (IN(pb + 0) && EN(1)) {
            if constexpr (layer == 0) {
                pg8::Gemm g{WSP(bf16, WS_HN), WSP(bf16, WS_WCIN), SEQ, 3 * DM, DM}; pg8::StaticOrder S; S.init(SEQ, 3 * DM, F.G, (int)blockIdx.x);
                pg8::EpiConvIn E{WSP(bf16, WS_Z), WSP(bf16, WS_GO)};
                pg8::gemm_phase<pg8::EpiConvIn, pg8::StaticOrder, true, true>(F.lds + RING_OFF, g, S, E);
            } else {
                c_finalize(F);
                pg8::Gemm g{WSP(bf16, WS_HN), WSP(bf16, WS_WAIN), SEQ, 3 * DM, DM}; pg8::StaticOrder S; S.init(SEQ, 3 * DM, F.G, (int)blockIdx.x);
                pg8::EpiQKV E{WSP(bf16, WS_Q), (size_t)(WS_K - WS_Q) / 2};
                pg8::gemm_phase<pg8::EpiQKV, pg8::StaticOrder, true, true>(F.lds + RING_OFF, g, S, E);
            }
        }
        SEAM(pb + 0);
        if (IN(pb + 1)) {
            if constexpr (layer == 0) { if (EN(2)) conv_phase(F); }
            else if (EN(3)) {
                const fox::Bases BS{WSP(fox::bf16, WS_Q), WSP(fox::bf16, WS_K), WSP(fox::bf16, WS_V), WSP(fox::bf16, WS_KX), WSP(fox::bf16, WS_HN)};
                const int total = NH * 32, stride = F.G;
                int L = blockIdx.x;
                if (L < total) {
#define FOX_REF(r, L_, pass_) do { (r).h = (L_) >> 5; (r).qb = (pass_) ? 63 - ((L_) & 31) : ((L_) & 31); (r).jlo = 0; } while (0)
                    fox::BlockRef cur, nxt; int pass = 0; FOX_REF(cur, L, 0);
                    fox::Seam S;
                    fox::fox_prime(BS, cur, (char*)lds + RING_OFF, lds32 + RING_OFF, S);
                    for (;;) {
                        const bool more_pass = pass == 0, more_item = L + stride < total, last = !more_pass && !more_item;
                        int passn = pass + 1, Ln = L;
                        if (!more_pass) { passn = 0; Ln = more_item ? L + stride : L; }
                        if (last) nxt = cur; else FOX_REF(nxt, Ln, passn);
                        fox::fox_block(BS, cur, nxt, (char*)lds + RING_OFF, lds32 + RING_OFF, S);
                        if (last) break;
                        cur = nxt; pass = passn; L = Ln;
                    }
#undef FOX_REF
                }
            }
        }
        SEAM(pb + 1);
        if (IN(pb + 2) && EN(4)) {
            pg8::Gemm g{WSP(bf16, WS_HN), layer == 0 ? WSP(bf16, WS_WCOUT) : WSP(bf16, WS_WAOUT), SEQ, DM, DM}; pg8::StaticOrder S; S.init(SEQ, DM, F.G, (int)blockIdx.x);
            pg8::EpiResF32 E{layer == 0 ? F.x : WSP(float, WS_X), WSP(float, WS_X)};
            pg8::gemm_phase<pg8::EpiResF32, pg8::StaticOrder, true, true>(F.lds + RING_OFF, g, S, E);
        }
        SEAM(pb + 2);
        if (IN(pb + 3) && EN(5)) row_phase<1>(F, layer);
        SEAM(pb + 3);
        if (IN(pb + 4) && EN(6)) gather_phase(F, layer);
        SEAM(pb + 4);
        if (IN(pb + 5) && EN(7)) {
            const int ntile = build_tiles(F, layer);
            pg8::Gemm g{WSP(bf16, WS_XS), WSP(bf16, WS_WGU) + (size_t)layer * 32 * 1024 * 2048, MAXT * 256, 32 * 1024, DM};
            pg8::ExpertOrder S{(const LAS int*)(F.lds + TILE_OFF), ntile * 4, 4, F.G, F.vcu};
            pg8::EpiGateUp E{WSP(bf16, WS_H)};
            pg8::gemm_phase<pg8::EpiGateUp, pg8::ExpertOrder, true, true>(F.lds + RING_OFF, g, S, E);
        }
        SEAM(pb + 5);
        if (IN(pb + 6) && EN(8)) {
            const int ntile = build_tiles(F, layer);
            pg8::Gemm g{WSP(bf16, WS_H), WSP(bf16, WS_WD) + (size_t)layer * 32 * 2048 * 512, MAXT * 256, 32 * 2048, DEXP};
            pg8::ExpertOrder S{(const LAS int*)(F.lds + TILE_OFF), ntile * 8, 8, F.G, F.vcu};
            pg8::EpiDown E{WSP(bf16, WS_XS)};
            pg8::gemm_phase<pg8::EpiDown, pg8::ExpertOrder, true, true>(F.lds + RING_OFF, g, S, E);
        }
        SEAM(pb + 6);
        if (IN(pb + 7) && EN(9)) { if (layer == 0) row_phase<2>(F, 0); else row_phase<3>(F, 1); }
        if (layer == 0) SEAM(pb + 7);
}

struct Args { const float* in[17]; float* out; unsigned char* ws; int ph_lo, ph_hi; };
__global__ void __launch_bounds__(NWAVES * 64, 2) trunk_fwd(Args args) {
    extern __shared__ __attribute__((aligned(16))) unsigned char lds[];
    Frame F;
    F.lds = (LAS unsigned char*)lds;
    F.MISC = (volatile LAS unsigned*)(F.lds + MISC_OFF);
    F.tid = threadIdx.x; F.lane = F.tid & 63; F.wave = __builtin_amdgcn_readfirstlane(F.tid >> 6);
    F.G = gridDim.x; { const int bx = blockIdx.x; F.vcu = (F.G % 8 == 0) ? (bx % 8) * (F.G / 8) + bx / 8 : bx; }
    F.ws = args.ws; F.out = args.out; F.ctl = (gu32*)(args.ws + WS_CTL);
    F.x = args.in[0]; F.mix_norm = args.in[1]; F.ffn_norm = args.in[2]; F.final_norm = args.in[3]; F.conv_w_in = args.in[4]; F.conv_w = args.in[5]; F.conv_w_out = args.in[6];
    F.attn_w_in = args.in[7]; F.attn_b_f = args.in[8]; F.attn_w_out = args.in[9]; F.rg_w = args.in[10]; F.rg_b = args.in[11]; F.re_w = args.in[12]; F.re_b = args.in[13];
    F.w_gate = args.in[14]; F.w_up = args.in[15]; F.w_down = args.in[16];
    if (F.tid < 32) F.MISC[F.tid] = 0u;
    __syncthreads();
    XcdBarrier bar; bar.bar = (unsigned*)(F.ctl + CW_BAR); bar.x = 0; bar.st = nullptr;
    if (MK_N_LAUNCHES == 1) bar = xcd_barrier_post((unsigned*)(F.ctl + CW_BAR), F.MISC + 8);
    const int lo = args.ph_lo, hi = args.ph_hi;

    if (IN(0) && EN(0)) { p0_prologue(F); row_phase<0>(F, 0); }
    SEAM(0);
    layer_phases<0>(F, bar, lds, lo, hi);
    layer_phases<1>(F, bar, lds, lo, hi);
}
#undef IN
#undef SEAM

extern "C" void kernel_launch(void* const* d_in, const int* in_sizes, int n_in, void* d_out, int out_size, void* d_ws, size_t ws_size, hipStream_t stream) {
    static int grid = 0;
    if (grid == 0) {
        if (n_in != 17 || in_sizes[0] != SEQ * DM || out_size != SEQ * DM || ws_size < WS_END) { fprintf(stderr, "kernel_launch: unexpected shapes (n_in %d, in0 %d, out %d, ws %zu < %zu); nothing launched\n", n_in, n_in > 0 ? in_sizes[0] : -1, out_size, ws_size, (size_t)WS_END); grid = -1; return; }
        int dev = 0, cus = 0, per_cu = 0;
        if (hipGetDevice(&dev) != hipSuccess || hipDeviceGetAttribute(&cus, hipDeviceAttributeMultiprocessorCount, dev) != hipSuccess) { fprintf(stderr, "kernel_launch: device query failed\n"); grid = -1; return; }
        if (hipFuncSetAttribute((const void*)trunk_fwd, hipFuncAttributeMaxDynamicSharedMemorySize, LDS_BYTES) != hipSuccess) { fprintf(stderr, "kernel_launch: hipFuncSetAttribute failed\n"); grid = -1; return; }
        if (hipOccupancyMaxActiveBlocksPerMultiprocessor(&per_cu, (const void*)trunk_fwd, NWAVES * 64, LDS_BYTES) != hipSuccess || per_cu < 1) { fprintf(stderr, "kernel_launch: occupancy query reports %d workgroups per CU\n", per_cu); (void)hipGetLastError(); grid = -1; return; }
        grid = cus;
    }
    if (grid < 0) return;
    if (hipMemsetAsync((char*)d_ws + WS_CTL, 0, CTL_ZERO_BYTES, stream) != hipSuccess) { fprintf(stderr, "kernel_launch: hipMemsetAsync failed\n"); return; }
    Args a{};
    for (int i = 0; i < 17; ++i) a.in[i] = (const float*)d_in[i];
    a.out = (float*)d_out; a.ws = (unsigned char*)d_ws;
#if MK_N_LAUNCHES == 1
    a.ph_lo = 0; a.ph_hi = N_PHASES;
    hipLaunchKernelGGL(trunk_fwd, dim3(grid), dim3(NWAVES * 64), LDS_BYTES, stream, a);
#else
    for (int p = 0; p < N_PHASES; ++p) { a.ph_lo = p; a.ph_hi = p + 1; hipLaunchKernelGGL(trunk_fwd, dim3(grid), dim3(NWAVES * 64), LDS_BYTES, stream, a); }
#endif
    const hipError_t le = hipPeekAtLastError();
    if (le != hipSuccess) fprintf(stderr, "kernel_launch: launch failed: %s\n", hipGetErrorName(le));
}
```

```cpp
#include <hip/hip_runtime.h>
#include <cstdio>
#include <cstdint>

constexpr int SEQ = 16384, DM = 2048, NH = 16, HD = 128, NEXP = 32, NGRP = 4, EPG = 8, DEXP = 512;
constexpr float RMS_EPS = 1e-6f;
constexpr int CAP = SEQ;
constexpr int MAXT = 160;

namespace pg8 {
#define PG8_LAS __attribute__((address_space(3)))
typedef unsigned short bf16_t;
typedef short bf16x8 __attribute__((ext_vector_type(8)));
typedef float f32x4 __attribute__((ext_vector_type(4)));
typedef unsigned u32x4 __attribute__((ext_vector_type(4)));
constexpr int BM = 256, BK = 64, HALF = 128, HTB = HALF * BK * 2  , STAGE_BYTES = 8 * HTB, NXCD = 8, WGM = 8;

__host__ __device__ __forceinline__ int lds_byte(int r, int c) { const int st = (r >> 4) * 2 + (c >> 5), rr = r & 15, cc = c & 31, ob = rr * 64 + cc * 2; return st * 1024 + (ob ^ (((ob >> 9) & 1) << 5)); }
__host__ __device__ __forceinline__ void stage_rc(int b, int& R, int& C) { const int st = b / 1024, sb = b % 1024, swz = sb ^ (((sb >> 9) & 1) << 5); R = (st >> 1) * 16 + swz / 64; C = (st & 1) * 32 + (swz % 64) / 2; }
__host__ __device__ __forceinline__ int perm32(int rho) { const int n = rho >> 4, i = rho & 15; return 8 * (i >> 2) + 4 * n + (i & 3); }

struct Unit { int pm, pn; };
struct Gemm { const bf16_t* A; const bf16_t* Bt; int M, N, K; };

struct StaticOrder {
    int nM, nN, nwg, G, c;
    __host__ __device__ void init(int M, int N, int G_, int c_) { nM = M / BM; nN = N / BM; nwg = nM * nN; G = G_; c = c_; }
    __host__ __device__ bool next(int i, Unit& u) const {
        const long L = (long)i * G + c; if (L >= nwg) return false;
        int wgid = (int)L; { const int q = nwg / NXCD, r = nwg % NXCD, xcd = wgid % NXCD, off = wgid / NXCD; wgid = (xcd < r ? xcd * (q + 1) : r * (q + 1) + (xcd - r) * q) + off; }
        const int nig = WGM * nN, gid = wgid / nig, fm = gid * WGM, gsz = (nM - fm) < WGM ? (nM - fm) : WGM;
        u.pm = fm + ((wgid % nig) % gsz); u.pn = (wgid % nig) / gsz; return true;
    }
    __device__ __forceinline__ void a_ready(const Unit&) const {}
    __device__ __forceinline__ void done(const Unit&) const {}
};
__device__ __forceinline__ unsigned cvt_pk_bf16(float lo, float hi) { unsigned r; asm volatile("v_cvt_pk_bf16_f32 %0, %1, %2" : "=v"(r) : "v"(lo), "v"(hi)); return r; }
__device__ __forceinline__ u32x4 pack8(f32x4 v0, f32x4 v1) { u32x4 w; w.x = cvt_pk_bf16(v0[0], v0[1]); w.y = cvt_pk_bf16(v0[2], v0[3]); w.z = cvt_pk_bf16(v1[0], v1[1]); w.w = cvt_pk_bf16(v1[2], v1[3]); return w; }
__device__ __forceinline__ float silu_f(float g) { return g * __builtin_amdgcn_rcpf(1.0f + __builtin_amdgcn_exp2f(g * -1.4426950408889634f)); }

struct EpiConvIn {
    static constexpr bool PERM = true, AFTER_DRAIN = false;
    bf16_t* Z; bf16_t* GO;
    __device__ __forceinline__ void operator()(const f32x4 (&acc)[2][2][4][2], const Unit& u, int wr, int wc, int fr, int fq) const {
        const int row0 = u.pm * BM + wr * 64 + fr;
        if (u.pn < 16) {
            const int col0 = u.pn * 128 + wc * 32 + 8 * fq;
#pragma unroll
            for (int ai = 0; ai < 2; ++ai)
#pragma unroll
                for (int m = 0; m < 4; ++m) { bf16_t* rowp = Z + (size_t)(row0 + ai * HALF + m * 16) * 2048 + col0;
                    *(u32x4*)rowp = pack8(acc[ai][0][m][0] * acc[ai][1][m][0], acc[ai][0][m][1] * acc[ai][1][m][1]); }
        } else {
            const int col0 = (u.pn - 16) * 256 + wc * 32 + 8 * fq;
#pragma unroll
            for (int ai = 0; ai < 2; ++ai)
#pragma unroll
                for (int m = 0; m < 4; ++m) { bf16_t* rowp = GO + (size_t)(row0 + ai * HALF + m * 16) * 2048 + col0;
#pragma unroll
                    for (int bj = 0; bj < 2; ++bj) *(u32x4*)(rowp + bj * HALF) = pack8(acc[ai][bj][m][0], acc[ai][bj][m][1]); }
        }
    }
};
struct EpiResF32 {
    static constexpr bool PERM = false, AFTER_DRAIN = false;
    const float* R; float* C;
    __device__ __forceinline__ void operator()(const f32x4 (&acc)[2][2][4][2], const Unit& u, int wr, int wc, int fr, int fq) const {
        const int row0 = u.pm * BM + wr * 64 + fr, col0 = u.pn * BM + wc * 32 + 4 * fq;
#pragma unroll
        for (int ai = 0; ai < 2; ++ai)
#pragma unroll
            for (int m = 0; m < 4; ++m) { const size_t ro = (size_t)(row0 + ai * HALF + m * 16) * 2048 + col0;
#pragma unroll
                for (int bj = 0; bj < 2; ++bj)
#pragma unroll
                    for (int n = 0; n < 2; ++n) { const size_t o = ro + bj * HALF + n * 16; *(f32x4*)(C + o) = *(const f32x4*)(R + o) + acc[ai][bj][m][n]; } }
    }
};
struct EpiGateUp {
    static constexpr bool PERM = true, AFTER_DRAIN = false;
    bf16_t* H;
    __device__ __forceinline__ void operator()(const f32x4 (&acc)[2][2][4][2], const Unit& u, int wr, int wc, int fr, int fq) const {
        const int row0 = u.pm * BM + wr * 64 + fr, col0 = (u.pn & 3) * 128 + wc * 32 + 8 * fq;
#pragma unroll
        for (int ai = 0; ai < 2; ++ai)
#pragma unroll
            for (int m = 0; m < 4; ++m) { bf16_t* rowp = H + (size_t)(row0 + ai * HALF + m * 16) * 512 + col0;
                f32x4 v0, v1;
#pragma unroll
                for (int j = 0; j < 4; ++j) { v0[j] = silu_f(acc[ai][0][m][0][j]) * acc[ai][1][m][0][j]; v1[j] = silu_f(acc[ai][0][m][1][j]) * acc[ai][1][m][1][j]; }
                *(u32x4*)rowp = pack8(v0, v1); }
    }
};
struct EpiDown {
    static constexpr bool PERM = true, AFTER_DRAIN = false;
    bf16_t* O;
    __device__ __forceinline__ void operator()(const f32x4 (&acc)[2][2][4][2], const Unit& u, int wr, int wc, int fr, int fq) const {
        const int row0 = u.pm * BM + wr * 64 + fr, col0 = (u.pn & 7) * 256 + wc * 32 + 8 * fq;
#pragma unroll
        for (int ai = 0; ai < 2; ++ai)
#pragma unroll
            for (int m = 0; m < 4; ++m) { bf16_t* rowp = O + (size_t)(row0 + ai * HALF + m * 16) * 2048 + col0;
#pragma unroll
                for (int bj = 0; bj < 2; ++bj) *(u32x4*)(rowp + bj * HALF) = pack8(acc[ai][bj][m][0], acc[ai][bj][m][1]); }
    }
};
struct EpiQKV {
    static constexpr bool PERM = true, AFTER_DRAIN = false;
    bf16_t* Q; size_t tstride; float* NB;
    __device__ __forceinline__ void operator()(const f32x4 (&acc)[2][2][4][2], const Unit& u, int wr, int wc, int fr, int fq) const {
        const int which = u.pn >> 3, hp = u.pn & 7; bf16_t* base = Q + (size_t)which * tstride;
        const int row0 = u.pm * BM + wr * 64 + fr, col0 = wc * 32 + 8 * fq;
#pragma unroll
        for (int bj = 0; bj < 2; ++bj) { bf16_t* hb = base + (size_t)(2 * hp + bj) * SEQ * 128 + col0;
            float pmx = 0.f;
#pragma unroll
            for (int ai = 0; ai < 2; ++ai)
#pragma unroll
                for (int m = 0; m < 4; ++m) { const f32x4 a = acc[ai][bj][m][0], b = acc[ai][bj][m][1];
                    *(u32x4*)(hb + (size_t)(row0 + ai * HALF + m * 16) * 128) = pack8(a, b);
                    if (which < 2) { float p = (a[0] * a[0] + a[1] * a[1]) + (a[2] * a[2] + a[3] * a[3]) + (b[0] * b[0] + b[1] * b[1]) + (b[2] * b[2] + b[3] * b[3]);
                        p += __shfl_xor(p, 16); p += __shfl_xor(p, 32); pmx = fmaxf(pmx, p); } }
            if (which < 2) {
#pragma unroll
                for (int o = 1; o < 16; o <<= 1) pmx = fmaxf(pmx, __shfl_xor(pmx, o));
                if (fr == 0 && fq == 0) NB[((which * 16 + 2 * hp + bj) * 64 + u.pm) * 8 + wr * 4 + wc] = pmx; }
        }
    }
};
struct ExpertOrder {
    const PG8_LAS int* tile_e; int n_units, nN, G, c;
    __device__ __forceinline__ bool next(int i, Unit& u) const {
        const int L = i * G + c; if (L >= n_units) return false;
        const int t = L / nN, j = L - t * nN; u.pm = t; u.pn = tile_e[t] * nN + j; return true;
    }
    __device__ __forceinline__ void a_ready(const Unit&) const {}
    __device__ __forceinline__ void done(const Unit&) const {}
};

template <class Epi, class Sched, bool ALIGN_EPI = false, bool SP2 = false>
__device__ __forceinline__ void gemm_phase(PG8_LAS unsigned char* lds, const Gemm g, const Sched& S, const Epi& E) {
    const int tid = threadIdx.x, wid = __builtin_amdgcn_readfirstlane(tid >> 6), lane = tid & 63, wr = wid >> 2, wc = wid & 3, fr = lane & 15, fq = lane >> 4;
    const int K = g.K, nt = K / BK;
    unsigned voffA[2], voffB[2];
#pragma unroll
    for (int i = 0; i < 2; ++i) { int R, C; stage_rc(tid * 16 + i * 8192, R, C); const int Rb = Epi::PERM ? ((R & ~31) + perm32(R & 31)) : R;
        voffA[i] = (unsigned)(R * K + C) * 2u; voffB[i] = (unsigned)(Rb * K + C) * 2u; }
    const size_t kstep = (size_t)(BK * 2);
    const size_t hstep = (size_t)HALF * K * 2;
    const size_t tstep = 2 * hstep;
    const unsigned ldsw = (unsigned)wid * 1024u;
    const int aoff = lds_byte(wr * 64 + fr, fq * 8), boff = lds_byte(wc * 32 + fr, fq * 8);
#define PG8_SA(b, h) (((b) * 2 + (h)) * HTB)
#define PG8_SB(b, h) ((4 + (b) * 2 + (h)) * HTB)
#define PG8_STAGE(bufoff, gbase, voff) do { _Pragma("unroll") for (int _i = 0; _i < 2; ++_i) \
        __builtin_amdgcn_global_load_lds((const unsigned*)((const char*)(gbase) + (voff)[_i]), (PG8_LAS unsigned*)(lds + (bufoff) + ldsw + _i * 8192), 16, 0, 0); } while (0)
#define PG8_LDA(dst, b, h) do { _Pragma("unroll") for (int m = 0; m < 4; ++m) _Pragma("unroll") for (int k = 0; k < 2; ++k) dst[m][k] = *(const PG8_LAS bf16x8*)(lds + PG8_SA(b, h) + aoff + m * 2048 + k * 1024); } while (0)
#define PG8_LDB(dst, b, h) do { _Pragma("unroll") for (int n = 0; n < 2; ++n) _Pragma("unroll") for (int k = 0; k < 2; ++k) dst[n][k] = *(const PG8_LAS bf16x8*)(lds + PG8_SB(b, h) + boff + n * 2048 + k * 1024); } while (0)
#define PG8_MMA(ai, bj, At, Bt) do { __builtin_amdgcn_s_setprio(1); _Pragma("unroll") for (int m = 0; m < 4; ++m) _Pragma("unroll") for (int n = 0; n < 2; ++n) _Pragma("unroll") for (int k = 0; k < 2; ++k) \
        acc[ai][bj][m][n] = __builtin_amdgcn_mfma_f32_16x16x32_bf16(Bt[n][k], At[m][k], acc[ai][bj][m][n], 0, 0, 0); __builtin_amdgcn_s_setprio(0); } while (0)
#define PG8_WAIT_V(n) asm volatile("s_waitcnt vmcnt(" #n ")" ::: "memory")
#define PG8_WAIT_L(n) asm volatile("s_waitcnt lgkmcnt(" #n ")" ::: "memory")
#define PG8_BAR __builtin_amdgcn_s_barrier()
#define PG8_SCHED __builtin_amdgcn_sched_barrier(0)
    Unit cur, nxt; int ui = 0;
    if (!S.next(0, cur)) return;
    f32x4 acc[2][2][4][2];
#pragma unroll
    for (int a = 0; a < 2; ++a)
#pragma unroll
        for (int b = 0; b < 2; ++b)
#pragma unroll
            for (int m = 0; m < 4; ++m)
#pragma unroll
                for (int n = 0; n < 2; ++n) acc[a][b][m][n] = (f32x4){0.f, 0.f, 0.f, 0.f};
    bf16x8 At[4][2], B0[2][2], B1[2][2];
    const char* cA = (const char*)g.A + (size_t)cur.pm * tstep; const char* cB = (const char*)g.Bt + (size_t)cur.pn * tstep;
    S.a_ready(cur);
    if constexpr (SP2) {
        PG8_STAGE(PG8_SB(0, 0), cB, voffB); PG8_STAGE(PG8_SB(0, 1), cB + hstep, voffB); PG8_STAGE(PG8_SA(0, 0), cA, voffA); PG8_STAGE(PG8_SA(0, 1), cA + hstep, voffA);
        if (wr == 1) PG8_BAR;
        PG8_WAIT_V(2); PG8_BAR;
        PG8_STAGE(PG8_SB(1, 0), cB + kstep, voffB); PG8_STAGE(PG8_SA(1, 0), cA + kstep, voffA); PG8_STAGE(PG8_SB(1, 1), cB + hstep + kstep, voffB);
        PG8_WAIT_V(6); PG8_BAR;
    } else {
        PG8_STAGE(PG8_SB(0, 0), cB, voffB); PG8_STAGE(PG8_SA(0, 0), cA, voffA); PG8_STAGE(PG8_SB(0, 1), cB + hstep, voffB); PG8_STAGE(PG8_SA(0, 1), cA + hstep, voffA);
        if (wr == 1) PG8_BAR;
        PG8_WAIT_V(4); PG8_BAR;
        PG8_STAGE(PG8_SB(1, 0), cB + kstep, voffB); PG8_STAGE(PG8_SA(1, 0), cA + kstep, voffA); PG8_STAGE(PG8_SB(1, 1), cB + hstep + kstep, voffB);
        PG8_WAIT_V(6); PG8_BAR;
    }
    for (;;) {
        const bool has_next = S.next(ui + 1, nxt);
        const char* nA = has_next ? (const char*)g.A + (size_t)nxt.pm * tstep : cA; const char* nB = has_next ? (const char*)g.Bt + (size_t)nxt.pn * tstep : cB;
        for (int t = 0; t < nt; t += 2) {
            const bool last = (t == nt - 2);
            const char* a1 = cA + (size_t)(t + 1) * kstep;
            const char* a2 = last ? nA : cA + (size_t)(t + 2) * kstep; const char* b2 = last ? nB : cB + (size_t)(t + 2) * kstep;
            const char* a3 = a2 + kstep; const char* b3 = b2 + kstep;
            if (last && has_next) S.a_ready(nxt);
            if constexpr (SP2) {
            PG8_LDB(B0, 0, 0); PG8_LDB(B1, 0, 1); PG8_SCHED; PG8_LDA(At, 0, 0); PG8_STAGE(PG8_SA(1, 1), a1 + hstep, voffA);
            PG8_WAIT_V(8); PG8_WAIT_L(0); PG8_BAR; PG8_MMA(0, 0, At, B0); PG8_MMA(0, 1, At, B1); PG8_BAR; PG8_SCHED;
            PG8_LDA(At, 0, 1); PG8_STAGE(PG8_SB(0, 0), b2, voffB); PG8_STAGE(PG8_SB(0, 1), b2 + hstep, voffB); PG8_STAGE(PG8_SA(0, 0), a2, voffA);
            PG8_WAIT_V(8); PG8_WAIT_L(0); PG8_BAR; PG8_MMA(1, 0, At, B0); PG8_MMA(1, 1, At, B1); PG8_BAR; PG8_SCHED;
            PG8_LDB(B0, 1, 0); PG8_LDB(B1, 1, 1); PG8_SCHED; PG8_LDA(At, 1, 0); PG8_STAGE(PG8_SA(0, 1), a2 + hstep, voffA);
            PG8_WAIT_V(8); PG8_WAIT_L(0); PG8_BAR; PG8_MMA(0, 0, At, B0); PG8_MMA(0, 1, At, B1); PG8_BAR; PG8_SCHED;
            PG8_LDA(At, 1, 1); PG8_STAGE(PG8_SB(1, 0), b3, voffB); PG8_STAGE(PG8_SB(1, 1), b3 + hstep, voffB); PG8_STAGE(PG8_SA(1, 0), a3, voffA);
            PG8_WAIT_V(8); PG8_WAIT_L(0); PG8_BAR; PG8_MMA(1, 0, At, B0); PG8_MMA(1, 1, At, B1); PG8_BAR; PG8_SCHED;
            } else {
            PG8_LDB(B0, 0, 0); PG8_SCHED; PG8_LDA(At, 0, 0); PG8_STAGE(PG8_SA(1, 1), a1 + hstep, voffA);
            PG8_WAIT_L(8); PG8_BAR; PG8_WAIT_L(0); PG8_MMA(0, 0, At, B0); PG8_BAR; PG8_SCHED;
            PG8_LDB(B1, 0, 1); PG8_STAGE(PG8_SB(0, 0), b2, voffB);
            PG8_BAR; PG8_WAIT_L(0); PG8_MMA(0, 1, At, B1); PG8_BAR;
            PG8_LDA(At, 0, 1); PG8_STAGE(PG8_SA(0, 0), a2, voffA);
            PG8_BAR; PG8_WAIT_L(0); PG8_MMA(1, 0, At, B0); PG8_BAR; PG8_SCHED;
            PG8_STAGE(PG8_SB(0, 1), b2 + hstep, voffB);
            PG8_WAIT_V(6); PG8_BAR; PG8_MMA(1, 1, At, B1); PG8_BAR;
            PG8_LDB(B0, 1, 0); PG8_SCHED; PG8_LDA(At, 1, 0); PG8_STAGE(PG8_SA(0, 1), a2 + hstep, voffA);
            PG8_WAIT_L(8); PG8_BAR; PG8_WAIT_L(0); PG8_MMA(0, 0, At, B0); PG8_BAR; PG8_SCHED;
            PG8_LDB(B1, 1, 1); PG8_STAGE(PG8_SB(1, 0), b3, voffB);
            PG8_BAR; PG8_WAIT_L(0); PG8_MMA(0, 1, At, B1); PG8_BAR;
            PG8_LDA(At, 1, 1); PG8_STAGE(PG8_SA(1, 0), a3, voffA);
            PG8_BAR; PG8_WAIT_L(0); PG8_MMA(1, 0, At, B0); PG8_BAR; PG8_SCHED;
            PG8_STAGE(PG8_SB(1, 1), b3 + hstep, voffB);
            PG8_WAIT_V(6); PG8_BAR; PG8_MMA(1, 1, At, B1); PG8_BAR;
            }
        }
        if constexpr (ALIGN_EPI) { if (wr == 0) PG8_BAR; }
        if constexpr (!Epi::AFTER_DRAIN) { E(acc, cur, wr, wc, fr, fq); S.done(cur); }
        if (!has_next) break;
#pragma unroll
        for (int a = 0; a < 2; ++a)
#pragma unroll
            for (int b = 0; b < 2; ++b)
#pragma unroll
                for (int m = 0; m < 4; ++m)
#pragma unroll
                    for (int n = 0; n < 2; ++n) acc[a][b][m][n] = (f32x4){0.f, 0.f, 0.f, 0.f};
        cur = nxt; cA = nA; cB = nB; ++ui;
        if constexpr (ALIGN_EPI) { if (wr == 1) PG8_BAR; }
    }
    PG8_WAIT_V(0);
    if constexpr (!ALIGN_EPI) { if (wr == 0) PG8_BAR; }
    PG8_BAR;
    if constexpr (Epi::AFTER_DRAIN) { E.fused(acc, cur, wr, wc, fr, fq, lds, wid, lane); S.done(cur); }
#undef PG8_SA
#undef PG8_SB
#undef PG8_STAGE
#undef PG8_LDA
#undef PG8_LDB
#undef PG8_MMA
#undef PG8_WAIT_V
#undef PG8_WAIT_L
#undef PG8_BAR
#undef PG8_SCHED
}
}
namespace fox {
#define FOX_LAS __attribute__((address_space(3)))
typedef unsigned short bf16;
typedef short bf16x8 __attribute__((ext_vector_type(8)));
typedef short s16x4 __attribute__((ext_vector_type(4)));
typedef float f32x16 __attribute__((ext_vector_type(16)));
typedef float f32x4 __attribute__((ext_vector_type(4)));
typedef unsigned u32x4 __attribute__((ext_vector_type(4)));
constexpr int D = 128, OPITCH = 2048;
constexpr float SCALE = 0.08838834764831845f;
constexpr float THR = 8.f;
constexpr int NW = 8, QBLK = 32, KVBLK = 64, QB = NW * QBLK;
constexpr int SHM_V = KVBLK * D * 2, SHM_K = KVBLK * D * 2, SHM_X = KVBLK * 4;
constexpr int JLO_OFF = 73728, KN2_OFF = JLO_OFF + 2048, NXT_OFF = KN2_OFF + 4096;
constexpr int LDS_WS_OFF = 2 * SHM_V + 2 * SHM_K, LDS_X_OFF = LDS_WS_OFF + NW * 64 * 4, LDS_BYTES = LDS_X_OFF + 2 * SHM_X;

#define KSWZ(row, colB) ((row) * 256 + ((colB) ^ (((row) & 7) << 4)))
#define SBAR() __builtin_amdgcn_sched_barrier(0)
__device__ __forceinline__ int v_st(int k, int c) { const int kk = (k & ~0xC) | ((k & 4) << 1) | ((k & 8) >> 1); return ((kk >> 3) * 4 + (c >> 5)) * 512 + ((kk & 7) * 32 + (c & 31)) * 2; }
__device__ __forceinline__ int v_rd_base(int lane) { return ((lane & 3) << 3) | (((lane >> 2) & 3) << 6) | (((lane >> 4) & 1) << 5) | (((lane >> 5) & 1) << 8); }
constexpr int v_rd_off(int d0, int ks, int half) { return d0 * 512 + ks * 4096 + half * 2048; }
__device__ __forceinline__ int crow(int r, int hi) { return (r & 3) + 8 * (r >> 2) + 4 * hi; }
__device__ __forceinline__ unsigned cvtpk(float lo, float hi) { unsigned r; asm volatile("v_cvt_pk_bf16_f32 %0, %1, %2" : "=v"(r) : "v"(lo), "v"(hi)); return r; }
__device__ __forceinline__ bf16x8 load8(const bf16* p) { return *reinterpret_cast<const bf16x8*>(p); }
__device__ __forceinline__ void glds4(const void* gsrc, unsigned lds_dst) { unsigned keep;
    asm volatile("s_mov_b32 %0, m0\n\ts_mov_b32 m0, %2\n\ts_nop 0\n\tglobal_load_lds_dword %1, off\n\ts_mov_b32 m0, %0" : "=&s"(keep) : "v"(gsrc), "s"(lds_dst) : "memory"); }
__device__ __forceinline__ void mask_tile(f32x16& p0, f32x16& p1, int dq) {
    const float NEG = -__builtin_inff();
#pragma unroll
    for (int r = 0; r < 16; ++r) {
        const int c = (r & 3) + 8 * (r >> 2);
        if (dq - c < 0) p0[r] = NEG;
        if (dq - c - 32 < 0) p1[r] = NEG;
    }
}
__device__ __forceinline__ void partialSM(f32x16& p0, f32x16& p1, float& m_reg, float& mn, float& alpha) {
    float pmax = p0[0]; for (int r = 1; r < 16; ++r) pmax = fmaxf(pmax, p0[r]); for (int r = 0; r < 16; ++r) pmax = fmaxf(pmax, p1[r]);
    { auto rr = __builtin_amdgcn_permlane32_swap(__float_as_uint(pmax), __float_as_uint(pmax), false, false);
      pmax = fmaxf(__uint_as_float(rr[0]), __uint_as_float(rr[1])); }
    constexpr float C2 = 1.4426950408889634f * SCALE;
    if (__builtin_expect(__all((pmax - m_reg) * SCALE <= THR), 1)) { mn = m_reg; alpha = 1.f; }
    else { mn = fmaxf(m_reg, pmax); alpha = __builtin_amdgcn_exp2f((m_reg - mn) * C2); m_reg = mn; }
    const float mnL = -mn * C2;
    for (int r = 0; r < 16; ++r) p0[r] = fmaf(p0[r], C2, mnL); for (int r = 0; r < 16; ++r) p1[r] = fmaf(p1[r], C2, mnL);
    for (int r = 0; r < 16; ++r) p0[r] = __builtin_amdgcn_exp2f(p0[r]);
}
__device__ __forceinline__ void finishSM(f32x16& p0, f32x16& p1, float alpha, float& l_reg, bf16x8& pa0, bf16x8& pa1, bf16x8& pa2, bf16x8& pa3) {
    for (int r = 0; r < 16; ++r) p1[r] = __builtin_amdgcn_exp2f(p1[r]);
    float ps = 0; for (int r = 0; r < 16; ++r) ps += p0[r]; for (int r = 0; r < 16; ++r) ps += p1[r];
    { auto rr = __builtin_amdgcn_permlane32_swap(__float_as_uint(ps), __float_as_uint(ps), false, false);
      ps = __uint_as_float(rr[0]) + __uint_as_float(rr[1]); }
    l_reg = l_reg * alpha + ps;
#define PK4(P, B_, OUT) do { unsigned a0 = cvtpk(P[B_+0], P[B_+1]), a1 = cvtpk(P[B_+2], P[B_+3]);                          \
        unsigned b0 = cvtpk(P[B_+4], P[B_+5]), b1 = cvtpk(P[B_+6], P[B_+7]);                                             \
        auto r0 = __builtin_amdgcn_permlane32_swap(a0, b0, false, false); auto r1 = __builtin_amdgcn_permlane32_swap(a1, b1, false, false); \
        u32x4 w = {r0[0], r1[0], r0[1], r1[1]}; OUT = *reinterpret_cast<bf16x8*>(&w); } while (0)
    PK4(p0, 0, pa0); PK4(p0, 8, pa1); PK4(p1, 0, pa2); PK4(p1, 8, pa3);
#undef PK4
}
template <int KB>
__device__ __forceinline__ void qkt(f32x16& p0, f32x16& p1, const char* K_lds, const char* X_lds, int r32, int hi, const bf16x8* qr) {
    { const char* xb = X_lds + KB * SHM_X + hi * 16;
#pragma unroll
      for (int g = 0; g < 4; ++g) { const f32x4 a = *reinterpret_cast<const f32x4*>(xb + g * 32), b = *reinterpret_cast<const f32x4*>(xb + 128 + g * 32);
          p0[4 * g] = a[0]; p0[4 * g + 1] = a[1]; p0[4 * g + 2] = a[2]; p0[4 * g + 3] = a[3]; p1[4 * g] = b[0]; p1[4 * g + 1] = b[1]; p1[4 * g + 2] = b[2]; p1[4 * g + 3] = b[3]; } }
    const char* kb[4];
#pragma unroll
    for (int dd = 0; dd < 4; ++dd) kb[dd] = K_lds + KB * SHM_K + KSWZ(r32, (dd * 16 + hi * 8) * 2);
#pragma unroll
    for (int d0 = 0; d0 < 8; ++d0) { const char* a = kb[d0 & 3] + (d0 >> 2) * 128;
        bf16x8 b0 = *reinterpret_cast<const bf16x8*>(a);
        bf16x8 b1 = *reinterpret_cast<const bf16x8*>(a + 32 * 256);
        p0 = __builtin_amdgcn_mfma_f32_32x32x16_bf16(b0, qr[d0], p0, 0, 0, 0);
        p1 = __builtin_amdgcn_mfma_f32_32x32x16_bf16(b1, qr[d0], p1, 0, 0, 0); }
}
template <int VB>
__device__ __forceinline__ void pv_tile(f32x16* o, int vb0, bf16x8 pa0, bf16x8 pa1, bf16x8 pa2, bf16x8 pa3) {
#define TRRD(dst, off) asm volatile("ds_read_b64_tr_b16 %0, %1 offset:%2" : "=&v"(dst) : "v"(vb0), "i"(off) : "memory")
#define PV_D0(d0) do { s16x4 l0, l1, l2, l3, h0, h1, h2, h3; constexpr int b_ = VB * SHM_V + v_rd_off(d0, 0, 0);     \
        TRRD(l0, b_); TRRD(h0, b_ + 2048); TRRD(l1, b_ + 4096); TRRD(h1, b_ + 6144); TRRD(l2, b_ + 8192); TRRD(h2, b_ + 10240); TRRD(l3, b_ + 12288); TRRD(h3, b_ + 14336); \
        asm volatile("s_waitcnt lgkmcnt(0)" ::: "memory"); SBAR();                                                        \
        o[d0] = __builtin_amdgcn_mfma_f32_32x32x16_bf16(pa0, (bf16x8){l0[0], l0[1], l0[2], l0[3], h0[0], h0[1], h0[2], h0[3]}, o[d0], 0, 0, 0);   \
        o[d0] = __builtin_amdgcn_mfma_f32_32x32x16_bf16(pa1, (bf16x8){l1[0], l1[1], l1[2], l1[3], h1[0], h1[1], h1[2], h1[3]}, o[d0], 0, 0, 0);   \
        o[d0] = __builtin_amdgcn_mfma_f32_32x32x16_bf16(pa2, (bf16x8){l2[0], l2[1], l2[2], l2[3], h2[0], h2[1], h2[2], h2[3]}, o[d0], 0, 0, 0);   \
        o[d0] = __builtin_amdgcn_mfma_f32_32x32x16_bf16(pa3, (bf16x8){l3[0], l3[1], l3[2], l3[3], h3[0], h3[1], h3[2], h3[3]}, o[d0], 0, 0, 0); } while (0)
    PV_D0(0); PV_D0(1); PV_D0(2); PV_D0(3);
#undef PV_D0
#undef TRRD
}
struct Bases { const bf16* Q; const bf16* K; const bf16* V; const float* KX; bf16* O; };
struct BlockRef { int h, qb, jlo; };
constexpr int SEQL = 16384;
#define REF_Q(B_, r) ((B_).Q + ((size_t)(r).h * SEQL + (size_t)(r).qb * QB) * D)
#define REF_K(B_, r) ((B_).K + (size_t)(r).h * SEQL * D)
#define REF_V(B_, r) ((B_).V + (size_t)(r).h * SEQL * D)
#define REF_X(B_, r) ((B_).KX + (size_t)(r).h * SEQL)
#define REF_O(B_, r) ((B_).O + (size_t)(r).qb * QB * OPITCH + (r).h * D)
struct Seam { bf16x8 qr[8]; bf16x8 st_v0, st_v1, st_k0, st_k1; };
#define ROW(p, k0, rr) ((p) + (size_t)((k0) + (rr)) * D + sc)
#define VMW() asm volatile("s_waitcnt vmcnt(0)" ::: "memory")
#define VMWN(n) asm volatile("s_waitcnt vmcnt(%0)" :: "i"(n) : "memory")
#define SLOAD_H(Kp, Vp, k0) do { S.st_v0 = load8(ROW(Vp, k0, sr)); S.st_v1 = load8(ROW(Vp, k0, 32 + sr));              \
                         S.st_k0 = load8(ROW(Kp, k0, sr)); S.st_k1 = load8(ROW(Kp, k0, 32 + sr)); } while (0)
#define XDMA(Xp, k0, bf) do { if (wid == 0) glds4((Xp) + (k0) + lane, x_l32 + (bf) * SHM_X); } while (0)
#define SWRITE_HK(bf) do { int tz_ = threadIdx.x; asm volatile("" : "+v"(tz_)); const int kws_ = KSWZ(tz_ >> 4, (tz_ & 15) * 16);                                   \
        *(bf16x8*)(K_lds + (bf) * SHM_K + kws_) = S.st_k0; *(bf16x8*)(K_lds + (bf) * SHM_K + kws_ + 32 * 256) = S.st_k1; } while (0)
#define SWRITE_HV(bf) do { int tz_ = threadIdx.x; asm volatile("" : "+v"(tz_)); const int sr_ = tz_ >> 4, sc_ = (tz_ & 15) * 8;                                      \
        *(bf16x8*)(V_lds + (bf) * SHM_V + v_st(sr_, sc_)) = S.st_v0; *(bf16x8*)(V_lds + (bf) * SHM_V + v_st(32 + sr_, sc_)) = S.st_v1; } while (0)
#define SWRITE_H(bf) do { SWRITE_HV(bf); SWRITE_HK(bf); } while (0)
__device__ __forceinline__ void fox_prime(const Bases& BS, const BlockRef& cur, char* lds, unsigned lds32, Seam& S) {
    const int tid = threadIdx.x, wid = __builtin_amdgcn_readfirstlane(tid >> 6), lane = tid & 63, r32 = lane & 31, hi = lane >> 5;
    const int sr = tid >> 4, sc = (tid & 15) * 8; char* K_lds = lds + 2 * SHM_V; const unsigned x_l32 = lds32 + LDS_X_OFF;
    const int kb0 = cur.jlo * KVBLK;
    for (int d0 = 0; d0 < 8; ++d0) S.qr[d0] = load8(REF_Q(BS, cur) + (size_t)(wid * QBLK + r32) * D + d0 * 16 + hi * 8);
    SLOAD_H(REF_K(BS, cur), REF_V(BS, cur), kb0); XDMA(REF_X(BS, cur), kb0, 0); VMW(); SWRITE_HK(0);
    __syncthreads();
}
__device__ __forceinline__ void fox_block(const Bases& BS, const BlockRef& cur, char* lds, unsigned lds32, Seam& S, BlockRef& nxo) {
    const int tid = threadIdx.x, wid = __builtin_amdgcn_readfirstlane(tid >> 6), lane = tid & 63, r32 = lane & 31, hi = lane >> 5;
    const int j_lo = cur.jlo;
    const int P0 = cur.qb * QB;
    const int j_hi = (P0 + QB - 1) / KVBLK + 1;
    const int NT = j_hi - j_lo;
    const int qlo = P0 + wid * QBLK, qm = qlo + r32 - 4 * hi;
    char* V_lds = lds; char* K_lds = lds + 2 * SHM_V; const char* X_lds = lds + LDS_X_OFF; const unsigned x_l32 = lds32 + LDS_X_OFF;
    float* ws = (float*)(lds + LDS_WS_OFF) + wid * 64; float* li_l = ws, * al_l = ws + 32;
    float m_reg = -1e30f, l_reg = 0; f32x16 o[4] = {};
    const int sr = tid >> 4, sc = (tid & 15) * 8;
    const int vb0 = (int)lds32 + v_rd_base(lane);
    const bf16* Kh = REF_K(BS, cur); const bf16* Vh = REF_V(BS, cur); const float* Xh = REF_X(BS, cur);
#define RESC(a) do { if (__any((a) < 1.f)) { if (hi == 0) al_l[r32] = (a); asm volatile("s_waitcnt lgkmcnt(0)" ::: "memory");              \
                     for (int d_ = 0; d_ < 4; ++d_) for (int r = 0; r < 16; ++r) o[d_][r] *= al_l[crow(r, hi)]; } } while (0)
#define KBASE(t) ((j_lo + (t)) * KVBLK)
#define MASKT(P0_, P1_, t) do { const int kb_ = KBASE(t); if (kb_ + KVBLK - 1 > qlo) mask_tile(P0_, P1_, qm - kb_); } while (0)
    constexpr int NQL = 8;
#define SEAM_K0() do { VMWN(NQL); SWRITE_HK(0); SBAR(); } while (0)
    f32x16 pA0, pA1, pB0, pB1; float mnA, mnB, alA, alB; bf16x8 pa0, pa1, pa2, pa3;
    SWRITE_HV(0); SBAR();
    if (NT > 1) { SLOAD_H(Kh, Vh, KBASE(1)); XDMA(Xh, KBASE(1), 1); }
    SBAR(); qkt<0>(pA0, pA1, K_lds, X_lds, r32, hi, S.qr);
    MASKT(pA0, pA1, 0); partialSM(pA0, pA1, m_reg, mnA, alA);
    if (NT > 1) { VMW(); SWRITE_H(1); }
    __syncthreads();
#define HALF_STEP(PX0, PX1, mnX, alX, PY0, PY1, alY, t, KB, VB, SB) do {                                                      \
        SBAR(); qkt<KB>(PX0, PX1, K_lds, X_lds, r32, hi, S.qr);                                                           \
        finishSM(PY0, PY1, alY, l_reg, pa0, pa1, pa2, pa3); SBAR();                                                           \
        if ((t) + 1 < NT) { SLOAD_H(Kh, Vh, KBASE((t) + 1)); XDMA(Xh, KBASE((t) + 1), SB); SBAR(); }                          \
        pv_tile<VB>(o, vb0, pa0, pa1, pa2, pa3); MASKT(PX0, PX1, (t)); partialSM(PX0, PX1, m_reg, mnX, alX);                  \
        __syncthreads();                                                                                                      \
        if ((t) + 1 < NT) { VMW(); SWRITE_H(SB); }                                                                            \
        RESC(alX); __syncthreads(); } while (0)
    for (int t = 1; t + 1 < NT; t += 2) {
        HALF_STEP(pB0, pB1, mnB, alB, pA0, pA1, alA, t, 1, 0, 0);
        HALF_STEP(pA0, pA1, mnA, alA, pB0, pB1, alB, t + 1, 0, 1, 1);
    }
    const bool even = (NT & 1) == 0;
    if (even) { SBAR(); qkt<1>(pB0, pB1, K_lds, X_lds, r32, hi, S.qr); SBAR(); }
    BlockRef nxt = cur; { const int nid = __builtin_amdgcn_readfirstlane(*(const int*)(lds + NXT_OFF)); nxo.h = -1; nxo.qb = 0; nxo.jlo = 0;
        if (nid < 1024) { nxt.h = nid & 15; nxt.qb = 63 - (nid >> 4); nxt.jlo = __builtin_amdgcn_readfirstlane((int)*(const unsigned short*)(lds + JLO_OFF + 2 * nid)); nxo = nxt; } }
    const int kbn = nxt.jlo * KVBLK;
    SLOAD_H(REF_K(BS, nxt), REF_V(BS, nxt), kbn); XDMA(REF_X(BS, nxt), kbn, 0); SBAR();
#pragma unroll
    for (int d0 = 0; d0 < 8; ++d0) S.qr[d0] = load8(REF_Q(BS, nxt) + (size_t)(wid * QBLK + r32) * D + d0 * 16 + hi * 8);
    SBAR();
    finishSM(pA0, pA1, alA, l_reg, pa0, pa1, pa2, pa3); SBAR();
    pv_tile<0>(o, vb0, pa0, pa1, pa2, pa3);
    if (even) { MASKT(pB0, pB1, NT - 1); partialSM(pB0, pB1, m_reg, mnB, alB); __syncthreads(); RESC(alB);
        finishSM(pB0, pB1, alB, l_reg, pa0, pa1, pa2, pa3); SBAR(); pv_tile<1>(o, vb0, pa0, pa1, pa2, pa3); }
    SBAR(); SEAM_K0();
    if (hi == 0) li_l[r32] = l_reg; asm volatile("s_waitcnt lgkmcnt(0)" ::: "memory");
    float rli[16];
#pragma unroll
    for (int r = 0; r < 16; ++r) rli[r] = __builtin_amdgcn_rcpf(li_l[crow(r, hi)]);
    bf16* Ow = REF_O(BS, cur) + (size_t)(wid * QBLK) * OPITCH;
#pragma unroll
    for (int r = 0; r < 16; ++r) { const int orow = crow(r, hi);
#pragma unroll
        for (int d0 = 0; d0 < 4; ++d0) { const float v = o[d0][r] * rli[r];
            const float vn = __shfl_xor(v, 1);
            if ((r32 & 1) == 0) *(unsigned*)(Ow + (size_t)orow * OPITCH + d0 * 32 + r32) = cvtpk(v, vn); } }
    __syncthreads();
#undef RESC
#undef KBASE
#undef MASKT
#undef SEAM_K0
#undef HALF_STEP
}
#undef REF_Q
#undef REF_K
#undef REF_V
#undef REF_X
#undef REF_O
#undef ROW
#undef VMW
#undef VMWN
#undef SLOAD_H
#undef XDMA
#undef SWRITE_HK
#undef SWRITE_HV
#undef SWRITE_H
#undef KSWZ
#undef SBAR
}

constexpr int NWAVES = 8;
#ifndef MK_N_LAUNCHES
#define MK_N_LAUNCHES 1
#endif
constexpr int N_PHASES = 17;

constexpr size_t MiB = 1u << 20;
constexpr size_t WS_CTL = 0, CTL_ZERO_BYTES = 64 * 1024;
constexpr size_t WS_TOKE = 1 * MiB, WS_TOKW0 = WS_TOKE + 65536, WS_TOKW1 = WS_TOKW0 + 65536, WS_TOKP0 = WS_TOKW1 + 65536, WS_TOKP1 = WS_TOKP0 + 65536;
constexpr size_t WS_SLOT = 2 * MiB;
constexpr size_t WS_LC = 4 * MiB;
constexpr size_t WS_CT = 5 * MiB;
constexpr size_t WS_WR = 5 * MiB + 512 * 1024;
constexpr size_t WS_WF = 6 * MiB;
constexpr size_t WS_NB = 7 * MiB + 512 * 1024;
constexpr size_t WS_KX = 8 * MiB;
constexpr size_t WS_WCIN = 16 * MiB, WS_WCOUT = 40 * MiB, WS_WAIN = 48 * MiB, WS_WAOUT = 72 * MiB;
constexpr size_t WS_WGU = 80 * MiB;
constexpr size_t WS_WD = 336 * MiB;
constexpr size_t WS_HN = 464 * MiB;
constexpr size_t WS_X = 528 * MiB;
constexpr size_t WS_STAGE = 656 * MiB;
constexpr size_t WS_Z = WS_STAGE, WS_GO = WS_STAGE + 64 * MiB;
constexpr size_t WS_XS = WS_STAGE, WS_H = WS_STAGE + 160 * MiB;
constexpr size_t WS_Q = WS_STAGE, WS_K = WS_STAGE + 64 * MiB, WS_V = WS_STAGE + 128 * MiB;
constexpr size_t WS_END = 856 * MiB;
constexpr int CW_ATT = 32;
constexpr int CW_CNT = 64;
constexpr int CW_BAR = 4096;
constexpr int RING_OFF = 0, RING_BYTES = 131072;
constexpr int TILE_OFF = RING_BYTES;
constexpr int TST_OFF = TILE_OFF + 1024;
constexpr int MISC_OFF = TST_OFF + 512;
constexpr int LDS_BYTES = 147456;
static_assert(MISC_OFF + 128 <= LDS_BYTES && fox::LDS_BYTES <= RING_BYTES, "LDS map");

#define GAS __attribute__((address_space(1)))
#define LAS __attribute__((address_space(3)))
typedef unsigned short bf16;
typedef unsigned v4u __attribute__((ext_vector_type(4)));
typedef unsigned v2u __attribute__((ext_vector_type(2)));
typedef float f32x4 __attribute__((ext_vector_type(4)));
typedef float f32x16 __attribute__((ext_vector_type(16)));
typedef short bf16x8 __attribute__((ext_vector_type(8)));
typedef GAS unsigned gu32;
#define RLX_AGENT __ATOMIC_RELAXED, __HIP_MEMORY_SCOPE_AGENT
#define LDS_WAIT() asm volatile("s_waitcnt lgkmcnt(0)" ::: "memory")
#define VM_WAIT() asm volatile("s_waitcnt vmcnt(0)" ::: "memory")
__device__ __forceinline__ unsigned f2bf(float f) { unsigned u = __builtin_bit_cast(unsigned, f); return (u + 0x7fffu + ((u >> 16) & 1u)) >> 16; }
__device__ __forceinline__ unsigned pk2(float lo, float hi) { return f2bf(lo) | (f2bf(hi) << 16); }
__device__ __forceinline__ float bf_lo(unsigned w) { return __builtin_bit_cast(float, w << 16); }
__device__ __forceinline__ float bf_hi(unsigned w) { return __builtin_bit_cast(float, w & 0xffff0000u); }
__device__ __forceinline__ float wave_sum(float v) {
#pragma unroll
    for (int o = 1; o < 64; o <<= 1) v += __shfl_xor(v, o);
    return v;
}

#define XB_TMO      128
#define XB_XCNT(j)  (256  + 64 * (j))
#define XB_XSUB(j)  (1280 + 64 * (j))
#define XB_XGEN(j)  (2304 + 64 * (j))
#define XB_TOP      3328
#define XB_TOPGEN   3392
#define XCD_BAR_WORDS 3456
#define XB_SPIN_CAP (1u << 18)

__device__ __forceinline__ unsigned xb_ld(unsigned* p)              { return __hip_atomic_load(p, __ATOMIC_RELAXED, __HIP_MEMORY_SCOPE_AGENT); }
__device__ __forceinline__ unsigned xb_add(unsigned* p, unsigned v) { return __hip_atomic_fetch_add(p, v, __ATOMIC_RELAXED, __HIP_MEMORY_SCOPE_AGENT); }
__device__ __forceinline__ unsigned xb_xcc_id() { return (unsigned)__builtin_amdgcn_s_getreg((3 << 11) | 20) & 0xFu; }
#define XB_SPIN(cond, bar) do { unsigned _sp = 0; while (cond) { __builtin_amdgcn_s_sleep(1); \
    if ((++_sp & 255u) == 0u) { if (xb_ld(&(bar)[XB_TMO])) break; if (_sp > XB_SPIN_CAP) { atomicAdd(&(bar)[XB_TMO], 1u); break; } } } } while (0)

struct XcdBarrier {
    unsigned* bar; unsigned x;
    volatile LAS unsigned* st;
};

__device__ __forceinline__ XcdBarrier xcd_barrier_post(unsigned* bar, volatile LAS unsigned* st) {
    XcdBarrier b; b.bar = bar; b.x = xb_xcc_id(); b.st = st;
    if (threadIdx.x == 0) (void)xb_add(&bar[XB_XCNT(b.x)], 1u);
    return b;
}
__device__ __forceinline__ void xcd_barrier_complete(unsigned* bar, unsigned x, unsigned& nloc, unsigned& nx) {
    const unsigned G = gridDim.x * gridDim.y * gridDim.z;
    unsigned sum, cnt, mine, sp = 0u;
    for (;;) {
        sum = 0u; cnt = 0u; mine = 0u;
#pragma unroll
        for (unsigned j = 0; j < 16; ++j) { const unsigned c = xb_ld(&bar[XB_XCNT(j)]); sum += c; cnt += (c > 0u) ? 1u : 0u; mine = (j == x) ? c : mine; }
        if (sum == G) break;
        __builtin_amdgcn_s_sleep(1);
        if ((++sp & 255u) == 0u) { if (xb_ld(&bar[XB_TMO])) break; if (sp > XB_SPIN_CAP) { atomicAdd(&bar[XB_TMO], 1u); break; } }
    }
    nloc = mine > 0u ? mine : 1u; nx = cnt > 0u ? cnt : 1u;
}

__device__ __forceinline__ void xcd_barrier(const XcdBarrier& b) {
    asm volatile("s_waitcnt vmcnt(0)" ::: "memory");
    __syncthreads();
    if (threadIdx.x == 0) {
        unsigned* bar = b.bar;
        __builtin_amdgcn_s_waitcnt(0);
        unsigned nloc = b.st[0], nx = b.st[1];
        if (nloc == 0u) { xcd_barrier_complete(bar, b.x, nloc, nx); b.st[0] = nloc; b.st[1] = nx; }
        const unsigned old = xb_add(&bar[XB_XSUB(b.x)], 1u);
        const unsigned gen = old / nloc;
        if (old + 1u == (gen + 1u) * nloc) {
            __builtin_amdgcn_fence(__ATOMIC_RELEASE, "agent");
            asm volatile("s_waitcnt vmcnt(0)" ::: "memory");
            const unsigned og = xb_add(&bar[XB_TOP], 1u);
            const unsigned tg = og / nx;
            if (og + 1u == (tg + 1u) * nx) xb_add(&bar[XB_TOPGEN], 1u);
            else XB_SPIN(xb_ld(&bar[XB_TOPGEN]) == tg, bar);
            __builtin_amdgcn_fence(__ATOMIC_ACQUIRE, "agent");
            xb_add(&bar[XB_XGEN(b.x)], 1u);
            asm volatile("s_waitcnt vmcnt(0)" ::: "memory");
        } else {
            XB_SPIN(xb_ld(&bar[XB_XGEN(b.x)]) == gen, bar);
            __builtin_amdgcn_fence(__ATOMIC_ACQUIRE, "agent");
            asm volatile("s_waitcnt vmcnt(0)" ::: "memory");
        }
    }
    __syncthreads();
}

struct Frame {
    LAS unsigned char* lds;
    volatile LAS unsigned* MISC;
    gu32* ctl;
    int tid, lane, wave;
    int vcu, G;
    const float *x, *mix_norm, *ffn_norm, *final_norm, *conv_w_in, *conv_w, *conv_w_out, *attn_w_in, *attn_b_f, *attn_w_out, *rg_w, *rg_b, *re_w, *re_b, *w_gate, *w_up, *w_down;
    float* out; unsigned char* ws;
};
#define WSP(T, off) ((T*)(F.ws + (off)))

struct TrItem { const float* src; bf16* dst; int ldw, ldd; };
__device__ __forceinline__ bool tr_decode(const Frame& F, int it, TrItem& d) {
    if (it < 6144) { const int kb = it / 192, nb = it % 192, n0 = nb * 32; d.src = F.conv_w_in + (size_t)(kb * 64) * 6144 + n0; d.ldw = 6144; d.ldd = 2048;
        int dr; if (n0 < 2048) dr = 4096 + n0; else if (n0 < 4096) { const int i = n0 - 2048; dr = 256 * (i >> 7) + (i & 127); } else { const int i = n0 - 4096; dr = 256 * (i >> 7) + 128 + (i & 127); }
        d.dst = WSP(bf16, WS_WCIN) + (size_t)dr * 2048 + kb * 64; return true; }
    it -= 6144;
    if (it < 2048) { const int kb = it / 64, nb = it % 64; d.src = F.conv_w_out + (size_t)(kb * 64) * 2048 + nb * 32; d.ldw = 2048; d.ldd = 2048; d.dst = WSP(bf16, WS_WCOUT) + (size_t)(nb * 32) * 2048 + kb * 64; return true; }
    it -= 2048;
    if (it < 6144) { const int kb = it / 192, nb = it % 192; d.src = F.attn_w_in + (size_t)(kb * 64) * 6160 + nb * 32; d.ldw = 6160; d.ldd = 2048; d.dst = WSP(bf16, WS_WAIN) + (size_t)(nb * 32) * 2048 + kb * 64; return true; }
    it -= 6144;
    if (it < 2048) { const int kb = it / 64, nb = it % 64; d.src = F.attn_w_out + (size_t)(kb * 64) * 2048 + nb * 32; d.ldw = 2048; d.ldd = 2048; d.dst = WSP(bf16, WS_WAOUT) + (size_t)(nb * 32) * 2048 + kb * 64; return true; }
    it -= 2048;
    if (it < 65536) { const int up = it >> 15, r = it & 32767, le = r >> 9, q = r & 511, kb = q >> 4, nb = q & 15, n0 = nb * 32;
        d.src = (up ? F.w_up : F.w_gate) + (size_t)le * 2048 * 512 + (size_t)(kb * 64) * 512 + n0; d.ldw = 512; d.ldd = 2048;
        const int dr = 256 * (n0 >> 7) + 128 * up + (n0 & 127);
        d.dst = WSP(bf16, WS_WGU) + ((size_t)le * 1024 + dr) * 2048 + kb * 64; return true; }
    it -= 65536;
    if (it < 32768) { const int le = it >> 9, q = it & 511, kb = q >> 6, nb = q & 63;
        d.src = F.w_down + (size_t)le * 512 * 2048 + (size_t)(kb * 64) * 2048 + nb * 32; d.ldw = 2048; d.ldd = 512;
        d.dst = WSP(bf16, WS_WD) + ((size_t)le * 2048 + nb * 32) * 512 + kb * 64; return true; }
    return false;
}
constexpr int TR_NITEMS = 6144 + 2048 + 6144 + 2048 + 65536 + 32768;
__device__ __forceinline__ void p0_prologue(Frame& F) {
    LAS float* scr = (LAS float*)(F.lds + RING_OFF + F.wave * 16384);
    const int gw = F.vcu * NWAVES + F.wave, NGW = F.G * NWAVES, lane = F.lane;
    float v[32]; TrItem cur, nx; int it = gw;
    bool have = tr_decode(F, it, cur);
    if (have) {
#pragma unroll
        for (int i = 0; i < 32; ++i) v[i] = cur.src[(size_t)(2 * i + (lane >> 5)) * cur.ldw + (lane & 31)];
    }
    while (have) {
#pragma unroll
        for (int i = 0; i < 32; ++i) scr[(2 * i + (lane >> 5)) * 33 + (lane & 31)] = v[i];
        it += NGW; const bool hn = tr_decode(F, it, nx);
        if (hn) {
#pragma unroll
            for (int i = 0; i < 32; ++i) v[i] = nx.src[(size_t)(2 * i + (lane >> 5)) * nx.ldw + (lane & 31)];
        }
        LDS_WAIT(); asm volatile("" ::: "memory");
        const int c = lane & 7;
#pragma unroll
        for (int j = 0; j < 4; ++j) { const int n = (lane >> 3) + 8 * j; const LAS float* s = scr + (8 * c) * 33 + n;
            v4u o; o.x = pk2(s[0 * 33], s[1 * 33]); o.y = pk2(s[2 * 33], s[3 * 33]); o.z = pk2(s[4 * 33], s[5 * 33]); o.w = pk2(s[6 * 33], s[7 * 33]);
            *(GAS v4u*)(cur.dst + (size_t)n * cur.ldd + 8 * c) = o; }
        LDS_WAIT(); asm volatile("" ::: "memory");
        cur = nx; have = hn;
    }
    const int gt = (F.vcu * NWAVES + F.wave) * 64 + lane, NGT = F.G * NWAVES * 64;
    for (int i = gt; i < 2 * 64 * 2048; i += NGT) { const int l = i >> 17, r = (i >> 11) & 63, k = i & 2047; float w = 0.f;
        if (r < 4) w = F.rg_w[((size_t)l * 2048 + k) * 4 + r];
        else if (r < 36) { const int g = (r - 4) >> 3, e = (r - 4) & 7; w = F.re_w[(((size_t)l * 4 + g) * 2048 + k) * 8 + e]; }
        WSP(bf16, WS_WR)[i] = (bf16)f2bf(w); }
    for (int i = gt; i < 32 * 2048; i += NGT) { const int r = i >> 11, k = i & 2047; const float w = r < 16 ? F.attn_w_in[(size_t)k * 6160 + 6144 + r] : 0.f; WSP(bf16, WS_WF)[i] = (bf16)f2bf(w); }
}

template <int NB>
__device__ __forceinline__ void small_gemm(const Frame& F, const bf16* hn_rows, const bf16* Wt, LAS float* lg) {
    constexpr int NC = NB * 32, NE = 64 * NC, PER = NE / 512;
    const int lane = F.lane, r32 = lane & 31, hi = lane >> 5, kw = F.wave * 256;
    f32x16 acc[2][NB];
#pragma unroll
    for (int a = 0; a < 2; ++a)
#pragma unroll
        for (int b = 0; b < NB; ++b) acc[a][b] = f32x16{};
    const bf16* ap = hn_rows + (size_t)r32 * 2048 + kw + hi * 8; const bf16* bp = Wt + (size_t)r32 * 2048 + kw + hi * 8;
#pragma unroll 4
    for (int ks = 0; ks < 16; ++ks) {
        const bf16x8 a0 = *(const bf16x8*)(ap + ks * 16), a1 = *(const bf16x8*)(ap + 32 * 2048 + ks * 16);
#pragma unroll
        for (int b = 0; b < NB; ++b) { const bf16x8 bv = *(const bf16x8*)(bp + (size_t)b * 32 * 2048 + ks * 16);
            acc[0][b] = __builtin_amdgcn_mfma_f32_32x32x16_bf16(a0, bv, acc[0][b], 0, 0, 0);
            acc[1][b] = __builtin_amdgcn_mfma_f32_32x32x16_bf16(a1, bv, acc[1][b], 0, 0, 0); }
    }
    LAS float* part = lg + F.wave * NE;
#pragma unroll
    for (int a = 0; a < 2; ++a)
#pragma unroll
        for (int b = 0; b < NB; ++b)
#pragma unroll
            for (int r = 0; r < 16; ++r) { const int row = a * 32 + (r & 3) + 8 * (r >> 2) + 4 * hi; part[row * NC + b * 32 + r32] = acc[a][b][r]; }
    LDS_WAIT(); __syncthreads();
    float s[PER];
#pragma unroll
    for (int q = 0; q < PER; ++q) { const int i = F.tid + 512 * q; float t = lg[i];
#pragma unroll
        for (int w = 1; w < 8; ++w) t += lg[w * NE + i];
        s[q] = t; }
    LDS_WAIT(); __syncthreads();
#pragma unroll
    for (int q = 0; q < PER; ++q) { const int i = F.tid + 512 * q; lg[(i / NC) * (NC + 1) + (i % NC)] = s[q]; }
    LDS_WAIT(); __syncthreads();
}
__device__ __forceinline__ int build_tiles(Frame& F, int layer) {
    LAS int* tile_e = (LAS int*)(F.lds + TILE_OFF); LAS int* tst = (LAS int*)(F.lds + TST_OFF);
    __syncthreads();
    if (F.tid < 64) {
        const int c = F.tid < 32 ? (int)__hip_atomic_load(F.ctl + CW_CNT + 32 * layer + F.tid, RLX_AGENT) : 0;
        const int nt = (c + 255) >> 8; int inc = nt;
#pragma unroll
        for (int o = 1; o < 32; o <<= 1) { const int t = __shfl_up(inc, o); if ((F.tid & 63) >= o) inc += t; }
        const int st = inc - nt;
        if (F.tid < 32) { tst[F.tid] = st; tst[32 + F.tid] = c; for (int t = 0; t < nt; ++t) tile_e[st + t] = F.tid; }
        if (F.tid == 31) tst[64] = inc;
    }
    __syncthreads();
    return tst[64];
}
template <int MODE>
__device__ __forceinline__ void row_phase(Frame& F, int layer) {
    const int lane = F.lane, wave = F.wave, tid = F.tid;
    const float* gain = MODE == 0 ? F.mix_norm : (MODE == 1 ? F.ffn_norm + layer * DM : (MODE == 2 ? F.mix_norm + DM : F.final_norm));
    f32x4 g[8];
#pragma unroll
    for (int j = 0; j < 4; ++j) { g[2 * j] = *(const f32x4*)(gain + 512 * j + 8 * lane); g[2 * j + 1] = *(const f32x4*)(gain + 512 * j + 8 * lane + 4); }
    LAS float* lg = (LAS float*)(F.lds + RING_OFF);
    LAS int* hist = (LAS int*)(F.lds + TILE_OFF);
    LAS int* tst = (LAS int*)(F.lds + TST_OFF);
    if (MODE >= 2) (void)build_tiles(F, MODE == 2 ? 0 : 1);
    const float* xin = MODE == 0 ? F.x : WSP(float, WS_X);
    bf16* HN = WSP(bf16, WS_HN);
    for (int chunk = F.vcu; chunk < SEQ / 64; chunk += F.G) {
        const int row0 = chunk * 64;
        if (MODE == 1) { if (tid < 64) hist[tid] = 0; }
        for (int i = 0; i < 8; ++i) {
            const int row = row0 + wave * 8 + i;
            const float* xr = xin + (size_t)row * DM + 8 * lane;
            f32x4 v[8];
#pragma unroll
            for (int j = 0; j < 4; ++j) { v[2 * j] = *(const f32x4*)(xr + 512 * j); v[2 * j + 1] = *(const f32x4*)(xr + 512 * j + 4); }
            if (MODE >= 2) {
                const unsigned ee = WSP(unsigned, WS_TOKE)[row]; const int e0 = ee & 255, e1 = (ee >> 8) & 255;
                const int r0 = tst[e0] * 256 + WSP(int, WS_TOKP0)[row], r1 = tst[e1] * 256 + WSP(int, WS_TOKP1)[row];
                const float w0 = WSP(float, WS_TOKW0)[row], w1 = WSP(float, WS_TOKW1)[row];
                const bf16* o0 = WSP(bf16, WS_XS) + (size_t)r0 * DM + 8 * lane; const bf16* o1 = WSP(bf16, WS_XS) + (size_t)r1 * DM + 8 * lane;
#pragma unroll
                for (int j = 0; j < 4; ++j) { const v4u a = *(const v4u*)(o0 + 512 * j), b = *(const v4u*)(o1 + 512 * j);
                    v[2 * j][0] += w0 * bf_lo(a.x) + w1 * bf_lo(b.x); v[2 * j][1] += w0 * bf_hi(a.x) + w1 * bf_hi(b.x);
                    v[2 * j][2] += w0 * bf_lo(a.y) + w1 * bf_lo(b.y); v[2 * j][3] += w0 * bf_hi(a.y) + w1 * bf_hi(b.y);
                    v[2 * j + 1][0] += w0 * bf_lo(a.z) + w1 * bf_lo(b.z); v[2 * j + 1][1] += w0 * bf_hi(a.z) + w1 * bf_hi(b.z);
                    v[2 * j + 1][2] += w0 * bf_lo(a.w) + w1 * bf_lo(b.w); v[2 * j + 1][3] += w0 * bf_hi(a.w) + w1 * bf_hi(b.w); }
            }
            float ss = 0.f;
#pragma unroll
            for (int j = 0; j < 8; ++j) ss += (v[j][0] * v[j][0] + v[j][1] * v[j][1]) + (v[j][2] * v[j][2] + v[j][3] * v[j][3]);
            const float rstd = 1.0f / sqrtf(wave_sum(ss) * (1.0f / DM) + RMS_EPS);
            if (MODE == 2) { float* xw = WSP(float, WS_X) + (size_t)row * DM + 8 * lane;
#pragma unroll
                for (int j = 0; j < 4; ++j) { *(f32x4*)(xw + 512 * j) = v[2 * j]; *(f32x4*)(xw + 512 * j + 4) = v[2 * j + 1]; } }
            if (MODE == 3) { float* ow = F.out + (size_t)row * DM + 8 * lane;
#pragma unroll
                for (int j = 0; j < 4; ++j) { *(f32x4*)(ow + 512 * j) = v[2 * j] * rstd * g[2 * j]; *(f32x4*)(ow + 512 * j + 4) = v[2 * j + 1] * rstd * g[2 * j + 1]; } }
            else { bf16* hw = HN + (size_t)row * DM + 8 * lane;
#pragma unroll
                for (int j = 0; j < 4; ++j) { const f32x4 a = v[2 * j] * rstd * g[2 * j], b = v[2 * j + 1] * rstd * g[2 * j + 1];
                    v4u o; o.x = pk2(a[0], a[1]); o.y = pk2(a[2], a[3]); o.z = pk2(b[0], b[1]); o.w = pk2(b[2], b[3]); *(v4u*)(hw + 512 * j) = o; } }
        }
        if (MODE == 1 || MODE == 2) {
            VM_WAIT(); __syncthreads();
            if (MODE == 1) small_gemm<2>(F, HN + (size_t)row0 * DM, WSP(bf16, WS_WR) + (size_t)layer * 64 * 2048, lg);
            else small_gemm<1>(F, HN + (size_t)row0 * DM, WSP(bf16, WS_WF), lg);
            if (MODE == 1) {
                int e0 = 0, e1 = 0, rk0 = 0, rk1 = 0; float w0 = 0.f, w1 = 0.f;
                if (tid < 64) {
                    const LAS float* l = lg + tid * 65; const float* gb = F.rg_b + layer * 4; const float* eb = F.re_b + layer * 32;
                    float gl[4]; for (int j = 0; j < 4; ++j) gl[j] = l[j] + gb[j];
                    int gs = 0; float gm = gl[0]; for (int j = 1; j < 4; ++j) if (gl[j] > gm) { gm = gl[j]; gs = j; }
                    float den = 0.f; for (int j = 0; j < 4; ++j) den += __expf(gl[j] - gm);
                    const float pg = 1.0f / den;
                    float el[8]; for (int j = 0; j < 8; ++j) el[j] = l[4 + gs * 8 + j] + eb[gs * 8 + j];
                    int i1 = 0; float v1 = el[0]; for (int j = 1; j < 8; ++j) if (el[j] > v1) { v1 = el[j]; i1 = j; }
                    int i2 = -1; float v2 = -3.0e38f; for (int j = 0; j < 8; ++j) if (j != i1 && el[j] > v2) { v2 = el[j]; i2 = j; }
                    const float s = 1.0f / (1.0f + __expf(v2 - v1));
                    w0 = pg * s; w1 = pg * (1.0f - s); e0 = gs * 8 + i1; e1 = gs * 8 + i2;
                    rk0 = __hip_atomic_fetch_add(hist + e0, 1, __ATOMIC_RELAXED, __HIP_MEMORY_SCOPE_WORKGROUP);
                    rk1 = __hip_atomic_fetch_add(hist + e1, 1, __ATOMIC_RELAXED, __HIP_MEMORY_SCOPE_WORKGROUP);
                    LDS_WAIT(); asm volatile("" ::: "memory");
                    if (tid < 32) { const int c = hist[tid]; hist[32 + tid] = c ? (int)__hip_atomic_fetch_add(F.ctl + CW_CNT + 32 * layer + tid, (unsigned)c, RLX_AGENT) : 0; }
                    LDS_WAIT(); asm volatile("" ::: "memory");
                    const int p0 = hist[32 + e0] + rk0, p1 = hist[32 + e1] + rk1, row = row0 + tid;
                    WSP(int, WS_SLOT)[e0 * CAP + p0] = row; WSP(int, WS_SLOT)[e1 * CAP + p1] = row;
                    WSP(unsigned, WS_TOKE)[row] = (unsigned)e0 | ((unsigned)e1 << 8);
                    WSP(int, WS_TOKP0)[row] = p0; WSP(int, WS_TOKP1)[row] = p1; WSP(float, WS_TOKW0)[row] = w0; WSP(float, WS_TOKW1)[row] = w1;
                }
            } else {
                if (tid < 16) {
                    const float bfh = F.attn_b_f[tid]; float run = 0.f; float* lc = WSP(float, WS_LC) + (size_t)row0 * 16 + tid;
                    for (int r = 0; r < 64; ++r) { const float xv = lg[r * 33 + tid] + bfh; const float ls = fminf(xv, 0.f) - log1pf(__expf(-fabsf(xv))); run += ls; lc[r * 16] = run; }
                    WSP(float, WS_CT)[chunk * 16 + tid] = run;
                }
            }
            __syncthreads();
        }
    }
}
__device__ __forceinline__ void c_finalize(Frame& F) {
    LAS float* part = (LAS float*)(F.lds + RING_OFF);
    const int tid = F.tid;
    for (int chunk = F.vcu; chunk < SEQ / 64; chunk += F.G) {
        __syncthreads();
        { const int h = tid & 15, p = tid >> 4; float s = 0.f; const float* ct = WSP(float, WS_CT);
            for (int c = p * 8; c < p * 8 + 8; ++c) if (c < chunk) s += ct[c * 16 + h];
            part[p * 16 + h] = s; }
        __syncthreads();
        if (tid < 16) { float s = 0.f; for (int p = 0; p < 32; ++p) s += part[p * 16 + tid]; part[512 + tid] = s; }
        __syncthreads();
        for (int i = tid; i < 64 * 16; i += 512) { const int r = i >> 4, h = i & 15, row = chunk * 64 + r;
            const float cv = WSP(float, WS_LC)[(size_t)row * 16 + h] + part[512 + h];
            WSP(float, WS_KX)[(size_t)h * SEQ + row] = -cv * 11.313708498984761f; }
    }
    __syncthreads();
}
__device__ __forceinline__ void conv_phase(Frame& F) {
    const int tid = F.tid, c8 = (tid & 255) * 8, half = tid >> 8;
    float w[3][8];
#pragma unroll
    for (int k = 0; k < 3; ++k)
#pragma unroll
        for (int j = 0; j < 8; ++j) w[k][j] = F.conv_w[k * DM + c8 + j];
    const bf16* Z = WSP(bf16, WS_Z); const bf16* GO = WSP(bf16, WS_GO); bf16* A = WSP(bf16, WS_HN);
    for (int chunk = F.vcu; chunk < SEQ / 64; chunk += F.G) {
        const int t0 = chunk * 64 + half * 32;
        v4u zm2 = (v4u){0u, 0u, 0u, 0u}, zm1 = zm2;
        if (t0 >= 2) { zm2 = *(const v4u*)(Z + (size_t)(t0 - 2) * DM + c8); zm1 = *(const v4u*)(Z + (size_t)(t0 - 1) * DM + c8); }
#pragma unroll 4
        for (int t = t0; t < t0 + 32; ++t) {
            const v4u z0 = *(const v4u*)(Z + (size_t)t * DM + c8), go = *(const v4u*)(GO + (size_t)t * DM + c8);
            v4u o;
#define CV(q, j) (w[0][j] * (((j) & 1) ? bf_hi(zm2.q) : bf_lo(zm2.q)) + w[1][j] * (((j) & 1) ? bf_hi(zm1.q) : bf_lo(zm1.q)) + w[2][j] * (((j) & 1) ? bf_hi(z0.q) : bf_lo(z0.q)))
            o.x = pk2(bf_lo(go.x) * CV(x, 0), bf_hi(go.x) * CV(x, 1)); o.y = pk2(bf_lo(go.y) * CV(y, 2), bf_hi(go.y) * CV(y, 3));
            o.z = pk2(bf_lo(go.z) * CV(z, 4), bf_hi(go.z) * CV(z, 5)); o.w = pk2(bf_lo(go.w) * CV(w, 6), bf_hi(go.w) * CV(w, 7));
#undef CV
            *(v4u*)(A + (size_t)t * DM + c8) = o;
            zm2 = zm1; zm1 = z0;
        }
    }
}
__device__ __forceinline__ void gather_phase(Frame& F, int layer) {
    const int ntile = build_tiles(F, layer);
    const LAS int* tile_e = (const LAS int*)(F.lds + TILE_OFF); const LAS int* tst = (const LAS int*)(F.lds + TST_OFF);
    const int gw = F.vcu * NWAVES + F.wave, NGW = F.G * NWAVES, lane = F.lane;
    const bf16* HN = WSP(bf16, WS_HN); bf16* XS = WSP(bf16, WS_XS);
    for (int r = gw; r < ntile * 256; r += NGW) {
        const int t = r >> 8, e = tile_e[t], pos = r - tst[e] * 256;
        if (pos < tst[32 + e]) { const int tok = WSP(int, WS_SLOT)[e * CAP + pos];
            const v4u* s = (const v4u*)(HN + (size_t)tok * DM) + lane; v4u* d = (v4u*)(XS + (size_t)r * DM) + lane;
            const v4u a = s[0], b = s[64], c = s[128], dd = s[192]; d[0] = a; d[64] = b; d[128] = c; d[192] = dd; }
    }
}


constexpr float PRUNE_T = 30.0f;
__device__ __forceinline__ void attn_phase(Frame& F, unsigned char* lds) {
    const unsigned lds32 = (unsigned)(size_t)F.lds;
    LAS unsigned short* jlo = (LAS unsigned short*)(F.lds + RING_OFF + fox::JLO_OFF);
    LAS float* kn2 = (LAS float*)(F.lds + RING_OFF + fox::KN2_OFF);
    LAS int* nxt_id = (LAS int*)(F.lds + RING_OFF + fox::NXT_OFF);
    const int tid = F.tid;
    const float* NBp = WSP(float, WS_NB); const float* Bp = WSP(float, WS_KX);
    for (int i = tid; i < 1024; i += 512) { const float* p = NBp + (size_t)(1024 + i) * 8;
        kn2[i] = (fmaxf(p[0], p[4]) + fmaxf(p[1], p[5])) + (fmaxf(p[2], p[6]) + fmaxf(p[3], p[7])); }
    __syncthreads();
    if (tid < 16) { float m = 0.f; for (int kb = 0; kb < 64; ++kb) { m = fmaxf(m, kn2[tid * 64 + kb]); kn2[tid * 64 + kb] = m; } }
    __syncthreads();
    for (int id = tid; id < 1024; id += 512) { const int h = id & 15, qb = 63 - (id >> 4);
        const float* p = NBp + (size_t)(h * 64 + qb) * 8;
        const float q2 = (fmaxf(p[0], p[4]) + fmaxf(p[1], p[5])) + (fmaxf(p[2], p[6]) + fmaxf(p[3], p[7]));
        const float thr = 2.0f * fox::SCALE * 1.02f * sqrtf(q2 * kn2[h * 64 + qb]) + PRUNE_T;
        const float* bh = Bp + (size_t)h * SEQ; const float b0 = bh[qb * 256];
        int lo = 0, hi = 4 * qb;
        while (lo < hi) { const int mid = (lo + hi) >> 1; if ((b0 - bh[mid * 64 + 63]) * fox::SCALE > thr) lo = mid + 1; else hi = mid; }
        jlo[id] = (unsigned short)lo; }
    __syncthreads();
    const fox::Bases BS{WSP(fox::bf16, WS_Q), WSP(fox::bf16, WS_K), WSP(fox::bf16, WS_V), WSP(float, WS_KX), WSP(fox::bf16, WS_HN)};
    const int total = 1024;
    int id = blockIdx.x;
    if (id < total) {
#define FOX_REF(r, k_) do { (r).h = (k_) & 15; (r).qb = 63 - ((k_) >> 4); (r).jlo = __builtin_amdgcn_readfirstlane((int)jlo[k_]); } while (0)
        fox::BlockRef cur, nxt; FOX_REF(cur, id);
        fox::Seam S;
        fox::fox_prime(BS, cur, (char*)lds + RING_OFF, lds32 + RING_OFF, S);
        for (;;) {
            if (tid == 0) *nxt_id = (int)F.G + (int)__hip_atomic_fetch_add(F.ctl + CW_ATT, 1u, RLX_AGENT);
            fox::fox_block(BS, cur, (char*)lds + RING_OFF, lds32 + RING_OFF, S, nxt);
            if (nxt.h < 0) break;
            cur = nxt;
        }
#undef FOX_REF
    }
}
#define IN(k) (lo <= (k) && (k) < hi)
#ifndef EN_MASK
#define EN_MASK 0xFFFF
#endif
#define EN(b) (((EN_MASK) >> (b)) & 1)
#define SEAM(k) do { if (MK_N_LAUNCHES == 1 && IN(k) && IN((k) + 1)) xcd_barrier(bar); } while (0)
template <int layer>
__device__ __forceinline__ void layer_phases(Frame& F, const XcdBarrier& bar, unsigned char* lds, const int lo, const int hi) {
    const unsigned lds32 = (unsigned)(size_t)F.lds;
        const int pb = 1 + 8 * layer;
        if (IN(pb + 0) && EN(1)) {
            if constexpr (layer == 0) {
                pg8::Gemm g{WSP(bf16, WS_HN), WSP(bf16, WS_WCIN), SEQ, 3 * DM, DM}; pg8::StaticOrder S; S.init(SEQ, 3 * DM, F.G, (int)blockIdx.x);
                pg8::EpiConvIn E{WSP(bf16, WS_Z), WSP(bf16, WS_GO)};
                pg8::gemm_phase<pg8::EpiConvIn, pg8::StaticOrder, true, true>(F.lds + RING_OFF, g, S, E);
            } else {
                c_finalize(F);
                pg8::Gemm g{WSP(bf16, WS_HN), WSP(bf16, WS_WAIN), SEQ, 3 * DM, DM}; pg8::StaticOrder S; S.init(SEQ, 3 * DM, F.G, (int)blockIdx.x);
                pg8::EpiQKV E{WSP(bf16, WS_Q), (size_t)(WS_K - WS_Q) / 2, WSP(float, WS_NB)};
                pg8::gemm_phase<pg8::EpiQKV, pg8::StaticOrder, true, true>(F.lds + RING_OFF, g, S, E);
            }
        }
        SEAM(pb + 0);
        if (IN(pb + 1)) {
            if constexpr (layer == 0) { if (EN(2)) conv_phase(F); }
            else if (EN(3)) attn_phase(F, lds);
        }
        SEAM(pb + 1);
        if (IN(pb + 2) && EN(4)) {
            pg8::Gemm g{WSP(bf16, WS_HN), layer == 0 ? WSP(bf16, WS_WCOUT) : WSP(bf16, WS_WAOUT), SEQ, DM, DM}; pg8::StaticOrder S; S.init(SEQ, DM, F.G, (int)blockIdx.x);
            pg8::EpiResF32 E{layer == 0 ? F.x : WSP(float, WS_X), WSP(float, WS_X)};
            pg8::gemm_phase<pg8::EpiResF32, pg8::StaticOrder, true, true>(F.lds + RING_OFF, g, S, E);
        }
        SEAM(pb + 2);
        if (IN(pb + 3) && EN(5)) row_phase<1>(F, layer);
        SEAM(pb + 3);
        if (IN(pb + 4) && EN(6)) gather_phase(F, layer);
        SEAM(pb + 4);
        if (IN(pb + 5) && EN(7)) {
            const int ntile = build_tiles(F, layer);
            pg8::Gemm g{WSP(bf16, WS_XS), WSP(bf16, WS_WGU) + (size_t)layer * 32 * 1024 * 2048, MAXT * 256, 32 * 1024, DM};
            pg8::ExpertOrder S{(const LAS int*)(F.lds + TILE_OFF), ntile * 4, 4, F.G, F.vcu};
            pg8::EpiGateUp E{WSP(bf16, WS_H)};
            pg8::gemm_phase<pg8::EpiGateUp, pg8::ExpertOrder, true, true>(F.lds + RING_OFF, g, S, E);
        }
        SEAM(pb + 5);
        if (IN(pb + 6) && EN(8)) {
            const int ntile = build_tiles(F, layer);
            pg8::Gemm g{WSP(bf16, WS_H), WSP(bf16, WS_WD) + (size_t)layer * 32 * 2048 * 512, MAXT * 256, 32 * 2048, DEXP};
            pg8::ExpertOrder S{(const LAS int*)(F.lds + TILE_OFF), ntile * 8, 8, F.G, F.vcu};
            pg8::EpiDown E{WSP(bf16, WS_XS)};
            pg8::gemm_phase<pg8::EpiDown, pg8::ExpertOrder, true, true>(F.lds + RING_OFF, g, S, E);
        }
        SEAM(pb + 6);
        if (IN(pb + 7) && EN(9)) { if (layer == 0) row_phase<2>(F, 0); else row_phase<3>(F, 1); }
        if (layer == 0) SEAM(pb + 7);
}

struct Args { const float* in[17]; float* out; unsigned char* ws; int ph_lo, ph_hi; };
__global__ void __launch_bounds__(NWAVES * 64, 2) trunk_fwd(Args args) {
    extern __shared__ __attribute__((aligned(16))) unsigned char lds[];
    Frame F;
    F.lds = (LAS unsigned char*)lds;
    F.MISC = (volatile LAS unsigned*)(F.lds + MISC_OFF);
    F.tid = threadIdx.x; F.lane = F.tid & 63; F.wave = __builtin_amdgcn_readfirstlane(F.tid >> 6);
    F.G = gridDim.x; { const int bx = blockIdx.x; F.vcu = (F.G % 8 == 0) ? (bx % 8) * (F.G / 8) + bx / 8 : bx; }
    F.ws = args.ws; F.out = args.out; F.ctl = (gu32*)(args.ws + WS_CTL);
    F.x = args.in[0]; F.mix_norm = args.in[1]; F.ffn_norm = args.in[2]; F.final_norm = args.in[3]; F.conv_w_in = args.in[4]; F.conv_w = args.in[5]; F.conv_w_out = args.in[6];
    F.attn_w_in = args.in[7]; F.attn_b_f = args.in[8]; F.attn_w_out = args.in[9]; F.rg_w = args.in[10]; F.rg_b = args.in[11]; F.re_w = args.in[12]; F.re_b = args.in[13];
    F.w_gate = args.in[14]; F.w_up = args.in[15]; F.w_down = args.in[16];
    if (F.tid < 32) F.MISC[F.tid] = 0u;
    __syncthreads();
    XcdBarrier bar; bar.bar = (unsigned*)(F.ctl + CW_BAR); bar.x = 0; bar.st = nullptr;
    if (MK_N_LAUNCHES == 1) bar = xcd_barrier_post((unsigned*)(F.ctl + CW_BAR), F.MISC + 8);
    const int lo = args.ph_lo, hi = args.ph_hi;

    if (IN(0) && EN(0)) { p0_prologue(F); row_phase<0>(F, 0); }
    SEAM(0);
    layer_phases<0>(F, bar, lds, lo, hi);
    layer_phases<1>(F, bar, lds, lo, hi);
}
#undef IN
#undef SEAM

extern "C" void kernel_launch(void* const* d_in, const int* in_sizes, int n_in, void* d_out, int out_size, void* d_ws, size_t ws_size, hipStream_t stream) {
    static int grid = 0;
    if (grid == 0) {
        if (n_in != 17 || in_sizes[0] != SEQ * DM || out_size != SEQ * DM || ws_size < WS_END) { fprintf(stderr, "kernel_launch: unexpected shapes (n_in %d, in0 %d, out %d, ws %zu < %zu); nothing launched\n", n_in, n_in > 0 ? in_sizes[0] : -1, out_size, ws_size, (size_t)WS_END); grid = -1; return; }
        int dev = 0, cus = 0, per_cu = 0;
        if (hipGetDevice(&dev) != hipSuccess || hipDeviceGetAttribute(&cus, hipDeviceAttributeMultiprocessorCount, dev) != hipSuccess) { fprintf(stderr, "kernel_launch: device query failed\n"); grid = -1; return; }
        if (hipFuncSetAttribute((const void*)trunk_fwd, hipFuncAttributeMaxDynamicSharedMemorySize, LDS_BYTES) != hipSuccess) { fprintf(stderr, "kernel_launch: hipFuncSetAttribute failed\n"); grid = -1; return; }
        if (hipOccupancyMaxActiveBlocksPerMultiprocessor(&per_cu, (const void*)trunk_fwd, NWAVES * 64, LDS_BYTES) != hipSuccess || per_cu < 1) { fprintf(stderr, "kernel_launch: occupancy query reports %d workgroups per CU\n", per_cu); (void)hipGetLastError(); grid = -1; return; }
        grid = cus;
    }
    if (grid < 0) return;
    if (hipMemsetAsync((char*)d_ws + WS_CTL, 0, CTL_ZERO_BYTES, stream) != hipSuccess) { fprintf(stderr, "kernel_launch: hipMemsetAsync failed\n"); return; }
    Args a{};
    for (int i = 0; i < 17; ++i) a.in[i] = (const float*)d_in[i];
    a.out = (float*)d_out; a.ws = (unsigned char*)d_ws;
#if MK_N_LAUNCHES == 1
    a.ph_lo = 0; a.ph_hi = N_PHASES;
    hipLaunchKernelGGL(trunk_fwd, dim3(grid), dim3(NWAVES * 64), LDS_BYTES, stream, a);
#else
    for (int p = 0; p < N_PHASES; ++p) { a.ph_lo = p; a.ph_hi = p + 1; hipLaunchKernelGGL(trunk_fwd, dim3(grid), dim3(NWAVES * 64), LDS_BYTES, stream, a); }
#endif
    const hipError_t le = hipPeekAtLastError();
    if (le != hipSuccess) fprintf(stderr, "kernel_launch: launch failed: %s\n", hipGetErrorName(le));
}
```

```cpp
#include <hip/hip_runtime.h>
#include <cstdio>
#include <cstdint>

constexpr int SEQ = 16384, DM = 2048, NH = 16, HD = 128, NEXP = 32, NGRP = 4, EPG = 8, DEXP = 512;
constexpr float RMS_EPS = 1e-6f;
constexpr int CAP = SEQ;
constexpr int MAXT = 160;

namespace pg8 {
#define PG8_LAS __attribute__((address_space(3)))
typedef unsigned short bf16_t;
typedef short bf16x8 __attribute__((ext_vector_type(8)));
typedef float f32x4 __attribute__((ext_vector_type(4)));
typedef unsigned u32x4 __attribute__((ext_vector_type(4)));
constexpr int BM = 256, BK = 64, HALF = 128, HTB = HALF * BK * 2  , STAGE_BYTES = 8 * HTB, NXCD = 8, WGM = 8;

__host__ __device__ __forceinline__ int lds_byte(int r, int c) { const int st = (r >> 4) * 2 + (c >> 5), rr = r & 15, cc = c & 31, ob = rr * 64 + cc * 2; return st * 1024 + (ob ^ (((ob >> 9) & 1) << 5)); }
__host__ __device__ __forceinline__ void stage_rc(int b, int& R, int& C) { const int st = b / 1024, sb = b % 1024, swz = sb ^ (((sb >> 9) & 1) << 5); R = (st >> 1) * 16 + swz / 64; C = (st & 1) * 32 + (swz % 64) / 2; }
__host__ __device__ __forceinline__ int perm32(int rho) { const int n = rho >> 4, i = rho & 15; return 8 * (i >> 2) + 4 * n + (i & 3); }

struct Unit { int pm, pn; };
struct Gemm { const bf16_t* A; const bf16_t* Bt; int M, N, K; };

struct StaticOrder {
    int nM, nN, nwg, G, c;
    __host__ __device__ void init(int M, int N, int G_, int c_) { nM = M / BM; nN = N / BM; nwg = nM * nN; G = G_; c = c_; }
    __host__ __device__ bool next(int i, Unit& u) const {
        const long L = (long)i * G + c; if (L >= nwg) return false;
        int wgid = (int)L; { const int q = nwg / NXCD, r = nwg % NXCD, xcd = wgid % NXCD, off = wgid / NXCD; wgid = (xcd < r ? xcd * (q + 1) : r * (q + 1) + (xcd - r) * q) + off; }
        const int nig = WGM * nN, gid = wgid / nig, fm = gid * WGM, gsz = (nM - fm) < WGM ? (nM - fm) : WGM;
        u.pm = fm + ((wgid % nig) % gsz); u.pn = (wgid % nig) / gsz; return true;
    }
    __device__ __forceinline__ void a_ready(const Unit&) const {}
    __device__ __forceinline__ void done(const Unit&) const {}
};
__device__ __forceinline__ unsigned cvt_pk_bf16(float lo, float hi) { unsigned r; asm volatile("v_cvt_pk_bf16_f32 %0, %1, %2" : "=v"(r) : "v"(lo), "v"(hi)); return r; }
__device__ __forceinline__ u32x4 pack8(f32x4 v0, f32x4 v1) { u32x4 w; w.x = cvt_pk_bf16(v0[0], v0[1]); w.y = cvt_pk_bf16(v0[2], v0[3]); w.z = cvt_pk_bf16(v1[0], v1[1]); w.w = cvt_pk_bf16(v1[2], v1[3]); return w; }
__device__ __forceinline__ float silu_f(float g) { return g * __builtin_amdgcn_rcpf(1.0f + __builtin_amdgcn_exp2f(g * -1.4426950408889634f)); }

struct EpiConvIn {
    static constexpr bool PERM = true, AFTER_DRAIN = false;
    bf16_t* Z; bf16_t* GO;
    __device__ __forceinline__ void operator()(const f32x4 (&acc)[2][2][4][2], const Unit& u, int wr, int wc, int fr, int fq) const {
        const int row0 = u.pm * BM + wr * 64 + fr;
        if (u.pn < 16) {
            const int col0 = u.pn * 128 + wc * 32 + 8 * fq;
#pragma unroll
            for (int ai = 0; ai < 2; ++ai)
#pragma unroll
                for (int m = 0; m < 4; ++m) { bf16_t* rowp = Z + (size_t)(row0 + ai * HALF + m * 16) * 2048 + col0;
                    *(u32x4*)rowp = pack8(acc[ai][0][m][0] * acc[ai][1][m][0], acc[ai][0][m][1] * acc[ai][1][m][1]); }
        } else {
            const int col0 = (u.pn - 16) * 256 + wc * 32 + 8 * fq;
#pragma unroll
            for (int ai = 0; ai < 2; ++ai)
#pragma unroll
                for (int m = 0; m < 4; ++m) { bf16_t* rowp = GO + (size_t)(row0 + ai * HALF + m * 16) * 2048 + col0;
#pragma unroll
                    for (int bj = 0; bj < 2; ++bj) *(u32x4*)(rowp + bj * HALF) = pack8(acc[ai][bj][m][0], acc[ai][bj][m][1]); }
        }
    }
};
struct EpiResF32 {
    static constexpr bool PERM = false, AFTER_DRAIN = false;
    const float* R; float* C;
    __device__ __forceinline__ void operator()(const f32x4 (&acc)[2][2][4][2], const Unit& u, int wr, int wc, int fr, int fq) const {
        const int row0 = u.pm * BM + wr * 64 + fr, col0 = u.pn * BM + wc * 32 + 4 * fq;
#pragma unroll
        for (int ai = 0; ai < 2; ++ai)
#pragma unroll
            for (int m = 0; m < 4; ++m) { const size_t ro = (size_t)(row0 + ai * HALF + m * 16) * 2048 + col0;
#pragma unroll
                for (int bj = 0; bj < 2; ++bj)
#pragma unroll
                    for (int n = 0; n < 2; ++n) { const size_t o = ro + bj * HALF + n * 16; *(f32x4*)(C + o) = *(const f32x4*)(R + o) + acc[ai][bj][m][n]; } }
    }
};
struct EpiGateUp {
    static constexpr bool PERM = true, AFTER_DRAIN = false;
    bf16_t* H;
    __device__ __forceinline__ void operator()(const f32x4 (&acc)[2][2][4][2], const Unit& u, int wr, int wc, int fr, int fq) const {
        const int row0 = u.pm * BM + wr * 64 + fr, col0 = (u.pn & 3) * 128 + wc * 32 + 8 * fq;
#pragma unroll
        for (int ai = 0; ai < 2; ++ai)
#pragma unroll
            for (int m = 0; m < 4; ++m) { bf16_t* rowp = H + (size_t)(row0 + ai * HALF + m * 16) * 512 + col0;
                f32x4 v0, v1;
#pragma unroll
                for (int j = 0; j < 4; ++j) { v0[j] = silu_f(acc[ai][0][m][0][j]) * acc[ai][1][m][0][j]; v1[j] = silu_f(acc[ai][0][m][1][j]) * acc[ai][1][m][1][j]; }
                *(u32x4*)rowp = pack8(v0, v1); }
    }
};
struct EpiDown {
    static constexpr bool PERM = true, AFTER_DRAIN = false;
    bf16_t* O;
    __device__ __forceinline__ void operator()(const f32x4 (&acc)[2][2][4][2], const Unit& u, int wr, int wc, int fr, int fq) const {
        const int row0 = u.pm * BM + wr * 64 + fr, col0 = (u.pn & 7) * 256 + wc * 32 + 8 * fq;
#pragma unroll
        for (int ai = 0; ai < 2; ++ai)
#pragma unroll
            for (int m = 0; m < 4; ++m) { bf16_t* rowp = O + (size_t)(row0 + ai * HALF + m * 16) * 2048 + col0;
#pragma unroll
                for (int bj = 0; bj < 2; ++bj) *(u32x4*)(rowp + bj * HALF) = pack8(acc[ai][bj][m][0], acc[ai][bj][m][1]); }
    }
};
struct EpiQKV {
    static constexpr bool PERM = true, AFTER_DRAIN = false;
    bf16_t* Q; size_t tstride; float* NB;
    __device__ __forceinline__ void operator()(const f32x4 (&acc)[2][2][4][2], const Unit& u, int wr, int wc, int fr, int fq) const {
        const int which = u.pn >> 3, hp = u.pn & 7; bf16_t* base = Q + (size_t)which * tstride;
        const int row0 = u.pm * BM + wr * 64 + fr, col0 = wc * 32 + 8 * fq;
#pragma unroll
        for (int bj = 0; bj < 2; ++bj) { bf16_t* hb = base + (size_t)(2 * hp + bj) * SEQ * 128 + col0;
            float pmx = 0.f;
#pragma unroll
            for (int ai = 0; ai < 2; ++ai)
#pragma unroll
                for (int m = 0; m < 4; ++m) { const f32x4 a = acc[ai][bj][m][0], b = acc[ai][bj][m][1];
                    *(u32x4*)(hb + (size_t)(row0 + ai * HALF + m * 16) * 128) = pack8(a, b);
                    if (which < 2) { float p = (a[0] * a[0] + a[1] * a[1]) + (a[2] * a[2] + a[3] * a[3]) + (b[0] * b[0] + b[1] * b[1]) + (b[2] * b[2] + b[3] * b[3]);
                        p += __shfl_xor(p, 16); p += __shfl_xor(p, 32); pmx = fmaxf(pmx, p); } }
            if (which < 2) {
#pragma unroll
                for (int o = 1; o < 16; o <<= 1) pmx = fmaxf(pmx, __shfl_xor(pmx, o));
                if (fr == 0 && fq == 0) NB[((which * 16 + 2 * hp + bj) * 64 + u.pm) * 8 + wr * 4 + wc] = pmx; }
        }
    }
};
struct ExpertOrder {
    const PG8_LAS int* tile_e; int n_units, nN, G, c;
    __device__ __forceinline__ bool next(int i, Unit& u) const {
        const int L = i * G + c; if (L >= n_units) return false;
        const int t = L / nN, j = L - t * nN; u.pm = t; u.pn = tile_e[t] * nN + j; return true;
    }
    __device__ __forceinline__ void a_ready(const Unit&) const {}
    __device__ __forceinline__ void done(const Unit&) const {}
};

template <class Epi, class Sched, bool ALIGN_EPI = false, bool SP2 = false>
__device__ __forceinline__ void gemm_phase(PG8_LAS unsigned char* lds, const Gemm g, const Sched& S, const Epi& E) {
    const int tid = threadIdx.x, wid = __builtin_amdgcn_readfirstlane(tid >> 6), lane = tid & 63, wr = wid >> 2, wc = wid & 3, fr = lane & 15, fq = lane >> 4;
    const int K = g.K, nt = K / BK;
    unsigned voffA[2], voffB[2];
#pragma unroll
    for (int i = 0; i < 2; ++i) { int R, C; stage_rc(tid * 16 + i * 8192, R, C); const int Rb = Epi::PERM ? ((R & ~31) + perm32(R & 31)) : R;
        voffA[i] = (unsigned)(R * K + C) * 2u; voffB[i] = (unsigned)(Rb * K + C) * 2u; }
    const size_t kstep = (size_t)(BK * 2);
    const size_t hstep = (size_t)HALF * K * 2;
    const size_t tstep = 2 * hstep;
    const unsigned ldsw = (unsigned)wid * 1024u;
    const int aoff = lds_byte(wr * 64 + fr, fq * 8), boff = lds_byte(wc * 32 + fr, fq * 8);
#define PG8_SA(b, h) (((b) * 2 + (h)) * HTB)
#define PG8_SB(b, h) ((4 + (b) * 2 + (h)) * HTB)
#define PG8_STAGE(bufoff, gbase, voff) do { _Pragma("unroll") for (int _i = 0; _i < 2; ++_i) \
        __builtin_amdgcn_global_load_lds((const unsigned*)((const char*)(gbase) + (voff)[_i]), (PG8_LAS unsigned*)(lds + (bufoff) + ldsw + _i * 8192), 16, 0, 0); } while (0)
#define PG8_LDA(dst, b, h) do { _Pragma("unroll") for (int m = 0; m < 4; ++m) _Pragma("unroll") for (int k = 0; k < 2; ++k) dst[m][k] = *(const PG8_LAS bf16x8*)(lds + PG8_SA(b, h) + aoff + m * 2048 + k * 1024); } while (0)
#define PG8_LDB(dst, b, h) do { _Pragma("unroll") for (int n = 0; n < 2; ++n) _Pragma("unroll") for (int k = 0; k < 2; ++k) dst[n][k] = *(const PG8_LAS bf16x8*)(lds + PG8_SB(b, h) + boff + n * 2048 + k * 1024); } while (0)
#define PG8_MMA(ai, bj, At, Bt) do { __builtin_amdgcn_s_setprio(1); _Pragma("unroll") for (int m = 0; m < 4; ++m) _Pragma("unroll") for (int n = 0; n < 2; ++n) _Pragma("unroll") for (int k = 0; k < 2; ++k) \
        acc[ai][bj][m][n] = __builtin_amdgcn_mfma_f32_16x16x32_bf16(Bt[n][k], At[m][k], acc[ai][bj][m][n], 0, 0, 0); __builtin_amdgcn_s_setprio(0); } while (0)
#define PG8_WAIT_V(n) asm volatile("s_waitcnt vmcnt(" #n ")" ::: "memory")
#define PG8_WAIT_L(n) asm volatile("s_waitcnt lgkmcnt(" #n ")" ::: "memory")
#define PG8_BAR __builtin_amdgcn_s_barrier()
#define PG8_SCHED __builtin_amdgcn_sched_barrier(0)
    Unit cur, nxt; int ui = 0;
    if (!S.next(0, cur)) return;
    f32x4 acc[2][2][4][2];
#pragma unroll
    for (int a = 0; a < 2; ++a)
#pragma unroll
        for (int b = 0; b < 2; ++b)
#pragma unroll
            for (int m = 0; m < 4; ++m)
#pragma unroll
                for (int n = 0; n < 2; ++n) acc[a][b][m][n] = (f32x4){0.f, 0.f, 0.f, 0.f};
    bf16x8 At[4][2], B0[2][2], B1[2][2];
    const char* cA = (const char*)g.A + (size_t)cur.pm * tstep; const char* cB = (const char*)g.Bt + (size_t)cur.pn * tstep;
    S.a_ready(cur);
    if constexpr (SP2) {
        PG8_STAGE(PG8_SB(0, 0), cB, voffB); PG8_STAGE(PG8_SB(0, 1), cB + hstep, voffB); PG8_STAGE(PG8_SA(0, 0), cA, voffA); PG8_STAGE(PG8_SA(0, 1), cA + hstep, voffA);
        if (wr == 1) PG8_BAR;
        PG8_WAIT_V(2); PG8_BAR;
        PG8_STAGE(PG8_SB(1, 0), cB + kstep, voffB); PG8_STAGE(PG8_SA(1, 0), cA + kstep, voffA); PG8_STAGE(PG8_SB(1, 1), cB + hstep + kstep, voffB);
        PG8_WAIT_V(6); PG8_BAR;
    } else {
        PG8_STAGE(PG8_SB(0, 0), cB, voffB); PG8_STAGE(PG8_SA(0, 0), cA, voffA); PG8_STAGE(PG8_SB(0, 1), cB + hstep, voffB); PG8_STAGE(PG8_SA(0, 1), cA + hstep, voffA);
        if (wr == 1) PG8_BAR;
        PG8_WAIT_V(4); PG8_BAR;
        PG8_STAGE(PG8_SB(1, 0), cB + kstep, voffB); PG8_STAGE(PG8_SA(1, 0), cA + kstep, voffA); PG8_STAGE(PG8_SB(1, 1), cB + hstep + kstep, voffB);
        PG8_WAIT_V(6); PG8_BAR;
    }
    for (;;) {
        const bool has_next = S.next(ui + 1, nxt);
        const char* nA = has_next ? (const char*)g.A + (size_t)nxt.pm * tstep : cA; const char* nB = has_next ? (const char*)g.Bt + (size_t)nxt.pn * tstep : cB;
        for (int t = 0; t < nt; t += 2) {
            const bool last = (t == nt - 2);
            const char* a1 = cA + (size_t)(t + 1) * kstep;
            const char* a2 = last ? nA : cA + (size_t)(t + 2) * kstep; const char* b2 = last ? nB : cB + (size_t)(t + 2) * kstep;
            const char* a3 = a2 + kstep; const char* b3 = b2 + kstep;
            if (last && has_next) S.a_ready(nxt);
            if constexpr (SP2) {
            PG8_LDB(B0, 0, 0); PG8_LDB(B1, 0, 1); PG8_SCHED; PG8_LDA(At, 0, 0); PG8_STAGE(PG8_SA(1, 1), a1 + hstep, voffA);
            PG8_WAIT_V(8); PG8_WAIT_L(0); PG8_BAR; PG8_MMA(0, 0, At, B0); PG8_MMA(0, 1, At, B1); PG8_BAR; PG8_SCHED;
            PG8_LDA(At, 0, 1); PG8_STAGE(PG8_SB(0, 0), b2, voffB); PG8_STAGE(PG8_SB(0, 1), b2 + hstep, voffB); PG8_STAGE(PG8_SA(0, 0), a2, voffA);
            PG8_WAIT_V(8); PG8_WAIT_L(0); PG8_BAR; PG8_MMA(1, 0, At, B0); PG8_MMA(1, 1, At, B1); PG8_BAR; PG8_SCHED;
            PG8_LDB(B0, 1, 0); PG8_LDB(B1, 1, 1); PG8_SCHED; PG8_LDA(At, 1, 0); PG8_STAGE(PG8_SA(0, 1), a2 + hstep, voffA);
            PG8_WAIT_V(8); PG8_WAIT_L(0); PG8_BAR; PG8_MMA(0, 0, At, B0); PG8_MMA(0, 1, At, B1); PG8_BAR; PG8_SCHED;
            PG8_LDA(At, 1, 1); PG8_STAGE(PG8_SB(1, 0), b3, voffB); PG8_STAGE(PG8_SB(1, 1), b3 + hstep, voffB); PG8_STAGE(PG8_SA(1, 0), a3, voffA);
            PG8_WAIT_V(8); PG8_WAIT_L(0); PG8_BAR; PG8_MMA(1, 0, At, B0); PG8_MMA(1, 1, At, B1); PG8_BAR; PG8_SCHED;
            } else {
            PG8_LDB(B0, 0, 0); PG8_SCHED; PG8_LDA(At, 0, 0); PG8_STAGE(PG8_SA(1, 1), a1 + hstep, voffA);
            PG8_WAIT_L(8); PG8_BAR; PG8_WAIT_L(0); PG8_MMA(0, 0, At, B0); PG8_BAR; PG8_SCHED;
            PG8_LDB(B1, 0, 1); PG8_STAGE(PG8_SB(0, 0), b2, voffB);
            PG8_BAR; PG8_WAIT_L(0); PG8_MMA(0, 1, At, B1); PG8_BAR;
            PG8_LDA(At, 0, 1); PG8_STAGE(PG8_SA(0, 0), a2, voffA);
            PG8_BAR; PG8_WAIT_L(0); PG8_MMA(1, 0, At, B0); PG8_BAR; PG8_SCHED;
            PG8_STAGE(PG8_SB(0, 1), b2 + hstep, voffB);
            PG8_WAIT_V(6); PG8_BAR; PG8_MMA(1, 1, At, B1); PG8_BAR;
            PG8_LDB(B0, 1, 0); PG8_SCHED; PG8_LDA(At, 1, 0); PG8_STAGE(PG8_SA(0, 1), a2 + hstep, voffA);
            PG8_WAIT_L(8); PG8_BAR; PG8_WAIT_L(0); PG8_MMA(0, 0, At, B0); PG8_BAR; PG8_SCHED;
            PG8_LDB(B1, 1, 1); PG8_STAGE(PG8_SB(1, 0), b3, voffB);
            PG8_BAR; PG8_WAIT_L(0); PG8_MMA(0, 1, At, B1); PG8_BAR;
            PG8_LDA(At, 1, 1); PG8_STAGE(PG8_SA(1, 0), a3, voffA);
            PG8_BAR; PG8_WAIT_L(0); PG8_MMA(1, 0, At, B0); PG8_BAR; PG8_SCHED;
            PG8_STAGE(PG8_SB(1, 1), b3 + hstep, voffB);
            PG8_WAIT_V(6); PG8_BAR; PG8_MMA(1, 1, At, B1); PG8_BAR;
            }
        }
        if constexpr (ALIGN_EPI) { if (wr == 0) PG8_BAR; }
        if constexpr (!Epi::AFTER_DRAIN) { E(acc, cur, wr, wc, fr, fq); S.done(cur); }
        if (!has_next) break;
#pragma unroll
        for (int a = 0; a < 2; ++a)
#pragma unroll
            for (int b = 0; b < 2; ++b)
#pragma unroll
                for (int m = 0; m < 4; ++m)
#pragma unroll
                    for (int n = 0; n < 2; ++n) acc[a][b][m][n] = (f32x4){0.f, 0.f, 0.f, 0.f};
        cur = nxt; cA = nA; cB = nB; ++ui;
        if constexpr (ALIGN_EPI) { if (wr == 1) PG8_BAR; }
    }
    PG8_WAIT_V(0);
    if constexpr (!ALIGN_EPI) { if (wr == 0) PG8_BAR; }
    PG8_BAR;
    if constexpr (Epi::AFTER_DRAIN) { E.fused(acc, cur, wr, wc, fr, fq, lds, wid, lane); S.done(cur); }
#undef PG8_SA
#undef PG8_SB
#undef PG8_STAGE
#undef PG8_LDA
#undef PG8_LDB
#undef PG8_MMA
#undef PG8_WAIT_V
#undef PG8_WAIT_L
#undef PG8_BAR
#undef PG8_SCHED
}
template <class Epi, class Sched>
__device__ __forceinline__ void gemm_phase_gather(PG8_LAS unsigned char* lds, const Gemm g, const Sched& S, const Epi& E, const PG8_LAS unsigned* rtok) {
    const int tid = threadIdx.x, wid = __builtin_amdgcn_readfirstlane(tid >> 6), lane = tid & 63, wr = wid >> 2, wc = wid & 3, fr = lane & 15, fq = lane >> 4;
    const int K = g.K, nt = K / BK;
    unsigned voffB[2];
#pragma unroll
    for (int i = 0; i < 2; ++i) { int R, C; stage_rc(tid * 16 + i * 8192, R, C); const int Rb = Epi::PERM ? ((R & ~31) + perm32(R & 31)) : R;
        voffB[i] = (unsigned)(Rb * K + C) * 2u; }
    unsigned vA[2][2], vN[2][2];
    const size_t kstep = (size_t)(BK * 2);
    const size_t hstep = (size_t)HALF * K * 2;
    const size_t tstep = 2 * hstep;
    const unsigned ldsw = (unsigned)wid * 1024u;
    const int aoff = lds_byte(wr * 64 + fr, fq * 8), boff = lds_byte(wc * 32 + fr, fq * 8);
#define PG8_SA(b, h) (((b) * 2 + (h)) * HTB)
#define PG8_SB(b, h) ((4 + (b) * 2 + (h)) * HTB)
#define PG8_STAGE(bufoff, gbase, voff) do { _Pragma("unroll") for (int _i = 0; _i < 2; ++_i) \
        __builtin_amdgcn_global_load_lds((const unsigned*)((const char*)(gbase) + (voff)[_i]), (PG8_LAS unsigned*)(lds + (bufoff) + ldsw + _i * 8192), 16, 0, 0); } while (0)
#define PG8_STAGE_A(bufoff, kptr, h, usenext) do { _Pragma("unroll") for (int _i = 0; _i < 2; ++_i) \
        __builtin_amdgcn_global_load_lds((const unsigned*)((const char*)(kptr) + ((usenext) ? vN[h][_i] : vA[h][_i])), (PG8_LAS unsigned*)(lds + (bufoff) + ldsw + _i * 8192), 16, 0, 0); } while (0)
#define PG8_LDA(dst, b, h) do { _Pragma("unroll") for (int m = 0; m < 4; ++m) _Pragma("unroll") for (int k = 0; k < 2; ++k) dst[m][k] = *(const PG8_LAS bf16x8*)(lds + PG8_SA(b, h) + aoff + m * 2048 + k * 1024); } while (0)
#define PG8_LDB(dst, b, h) do { _Pragma("unroll") for (int n = 0; n < 2; ++n) _Pragma("unroll") for (int k = 0; k < 2; ++k) dst[n][k] = *(const PG8_LAS bf16x8*)(lds + PG8_SB(b, h) + boff + n * 2048 + k * 1024); } while (0)
#define PG8_MMA(ai, bj, At, Bt) do { __builtin_amdgcn_s_setprio(1); _Pragma("unroll") for (int m = 0; m < 4; ++m) _Pragma("unroll") for (int n = 0; n < 2; ++n) _Pragma("unroll") for (int k = 0; k < 2; ++k) \
        acc[ai][bj][m][n] = __builtin_amdgcn_mfma_f32_16x16x32_bf16(Bt[n][k], At[m][k], acc[ai][bj][m][n], 0, 0, 0); __builtin_amdgcn_s_setprio(0); } while (0)
#define PG8_WAIT_V(n) asm volatile("s_waitcnt vmcnt(" #n ")" ::: "memory")
#define PG8_WAIT_L(n) asm volatile("s_waitcnt lgkmcnt(" #n ")" ::: "memory")
#define PG8_BAR __builtin_amdgcn_s_barrier()
#define PG8_SCHED __builtin_amdgcn_sched_barrier(0)
#define PG8_LOADTOK(dst, ui_) do { int tz_ = threadIdx.x; asm volatile("" : "+v"(tz_)); _Pragma("unroll") for (int i_ = 0; i_ < 2; ++i_) { int R_, C_; stage_rc(tz_ * 16 + i_ * 8192, R_, C_); \
        _Pragma("unroll") for (int h_ = 0; h_ < 2; ++h_) dst[h_][i_] = rtok[(ui_) * 256 + h_ * 128 + R_] + (unsigned)C_ * 2u; } } while (0)
    Unit cur, nxt; int ui = 0;
    if (!S.next(0, cur)) return;
    f32x4 acc[2][2][4][2];
#pragma unroll
    for (int a = 0; a < 2; ++a)
#pragma unroll
        for (int b = 0; b < 2; ++b)
#pragma unroll
            for (int m = 0; m < 4; ++m)
#pragma unroll
                for (int n = 0; n < 2; ++n) acc[a][b][m][n] = (f32x4){0.f, 0.f, 0.f, 0.f};
    bf16x8 At[4][2], B0[2][2], B1[2][2];
    const char* const gA = (const char*)g.A; const char* cB = (const char*)g.Bt + (size_t)cur.pn * tstep;
    PG8_LOADTOK(vA, 0);
#pragma unroll
    for (int h_ = 0; h_ < 2; ++h_)
#pragma unroll
        for (int i_ = 0; i_ < 2; ++i_) vN[h_][i_] = vA[h_][i_];
    PG8_STAGE(PG8_SB(0, 0), cB, voffB); PG8_STAGE(PG8_SB(0, 1), cB + hstep, voffB); PG8_STAGE_A(PG8_SA(0, 0), gA, 0, false); PG8_STAGE_A(PG8_SA(0, 1), gA, 1, false);
    if (wr == 1) PG8_BAR;
    PG8_WAIT_V(2); PG8_BAR;
    PG8_STAGE(PG8_SB(1, 0), cB + kstep, voffB); PG8_STAGE_A(PG8_SA(1, 0), gA + kstep, 0, false); PG8_STAGE(PG8_SB(1, 1), cB + hstep + kstep, voffB);
    PG8_WAIT_V(6); PG8_BAR;
    for (;;) {
        const bool has_next = S.next(ui + 1, nxt);
        const char* nB = has_next ? (const char*)g.Bt + (size_t)nxt.pn * tstep : cB;
        for (int t = 0; t < nt; t += 2) {
            const bool last = (t == nt - 2);
            const char* a1 = gA + (size_t)(t + 1) * kstep;
            const char* a2 = last ? gA : gA + (size_t)(t + 2) * kstep; const char* b2 = last ? nB : cB + (size_t)(t + 2) * kstep;
            const char* a3 = a2 + kstep; const char* b3 = b2 + kstep;
            if (last && has_next) PG8_LOADTOK(vN, ui + 1);
            const bool un = last && has_next;
            PG8_LDB(B0, 0, 0); PG8_LDB(B1, 0, 1); PG8_SCHED; PG8_LDA(At, 0, 0); PG8_STAGE_A(PG8_SA(1, 1), a1, 1, false);
            PG8_WAIT_V(8); PG8_WAIT_L(0); PG8_BAR; PG8_MMA(0, 0, At, B0); PG8_MMA(0, 1, At, B1); PG8_BAR; PG8_SCHED;
            PG8_LDA(At, 0, 1); PG8_STAGE(PG8_SB(0, 0), b2, voffB); PG8_STAGE(PG8_SB(0, 1), b2 + hstep, voffB); PG8_STAGE_A(PG8_SA(0, 0), a2, 0, un);
            PG8_WAIT_V(8); PG8_WAIT_L(0); PG8_BAR; PG8_MMA(1, 0, At, B0); PG8_MMA(1, 1, At, B1); PG8_BAR; PG8_SCHED;
            PG8_LDB(B0, 1, 0); PG8_LDB(B1, 1, 1); PG8_SCHED; PG8_LDA(At, 1, 0); PG8_STAGE_A(PG8_SA(0, 1), a2, 1, un);
            PG8_WAIT_V(8); PG8_WAIT_L(0); PG8_BAR; PG8_MMA(0, 0, At, B0); PG8_MMA(0, 1, At, B1); PG8_BAR; PG8_SCHED;
            PG8_LDA(At, 1, 1); PG8_STAGE(PG8_SB(1, 0), b3, voffB); PG8_STAGE(PG8_SB(1, 1), b3 + hstep, voffB); PG8_STAGE_A(PG8_SA(1, 0), a3, 0, un);
            PG8_WAIT_V(8); PG8_WAIT_L(0); PG8_BAR; PG8_MMA(1, 0, At, B0); PG8_MMA(1, 1, At, B1); PG8_BAR; PG8_SCHED;
        }
        if (wr == 0) PG8_BAR;
        E(acc, cur, wr, wc, fr, fq);
        if (!has_next) break;
#pragma unroll
        for (int a = 0; a < 2; ++a)
#pragma unroll
            for (int b = 0; b < 2; ++b)
#pragma unroll
                for (int m = 0; m < 4; ++m)
#pragma unroll
                    for (int n = 0; n < 2; ++n) acc[a][b][m][n] = (f32x4){0.f, 0.f, 0.f, 0.f};
        cur = nxt; cB = nB; ++ui;
#pragma unroll
        for (int h_ = 0; h_ < 2; ++h_)
#pragma unroll
            for (int i_ = 0; i_ < 2; ++i_) vA[h_][i_] = vN[h_][i_];
        if (wr == 1) PG8_BAR;
    }
    PG8_WAIT_V(0);
    PG8_BAR;
#undef PG8_SA
#undef PG8_SB
#undef PG8_STAGE
#undef PG8_STAGE_A
#undef PG8_LDA
#undef PG8_LDB
#undef PG8_MMA
#undef PG8_WAIT_V
#undef PG8_WAIT_L
#undef PG8_BAR
#undef PG8_SCHED
#undef PG8_LOADTOK
}
}
namespace fox {
#define FOX_LAS __attribute__((address_space(3)))
typedef unsigned short bf16;
typedef short bf16x8 __attribute__((ext_vector_type(8)));
typedef short s16x4 __attribute__((ext_vector_type(4)));
typedef float f32x16 __attribute__((ext_vector_type(16)));
typedef float f32x4 __attribute__((ext_vector_type(4)));
typedef unsigned u32x4 __attribute__((ext_vector_type(4)));
constexpr int D = 128, OPITCH = 2048;
constexpr float SCALE = 0.08838834764831845f;
constexpr float THR = 8.f;
constexpr int NW = 8, QBLK = 32, KVBLK = 64, QB = NW * QBLK;
constexpr int SHM_V = KVBLK * D * 2, SHM_K = KVBLK * D * 2, SHM_X = KVBLK * 4;
constexpr int JLO_OFF = 73728, KN2_OFF = JLO_OFF + 2048, NXT_OFF = KN2_OFF + 4096;
constexpr int LDS_WS_OFF = 2 * SHM_V + 2 * SHM_K, LDS_X_OFF = LDS_WS_OFF + NW * 64 * 4, LDS_BYTES = LDS_X_OFF + 2 * SHM_X;

#define KSWZ(row, colB) ((row) * 256 + ((colB) ^ (((row) & 7) << 4)))
#define SBAR() __builtin_amdgcn_sched_barrier(0)
__device__ __forceinline__ int v_st(int k, int c) { const int kk = (k & ~0xC) | ((k & 4) << 1) | ((k & 8) >> 1); return ((kk >> 3) * 4 + (c >> 5)) * 512 + ((kk & 7) * 32 + (c & 31)) * 2; }
__device__ __forceinline__ int v_rd_base(int lane) { return ((lane & 3) << 3) | (((lane >> 2) & 3) << 6) | (((lane >> 4) & 1) << 5) | (((lane >> 5) & 1) << 8); }
constexpr int v_rd_off(int d0, int ks, int half) { return d0 * 512 + ks * 4096 + half * 2048; }
__device__ __forceinline__ int crow(int r, int hi) { return (r & 3) + 8 * (r >> 2) + 4 * hi; }
__device__ __forceinline__ unsigned cvtpk(float lo, float hi) { unsigned r; asm volatile("v_cvt_pk_bf16_f32 %0, %1, %2" : "=v"(r) : "v"(lo), "v"(hi)); return r; }
__device__ __forceinline__ bf16x8 load8(const bf16* p) { return *reinterpret_cast<const bf16x8*>(p); }
__device__ __forceinline__ void glds4(const void* gsrc, unsigned lds_dst) { unsigned keep;
    asm volatile("s_mov_b32 %0, m0\n\ts_mov_b32 m0, %2\n\ts_nop 0\n\tglobal_load_lds_dword %1, off\n\ts_mov_b32 m0, %0" : "=&s"(keep) : "v"(gsrc), "s"(lds_dst) : "memory"); }
__device__ __forceinline__ void mask_tile(f32x16& p0, f32x16& p1, int dq) {
    const float NEG = -__builtin_inff();
#pragma unroll
    for (int r = 0; r < 16; ++r) {
        const int c = (r & 3) + 8 * (r >> 2);
        if (dq - c < 0) p0[r] = NEG;
        if (dq - c - 32 < 0) p1[r] = NEG;
    }
}
__device__ __forceinline__ void partialSM(f32x16& p0, f32x16& p1, float& m_reg, float& mn, float& alpha) {
    float pmax = p0[0]; for (int r = 1; r < 16; ++r) pmax = fmaxf(pmax, p0[r]); for (int r = 0; r < 16; ++r) pmax = fmaxf(pmax, p1[r]);
    { auto rr = __builtin_amdgcn_permlane32_swap(__float_as_uint(pmax), __float_as_uint(pmax), false, false);
      pmax = fmaxf(__uint_as_float(rr[0]), __uint_as_float(rr[1])); }
    constexpr float C2 = 1.4426950408889634f * SCALE;
    if (__builtin_expect(__all((pmax - m_reg) * SCALE <= THR), 1)) { mn = m_reg; alpha = 1.f; }
    else { mn = fmaxf(m_reg, pmax); alpha = __builtin_amdgcn_exp2f((m_reg - mn) * C2); m_reg = mn; }
    const float mnL = -mn * C2;
    for (int r = 0; r < 16; ++r) p0[r] = fmaf(p0[r], C2, mnL); for (int r = 0; r < 16; ++r) p1[r] = fmaf(p1[r], C2, mnL);
    for (int r = 0; r < 16; ++r) p0[r] = __builtin_amdgcn_exp2f(p0[r]);
}
__device__ __forceinline__ void finishSM(f32x16& p0, f32x16& p1, float alpha, float& l_reg, bf16x8& pa0, bf16x8& pa1, bf16x8& pa2, bf16x8& pa3) {
    for (int r = 0; r < 16; ++r) p1[r] = __builtin_amdgcn_exp2f(p1[r]);
    float ps = 0; for (int r = 0; r < 16; ++r) ps += p0[r]; for (int r = 0; r < 16; ++r) ps += p1[r];
    { auto rr = __builtin_amdgcn_permlane32_swap(__float_as_uint(ps), __float_as_uint(ps), false, false);
      ps = __uint_as_float(rr[0]) + __uint_as_float(rr[1]); }
    l_reg = l_reg * alpha + ps;
#define PK4(P, B_, OUT) do { unsigned a0 = cvtpk(P[B_+0], P[B_+1]), a1 = cvtpk(P[B_+2], P[B_+3]);                          \
        unsigned b0 = cvtpk(P[B_+4], P[B_+5]), b1 = cvtpk(P[B_+6], P[B_+7]);                                             \
        auto r0 = __builtin_amdgcn_permlane32_swap(a0, b0, false, false); auto r1 = __builtin_amdgcn_permlane32_swap(a1, b1, false, false); \
        u32x4 w = {r0[0], r1[0], r0[1], r1[1]}; OUT = *reinterpret_cast<bf16x8*>(&w); } while (0)
    PK4(p0, 0, pa0); PK4(p0, 8, pa1); PK4(p1, 0, pa2); PK4(p1, 8, pa3);
#undef PK4
}
template <int KB>
__device__ __forceinline__ void qkt(f32x16& p0, f32x16& p1, const char* K_lds, const char* X_lds, int r32, int hi, const bf16x8* qr) {
    { const char* xb = X_lds + KB * SHM_X + hi * 16;
#pragma unroll
      for (int g = 0; g < 4; ++g) { const f32x4 a = *reinterpret_cast<const f32x4*>(xb + g * 32), b = *reinterpret_cast<const f32x4*>(xb + 128 + g * 32);
          p0[4 * g] = a[0]; p0[4 * g + 1] = a[1]; p0[4 * g + 2] = a[2]; p0[4 * g + 3] = a[3]; p1[4 * g] = b[0]; p1[4 * g + 1] = b[1]; p1[4 * g + 2] = b[2]; p1[4 * g + 3] = b[3]; } }
    const char* kb[4];
#pragma unroll
    for (int dd = 0; dd < 4; ++dd) kb[dd] = K_lds + KB * SHM_K + KSWZ(r32, (dd * 16 + hi * 8) * 2);
#pragma unroll
    for (int d0 = 0; d0 < 8; ++d0) { const char* a = kb[d0 & 3] + (d0 >> 2) * 128;
        bf16x8 b0 = *reinterpret_cast<const bf16x8*>(a);
        bf16x8 b1 = *reinterpret_cast<const bf16x8*>(a + 32 * 256);
        p0 = __builtin_amdgcn_mfma_f32_32x32x16_bf16(b0, qr[d0], p0, 0, 0, 0);
        p1 = __builtin_amdgcn_mfma_f32_32x32x16_bf16(b1, qr[d0], p1, 0, 0, 0); }
}
template <int VB>
__device__ __forceinline__ void pv_tile(f32x16* o, int vb0, bf16x8 pa0, bf16x8 pa1, bf16x8 pa2, bf16x8 pa3) {
#define TRRD(dst, off) asm volatile("ds_read_b64_tr_b16 %0, %1 offset:%2" : "=&v"(dst) : "v"(vb0), "i"(off) : "memory")
#define PV_D0(d0) do { s16x4 l0, l1, l2, l3, h0, h1, h2, h3; constexpr int b_ = VB * SHM_V + v_rd_off(d0, 0, 0);     \
        TRRD(l0, b_); TRRD(h0, b_ + 2048); TRRD(l1, b_ + 4096); TRRD(h1, b_ + 6144); TRRD(l2, b_ + 8192); TRRD(h2, b_ + 10240); TRRD(l3, b_ + 12288); TRRD(h3, b_ + 14336); \
        asm volatile("s_waitcnt lgkmcnt(0)" ::: "memory"); SBAR();                                                        \
        o[d0] = __builtin_amdgcn_mfma_f32_32x32x16_bf16(pa0, (bf16x8){l0[0], l0[1], l0[2], l0[3], h0[0], h0[1], h0[2], h0[3]}, o[d0], 0, 0, 0);   \
        o[d0] = __builtin_amdgcn_mfma_f32_32x32x16_bf16(pa1, (bf16x8){l1[0], l1[1], l1[2], l1[3], h1[0], h1[1], h1[2], h1[3]}, o[d0], 0, 0, 0);   \
        o[d0] = __builtin_amdgcn_mfma_f32_32x32x16_bf16(pa2, (bf16x8){l2[0], l2[1], l2[2], l2[3], h2[0], h2[1], h2[2], h2[3]}, o[d0], 0, 0, 0);   \
        o[d0] = __builtin_amdgcn_mfma_f32_32x32x16_bf16(pa3, (bf16x8){l3[0], l3[1], l3[2], l3[3], h3[0], h3[1], h3[2], h3[3]}, o[d0], 0, 0, 0); } while (0)
    PV_D0(0); PV_D0(1); PV_D0(2); PV_D0(3);
#undef PV_D0
#undef TRRD
}
struct Bases { const bf16* Q; const bf16* K; const bf16* V; const float* KX; bf16* O; };
struct BlockRef { int h, qb, jlo; };
constexpr int SEQL = 16384;
#define REF_Q(B_, r) ((B_).Q + ((size_t)(r).h * SEQL + (size_t)(r).qb * QB) * D)
#define REF_K(B_, r) ((B_).K + (size_t)(r).h * SEQL * D)
#define REF_V(B_, r) ((B_).V + (size_t)(r).h * SEQL * D)
#define REF_X(B_, r) ((B_).KX + (size_t)(r).h * SEQL)
#define REF_O(B_, r) ((B_).O + (size_t)(r).qb * QB * OPITCH + (r).h * D)
struct Seam { bf16x8 qr[8]; bf16x8 st_v0, st_v1, st_k0, st_k1; };
#define ROW(p, k0, rr) ((p) + (size_t)((k0) + (rr)) * D + sc)
#define VMW() asm volatile("s_waitcnt vmcnt(0)" ::: "memory")
#define VMWN(n) asm volatile("s_waitcnt vmcnt(%0)" :: "i"(n) : "memory")
#define SLOAD_H(Kp, Vp, k0) do { S.st_v0 = load8(ROW(Vp, k0, sr)); S.st_v1 = load8(ROW(Vp, k0, 32 + sr));              \
                         S.st_k0 = load8(ROW(Kp, k0, sr)); S.st_k1 = load8(ROW(Kp, k0, 32 + sr)); } while (0)
#define XDMA(Xp, k0, bf) do { if (wid == 0) glds4((Xp) + (k0) + lane, x_l32 + (bf) * SHM_X); } while (0)
#define SWRITE_HK(bf) do { int tz_ = threadIdx.x; asm volatile("" : "+v"(tz_)); const int kws_ = KSWZ(tz_ >> 4, (tz_ & 15) * 16);                                   \
        *(bf16x8*)(K_lds + (bf) * SHM_K + kws_) = S.st_k0; *(bf16x8*)(K_lds + (bf) * SHM_K + kws_ + 32 * 256) = S.st_k1; } while (0)
#define SWRITE_HV(bf) do { int tz_ = threadIdx.x; asm volatile("" : "+v"(tz_)); const int sr_ = tz_ >> 4, sc_ = (tz_ & 15) * 8;                                      \
        *(bf16x8*)(V_lds + (bf) * SHM_V + v_st(sr_, sc_)) = S.st_v0; *(bf16x8*)(V_lds + (bf) * SHM_V + v_st(32 + sr_, sc_)) = S.st_v1; } while (0)
#define SWRITE_H(bf) do { SWRITE_HV(bf); SWRITE_HK(bf); } while (0)
__device__ __forceinline__ void fox_prime(const Bases& BS, const BlockRef& cur, char* lds, unsigned lds32, Seam& S) {
    const int tid = threadIdx.x, wid = __builtin_amdgcn_readfirstlane(tid >> 6), lane = tid & 63, r32 = lane & 31, hi = lane >> 5;
    const int sr = tid >> 4, sc = (tid & 15) * 8; char* K_lds = lds + 2 * SHM_V; const unsigned x_l32 = lds32 + LDS_X_OFF;
    const int kb0 = cur.jlo * KVBLK;
    for (int d0 = 0; d0 < 8; ++d0) S.qr[d0] = load8(REF_Q(BS, cur) + (size_t)(wid * QBLK + r32) * D + d0 * 16 + hi * 8);
    SLOAD_H(REF_K(BS, cur), REF_V(BS, cur), kb0); XDMA(REF_X(BS, cur), kb0, 0); VMW(); SWRITE_HK(0);
    __syncthreads();
}
__device__ __forceinline__ void fox_block(const Bases& BS, const BlockRef& cur, char* lds, unsigned lds32, Seam& S, BlockRef& nxo) {
    const int tid = threadIdx.x, wid = __builtin_amdgcn_readfirstlane(tid >> 6), lane = tid & 63, r32 = lane & 31, hi = lane >> 5;
    const int j_lo = cur.jlo;
    const int P0 = cur.qb * QB;
    const int j_hi = (P0 + QB - 1) / KVBLK + 1;
    const int NT = j_hi - j_lo;
    const int qlo = P0 + wid * QBLK, qm = qlo + r32 - 4 * hi;
    char* V_lds = lds; char* K_lds = lds + 2 * SHM_V; const char* X_lds = lds + LDS_X_OFF; const unsigned x_l32 = lds32 + LDS_X_OFF;
    float* ws = (float*)(lds + LDS_WS_OFF) + wid * 64; float* li_l = ws, * al_l = ws + 32;
    float m_reg = -1e30f, l_reg = 0; f32x16 o[4] = {};
    const int sr = tid >> 4, sc = (tid & 15) * 8;
    const int vb0 = (int)lds32 + v_rd_base(lane);
    const bf16* Kh = REF_K(BS, cur); const bf16* Vh = REF_V(BS, cur); const float* Xh = REF_X(BS, cur);
#define RESC(a) do { if (__any((a) < 1.f)) { if (hi == 0) al_l[r32] = (a); asm volatile("s_waitcnt lgkmcnt(0)" ::: "memory");              \
                     for (int d_ = 0; d_ < 4; ++d_) for (int r = 0; r < 16; ++r) o[d_][r] *= al_l[crow(r, hi)]; } } while (0)
#define KBASE(t) ((j_lo + (t)) * KVBLK)
#define MASKT(P0_, P1_, t) do { const int kb_ = KBASE(t); if (kb_ + KVBLK - 1 > qlo) mask_tile(P0_, P1_, qm - kb_); } while (0)
    constexpr int NQL = 8;
#define SEAM_K0() do { VMWN(NQL); SWRITE_HK(0); SBAR(); } while (0)
    f32x16 pA0, pA1, pB0, pB1; float mnA, mnB, alA, alB; bf16x8 pa0, pa1, pa2, pa3;
    SWRITE_HV(0); SBAR();
    if (NT > 1) { SLOAD_H(Kh, Vh, KBASE(1)); XDMA(Xh, KBASE(1), 1); }
    SBAR(); qkt<0>(pA0, pA1, K_lds, X_lds, r32, hi, S.qr);
    MASKT(pA0, pA1, 0); partialSM(pA0, pA1, m_reg, mnA, alA);
    if (NT > 1) { VMW(); SWRITE_H(1); }
    __syncthreads();
#define HALF_STEP(PX0, PX1, mnX, alX, PY0, PY1, alY, t, KB, VB, SB) do {                                                      \
        SBAR(); qkt<KB>(PX0, PX1, K_lds, X_lds, r32, hi, S.qr);                                                           \
        finishSM(PY0, PY1, alY, l_reg, pa0, pa1, pa2, pa3); SBAR();                                                           \
        if ((t) + 1 < NT) { SLOAD_H(Kh, Vh, KBASE((t) + 1)); XDMA(Xh, KBASE((t) + 1), SB); SBAR(); }                          \
        pv_tile<VB>(o, vb0, pa0, pa1, pa2, pa3); MASKT(PX0, PX1, (t)); partialSM(PX0, PX1, m_reg, mnX, alX);                  \
        __syncthreads();                                                                                                      \
        if ((t) + 1 < NT) { VMW(); SWRITE_H(SB); }                                                                            \
        RESC(alX); __syncthreads(); } while (0)
    for (int t = 1; t + 1 < NT; t += 2) {
        HALF_STEP(pB0, pB1, mnB, alB, pA0, pA1, alA, t, 1, 0, 0);
        HALF_STEP(pA0, pA1, mnA, alA, pB0, pB1, alB, t + 1, 0, 1, 1);
    }
    const bool even = (NT & 1) == 0;
    if (even) { SBAR(); qkt<1>(pB0, pB1, K_lds, X_lds, r32, hi, S.qr); SBAR(); }
    BlockRef nxt = cur; { const int nid = __builtin_amdgcn_readfirstlane(*(const int*)(lds + NXT_OFF)); nxo.h = -1; nxo.qb = 0; nxo.jlo = 0;
        if (nid < 1024) { nxt.h = nid & 15; nxt.qb = 63 - (nid >> 4); nxt.jlo = __builtin_amdgcn_readfirstlane((int)*(const unsigned short*)(lds + JLO_OFF + 2 * nid)); nxo = nxt; } }
    const int kbn = nxt.jlo * KVBLK;
    SLOAD_H(REF_K(BS, nxt), REF_V(BS, nxt), kbn); XDMA(REF_X(BS, nxt), kbn, 0); SBAR();
#pragma unroll
    for (int d0 = 0; d0 < 8; ++d0) S.qr[d0] = load8(REF_Q(BS, nxt) + (size_t)(wid * QBLK + r32) * D + d0 * 16 + hi * 8);
    SBAR();
    finishSM(pA0, pA1, alA, l_reg, pa0, pa1, pa2, pa3); SBAR();
    pv_tile<0>(o, vb0, pa0, pa1, pa2, pa3);
    if (even) { MASKT(pB0, pB1, NT - 1); partialSM(pB0, pB1, m_reg, mnB, alB); __syncthreads(); RESC(alB);
        finishSM(pB0, pB1, alB, l_reg, pa0, pa1, pa2, pa3); SBAR(); pv_tile<1>(o, vb0, pa0, pa1, pa2, pa3); }
    SBAR(); SEAM_K0();
    if (hi == 0) li_l[r32] = l_reg; asm volatile("s_waitcnt lgkmcnt(0)" ::: "memory");
    float rli[16];
#pragma unroll
    for (int r = 0; r < 16; ++r) rli[r] = __builtin_amdgcn_rcpf(li_l[crow(r, hi)]);
    bf16* Ow = REF_O(BS, cur) + (size_t)(wid * QBLK) * OPITCH;
#pragma unroll
    for (int r = 0; r < 16; ++r) { const int orow = crow(r, hi);
#pragma unroll
        for (int d0 = 0; d0 < 4; ++d0) { const float v = o[d0][r] * rli[r];
            const float vn = __shfl_xor(v, 1);
            if ((r32 & 1) == 0) *(unsigned*)(Ow + (size_t)orow * OPITCH + d0 * 32 + r32) = cvtpk(v, vn); } }
    __syncthreads();
#undef RESC
#undef KBASE
#undef MASKT
#undef SEAM_K0
#undef HALF_STEP
}
#undef REF_Q
#undef REF_K
#undef REF_V
#undef REF_X
#undef REF_O
#undef ROW
#undef VMW
#undef VMWN
#undef SLOAD_H
#undef XDMA
#undef SWRITE_HK
#undef SWRITE_HV
#undef SWRITE_H
#undef KSWZ
#undef SBAR
}

constexpr int NWAVES = 8;
#ifndef MK_N_LAUNCHES
#define MK_N_LAUNCHES 1
#endif
constexpr int N_PHASES = 17;

constexpr size_t MiB = 1u << 20;
constexpr size_t WS_CTL = 0, CTL_ZERO_BYTES = 64 * 1024;
constexpr size_t WS_TOKE = 1 * MiB, WS_TOKW0 = WS_TOKE + 65536, WS_TOKW1 = WS_TOKW0 + 65536, WS_TOKP0 = WS_TOKW1 + 65536, WS_TOKP1 = WS_TOKP0 + 65536;
constexpr size_t WS_SLOT = 2 * MiB;
constexpr size_t WS_LC = 4 * MiB;
constexpr size_t WS_CT = 5 * MiB;
constexpr size_t WS_WR = 5 * MiB + 512 * 1024;
constexpr size_t WS_WF = 6 * MiB;
constexpr size_t WS_NB = 7 * MiB + 512 * 1024;
constexpr size_t WS_KX = 8 * MiB;
constexpr size_t WS_WCIN = 16 * MiB, WS_WCOUT = 40 * MiB, WS_WAIN = 48 * MiB, WS_WAOUT = 72 * MiB;
constexpr size_t WS_WGU = 80 * MiB;
constexpr size_t WS_WD = 336 * MiB;
constexpr size_t WS_HN = 464 * MiB;
constexpr size_t WS_X = 528 * MiB;
constexpr size_t WS_STAGE = 656 * MiB;
constexpr size_t WS_Y = WS_STAGE;
constexpr size_t WS_Z = WS_STAGE, WS_GO = WS_STAGE + 64 * MiB;
constexpr size_t WS_XS = WS_STAGE, WS_H = WS_STAGE + 160 * MiB;
constexpr size_t WS_Q = WS_STAGE, WS_K = WS_STAGE + 64 * MiB, WS_V = WS_STAGE + 128 * MiB;
constexpr size_t WS_END = 856 * MiB;
constexpr int CW_ATT = 32;
constexpr int CW_CNT = 64;
constexpr int CW_BAR = 4096;
constexpr int RING_OFF = 0, RING_BYTES = 131072;
constexpr int TILE_OFF = RING_BYTES;
constexpr int TST_OFF = TILE_OFF + 1024;
constexpr int MISC_OFF = TST_OFF + 512;
constexpr int RTOK_OFF = MISC_OFF + 128;
constexpr int LDS_BYTES = 147456;
static_assert(RTOK_OFF + 4096 <= LDS_BYTES && fox::LDS_BYTES <= RING_BYTES, "LDS map");

#define GAS __attribute__((address_space(1)))
#define LAS __attribute__((address_space(3)))
typedef unsigned short bf16;
typedef unsigned v4u __attribute__((ext_vector_type(4)));
typedef unsigned v2u __attribute__((ext_vector_type(2)));
typedef float f32x4 __attribute__((ext_vector_type(4)));
typedef float f32x16 __attribute__((ext_vector_type(16)));
typedef short bf16x8 __attribute__((ext_vector_type(8)));
typedef GAS unsigned gu32;
#define RLX_AGENT __ATOMIC_RELAXED, __HIP_MEMORY_SCOPE_AGENT
#define LDS_WAIT() asm volatile("s_waitcnt lgkmcnt(0)" ::: "memory")
#define VM_WAIT() asm volatile("s_waitcnt vmcnt(0)" ::: "memory")
__device__ __forceinline__ unsigned f2bf(float f) { unsigned u = __builtin_bit_cast(unsigned, f); return (u + 0x7fffu + ((u >> 16) & 1u)) >> 16; }
__device__ __forceinline__ unsigned pk2(float lo, float hi) { return f2bf(lo) | (f2bf(hi) << 16); }
__device__ __forceinline__ float bf_lo(unsigned w) { return __builtin_bit_cast(float, w << 16); }
__device__ __forceinline__ float bf_hi(unsigned w) { return __builtin_bit_cast(float, w & 0xffff0000u); }
__device__ __forceinline__ float wave_sum(float v) {
#pragma unroll
    for (int o = 1; o < 64; o <<= 1) v += __shfl_xor(v, o);
    return v;
}

#define XB_TMO      128
#define XB_XCNT(j)  (256  + 64 * (j))
#define XB_XSUB(j)  (1280 + 64 * (j))
#define XB_XGEN(j)  (2304 + 64 * (j))
#define XB_TOP      3328
#define XB_TOPGEN   3392
#define XCD_BAR_WORDS 3456
#define XB_SPIN_CAP (1u << 18)

__device__ __forceinline__ unsigned xb_ld(unsigned* p)              { return __hip_atomic_load(p, __ATOMIC_RELAXED, __HIP_MEMORY_SCOPE_AGENT); }
__device__ __forceinline__ unsigned xb_add(unsigned* p, unsigned v) { return __hip_atomic_fetch_add(p, v, __ATOMIC_RELAXED, __HIP_MEMORY_SCOPE_AGENT); }
__device__ __forceinline__ unsigned xb_xcc_id() { return (unsigned)__builtin_amdgcn_s_getreg((3 << 11) | 20) & 0xFu; }
#define XB_SPIN(cond, bar) do { unsigned _sp = 0; while (cond) { __builtin_amdgcn_s_sleep(1); \
    if ((++_sp & 255u) == 0u) { if (xb_ld(&(bar)[XB_TMO])) break; if (_sp > XB_SPIN_CAP) { atomicAdd(&(bar)[XB_TMO], 1u); break; } } } } while (0)

struct XcdBarrier {
    unsigned* bar; unsigned x;
    volatile LAS unsigned* st;
};

__device__ __forceinline__ XcdBarrier xcd_barrier_post(unsigned* bar, volatile LAS unsigned* st) {
    XcdBarrier b; b.bar = bar; b.x = xb_xcc_id(); b.st = st;
    if (threadIdx.x == 0) (void)xb_add(&bar[XB_XCNT(b.x)], 1u);
    return b;
}
__device__ __forceinline__ void xcd_barrier_complete(unsigned* bar, unsigned x, unsigned& nloc, unsigned& nx) {
    const unsigned G = gridDim.x * gridDim.y * gridDim.z;
    unsigned sum, cnt, mine, sp = 0u;
    for (;;) {
        sum = 0u; cnt = 0u; mine = 0u;
#pragma unroll
        for (unsigned j = 0; j < 16; ++j) { const unsigned c = xb_ld(&bar[XB_XCNT(j)]); sum += c; cnt += (c > 0u) ? 1u : 0u; mine = (j == x) ? c : mine; }
        if (sum == G) break;
        __builtin_amdgcn_s_sleep(1);
        if ((++sp & 255u) == 0u) { if (xb_ld(&bar[XB_TMO])) break; if (sp > XB_SPIN_CAP) { atomicAdd(&bar[XB_TMO], 1u); break; } }
    }
    nloc = mine > 0u ? mine : 1u; nx = cnt > 0u ? cnt : 1u;
}

__device__ __forceinline__ void xcd_barrier(const XcdBarrier& b) {
    asm volatile("s_waitcnt vmcnt(0)" ::: "memory");
    __syncthreads();
    if (threadIdx.x == 0) {
        unsigned* bar = b.bar;
        __builtin_amdgcn_s_waitcnt(0);
        unsigned nloc = b.st[0], nx = b.st[1];
        if (nloc == 0u) { xcd_barrier_complete(bar, b.x, nloc, nx); b.st[0] = nloc; b.st[1] = nx; }
        const unsigned old = xb_add(&bar[XB_XSUB(b.x)], 1u);
        const unsigned gen = old / nloc;
        if (old + 1u == (gen + 1u) * nloc) {
            __builtin_amdgcn_fence(__ATOMIC_RELEASE, "agent");
            asm volatile("s_waitcnt vmcnt(0)" ::: "memory");
            const unsigned og = xb_add(&bar[XB_TOP], 1u);
            const unsigned tg = og / nx;
            if (og + 1u == (tg + 1u) * nx) xb_add(&bar[XB_TOPGEN], 1u);
            else XB_SPIN(xb_ld(&bar[XB_TOPGEN]) == tg, bar);
            __builtin_amdgcn_fence(__ATOMIC_ACQUIRE, "agent");
            xb_add(&bar[XB_XGEN(b.x)], 1u);
            asm volatile("s_waitcnt vmcnt(0)" ::: "memory");
        } else {
            XB_SPIN(xb_ld(&bar[XB_XGEN(b.x)]) == gen, bar);
            __builtin_amdgcn_fence(__ATOMIC_ACQUIRE, "agent");
            asm volatile("s_waitcnt vmcnt(0)" ::: "memory");
        }
    }
    __syncthreads();
}

struct Frame {
    LAS unsigned char* lds;
    volatile LAS unsigned* MISC;
    gu32* ctl;
    int tid, lane, wave;
    int vcu, G;
    const float *x, *mix_norm, *ffn_norm, *final_norm, *conv_w_in, *conv_w, *conv_w_out, *attn_w_in, *attn_b_f, *attn_w_out, *rg_w, *rg_b, *re_w, *re_b, *w_gate, *w_up, *w_down;
    float* out; unsigned char* ws;
};
#define WSP(T, off) ((T*)(F.ws + (off)))

struct TrItem { const float* src; bf16* dst; int ldw, ldd; };
__device__ __forceinline__ bool tr_decode(const Frame& F, int it, TrItem& d) {
    if (it < 6144) { const int kb = it / 192, nb = it % 192, n0 = nb * 32; d.src = F.conv_w_in + (size_t)(kb * 64) * 6144 + n0; d.ldw = 6144; d.ldd = 2048;
        int dr; if (n0 < 2048) dr = 4096 + n0; else if (n0 < 4096) { const int i = n0 - 2048; dr = 256 * (i >> 7) + (i & 127); } else { const int i = n0 - 4096; dr = 256 * (i >> 7) + 128 + (i & 127); }
        d.dst = WSP(bf16, WS_WCIN) + (size_t)dr * 2048 + kb * 64; return true; }
    it -= 6144;
    if (it < 2048) { const int kb = it / 64, nb = it % 64; d.src = F.conv_w_out + (size_t)(kb * 64) * 2048 + nb * 32; d.ldw = 2048; d.ldd = 2048; d.dst = WSP(bf16, WS_WCOUT) + (size_t)(nb * 32) * 2048 + kb * 64; return true; }
    it -= 2048;
    if (it < 6144) { const int kb = it / 192, nb = it % 192; d.src = F.attn_w_in + (size_t)(kb * 64) * 6160 + nb * 32; d.ldw = 6160; d.ldd = 2048; d.dst = WSP(bf16, WS_WAIN) + (size_t)(nb * 32) * 2048 + kb * 64; return true; }
    it -= 6144;
    if (it < 2048) { const int kb = it / 64, nb = it % 64; d.src = F.attn_w_out + (size_t)(kb * 64) * 2048 + nb * 32; d.ldw = 2048; d.ldd = 2048; d.dst = WSP(bf16, WS_WAOUT) + (size_t)(nb * 32) * 2048 + kb * 64; return true; }
    it -= 2048;
    if (it < 65536) { const int up = it >> 15, r = it & 32767, le = r >> 9, q = r & 511, kb = q >> 4, nb = q & 15, n0 = nb * 32;
        d.src = (up ? F.w_up : F.w_gate) + (size_t)le * 2048 * 512 + (size_t)(kb * 64) * 512 + n0; d.ldw = 512; d.ldd = 2048;
        const int dr = 256 * (n0 >> 7) + 128 * up + (n0 & 127);
        d.dst = WSP(bf16, WS_WGU) + ((size_t)le * 1024 + dr) * 2048 + kb * 64; return true; }
    it -= 65536;
    if (it < 32768) { const int le = it >> 9, q = it & 511, kb = q >> 6, nb = q & 63;
        d.src = F.w_down + (size_t)le * 512 * 2048 + (size_t)(kb * 64) * 2048 + nb * 32; d.ldw = 2048; d.ldd = 512;
        d.dst = WSP(bf16, WS_WD) + ((size_t)le * 2048 + nb * 32) * 512 + kb * 64; return true; }
    return false;
}
constexpr int TR_NITEMS = 6144 + 2048 + 6144 + 2048 + 65536 + 32768;
__device__ __forceinline__ void p0_prologue(Frame& F) {
    LAS float* scr = (LAS float*)(F.lds + RING_OFF + F.wave * 16384);
    const int gw = F.vcu * NWAVES + F.wave, NGW = F.G * NWAVES, lane = F.lane;
    float v[32]; TrItem cur, nx; int it = gw;
    bool have = tr_decode(F, it, cur);
    if (have) {
#pragma unroll
        for (int i = 0; i < 32; ++i) v[i] = cur.src[(size_t)(2 * i + (lane >> 5)) * cur.ldw + (lane & 31)];
    }
    while (have) {
#pragma unroll
        for (int i = 0; i < 32; ++i) scr[(2 * i + (lane >> 5)) * 33 + (lane & 31)] = v[i];
        it += NGW; const bool hn = tr_decode(F, it, nx);
        if (hn) {
#pragma unroll
            for (int i = 0; i < 32; ++i) v[i] = nx.src[(size_t)(2 * i + (lane >> 5)) * nx.ldw + (lane & 31)];
        }
        LDS_WAIT(); asm volatile("" ::: "memory");
        const int c = lane & 7;
#pragma unroll
        for (int j = 0; j < 4; ++j) { const int n = (lane >> 3) + 8 * j; const LAS float* s = scr + (8 * c) * 33 + n;
            v4u o; o.x = pk2(s[0 * 33], s[1 * 33]); o.y = pk2(s[2 * 33], s[3 * 33]); o.z = pk2(s[4 * 33], s[5 * 33]); o.w = pk2(s[6 * 33], s[7 * 33]);
            *(GAS v4u*)(cur.dst + (size_t)n * cur.ldd + 8 * c) = o; }
        LDS_WAIT(); asm volatile("" ::: "memory");
        cur = nx; have = hn;
    }
    const int gt = (F.vcu * NWAVES + F.wave) * 64 + lane, NGT = F.G * NWAVES * 64;
    for (int i = gt; i < 2 * 64 * 2048; i += NGT) { const int l = i >> 17, r = (i >> 11) & 63, k = i & 2047; float w = 0.f;
        if (r < 4) w = F.rg_w[((size_t)l * 2048 + k) * 4 + r];
        else if (r < 36) { const int g = (r - 4) >> 3, e = (r - 4) & 7; w = F.re_w[(((size_t)l * 4 + g) * 2048 + k) * 8 + e]; }
        WSP(bf16, WS_WR)[i] = (bf16)f2bf(w); }
    for (int i = gt; i < 32 * 2048; i += NGT) { const int r = i >> 11, k = i & 2047; const float w = r < 16 ? F.attn_w_in[(size_t)k * 6160 + 6144 + r] : 0.f; WSP(bf16, WS_WF)[i] = (bf16)f2bf(w); }
}

template <int NB>
__device__ __forceinline__ void small_gemm(const Frame& F, const bf16* hn_rows, const bf16* Wt, LAS float* lg) {
    constexpr int NC = NB * 32, NE = 64 * NC, PER = NE / 512;
    const int lane = F.lane, r32 = lane & 31, hi = lane >> 5, kw = F.wave * 256;
    f32x16 acc[2][NB];
#pragma unroll
    for (int a = 0; a < 2; ++a)
#pragma unroll
        for (int b = 0; b < NB; ++b) acc[a][b] = f32x16{};
    const bf16* ap = hn_rows + (size_t)r32 * 2048 + kw + hi * 8; const bf16* bp = Wt + (size_t)r32 * 2048 + kw + hi * 8;
#pragma unroll 4
    for (int ks = 0; ks < 16; ++ks) {
        const bf16x8 a0 = *(const bf16x8*)(ap + ks * 16), a1 = *(const bf16x8*)(ap + 32 * 2048 + ks * 16);
#pragma unroll
        for (int b = 0; b < NB; ++b) { const bf16x8 bv = *(const bf16x8*)(bp + (size_t)b * 32 * 2048 + ks * 16);
            acc[0][b] = __builtin_amdgcn_mfma_f32_32x32x16_bf16(a0, bv, acc[0][b], 0, 0, 0);
            acc[1][b] = __builtin_amdgcn_mfma_f32_32x32x16_bf16(a1, bv, acc[1][b], 0, 0, 0); }
    }
    LAS float* part = lg + F.wave * NE;
#pragma unroll
    for (int a = 0; a < 2; ++a)
#pragma unroll
        for (int b = 0; b < NB; ++b)
#pragma unroll
            for (int r = 0; r < 16; ++r) { const int row = a * 32 + (r & 3) + 8 * (r >> 2) + 4 * hi; part[row * NC + b * 32 + r32] = acc[a][b][r]; }
    LDS_WAIT(); __syncthreads();
    float s[PER];
#pragma unroll
    for (int q = 0; q < PER; ++q) { const int i = F.tid + 512 * q; float t = lg[i];
#pragma unroll
        for (int w = 1; w < 8; ++w) t += lg[w * NE + i];
        s[q] = t; }
    LDS_WAIT(); __syncthreads();
#pragma unroll
    for (int q = 0; q < PER; ++q) { const int i = F.tid + 512 * q; lg[(i / NC) * (NC + 1) + (i % NC)] = s[q]; }
    LDS_WAIT(); __syncthreads();
}
__device__ __forceinline__ int build_tiles(Frame& F, int layer) {
    LAS int* tile_e = (LAS int*)(F.lds + TILE_OFF); LAS int* tst = (LAS int*)(F.lds + TST_OFF);
    __syncthreads();
    if (F.tid < 64) {
        const int c = F.tid < 32 ? (int)__hip_atomic_load(F.ctl + CW_CNT + 32 * layer + F.tid, RLX_AGENT) : 0;
        const int nt = (c + 255) >> 8; int inc = nt;
#pragma unroll
        for (int o = 1; o < 32; o <<= 1) { const int t = __shfl_up(inc, o); if ((F.tid & 63) >= o) inc += t; }
        const int st = inc - nt;
        if (F.tid < 32) { tst[F.tid] = st; tst[32 + F.tid] = c; for (int t = 0; t < nt; ++t) tile_e[st + t] = F.tid; }
        if (F.tid == 31) tst[64] = inc;
    }
    __syncthreads();
    return tst[64];
}
template <int MODE>
__device__ __forceinline__ void row_phase(Frame& F, int layer) {
    const int lane = F.lane, wave = F.wave, tid = F.tid;
    const float* gain = MODE == 0 ? F.mix_norm : (MODE == 1 ? F.ffn_norm + layer * DM : (MODE == 2 ? F.mix_norm + DM : F.final_norm));
    f32x4 g[8];
#pragma unroll
    for (int j = 0; j < 4; ++j) { g[2 * j] = *(const f32x4*)(gain + 512 * j + 8 * lane); g[2 * j + 1] = *(const f32x4*)(gain + 512 * j + 8 * lane + 4); }
    LAS float* lg = (LAS float*)(F.lds + RING_OFF);
    LAS int* hist = (LAS int*)(F.lds + TILE_OFF);
    LAS int* tst = (LAS int*)(F.lds + TST_OFF);
    if (MODE >= 2) (void)build_tiles(F, MODE == 2 ? 0 : 1);
    const float* xin = (MODE == 0 || (MODE == 1 && layer == 0)) ? F.x : WSP(float, WS_X);
    bf16* HN = WSP(bf16, WS_HN);
    for (int chunk = F.vcu; chunk < SEQ / 64; chunk += F.G) {
        const int row0 = chunk * 64;
        if (MODE == 1) { if (tid < 64) hist[tid] = 0; }
        for (int i = 0; i < 8; ++i) {
            const int row = row0 + wave * 8 + i;
            const float* xr = xin + (size_t)row * DM + 8 * lane;
            f32x4 v[8];
#pragma unroll
            for (int j = 0; j < 4; ++j) { v[2 * j] = *(const f32x4*)(xr + 512 * j); v[2 * j + 1] = *(const f32x4*)(xr + 512 * j + 4); }
            if (MODE == 1) { const bf16* yr = WSP(bf16, WS_Y) + (size_t)row * DM + 8 * lane;
#pragma unroll
                for (int j = 0; j < 4; ++j) { const v4u a = *(const v4u*)(yr + 512 * j);
                    v[2 * j][0] += bf_lo(a.x); v[2 * j][1] += bf_hi(a.x); v[2 * j][2] += bf_lo(a.y); v[2 * j][3] += bf_hi(a.y);
                    v[2 * j + 1][0] += bf_lo(a.z); v[2 * j + 1][1] += bf_hi(a.z); v[2 * j + 1][2] += bf_lo(a.w); v[2 * j + 1][3] += bf_hi(a.w); } }
            if (MODE >= 2) {
                const unsigned ee = WSP(unsigned, WS_TOKE)[row]; const int e0 = ee & 255, e1 = (ee >> 8) & 255;
                const int r0 = tst[e0] * 256 + WSP(int, WS_TOKP0)[row], r1 = tst[e1] * 256 + WSP(int, WS_TOKP1)[row];
                const float w0 = WSP(float, WS_TOKW0)[row], w1 = WSP(float, WS_TOKW1)[row];
                const bf16* o0 = WSP(bf16, WS_XS) + (size_t)r0 * DM + 8 * lane; const bf16* o1 = WSP(bf16, WS_XS) + (size_t)r1 * DM + 8 * lane;
#pragma unroll
                for (int j = 0; j < 4; ++j) { const v4u a = *(const v4u*)(o0 + 512 * j), b = *(const v4u*)(o1 + 512 * j);
                    v[2 * j][0] += w0 * bf_lo(a.x) + w1 * bf_lo(b.x); v[2 * j][1] += w0 * bf_hi(a.x) + w1 * bf_hi(b.x);
                    v[2 * j][2] += w0 * bf_lo(a.y) + w1 * bf_lo(b.y); v[2 * j][3] += w0 * bf_hi(a.y) + w1 * bf_hi(b.y);
                    v[2 * j + 1][0] += w0 * bf_lo(a.z) + w1 * bf_lo(b.z); v[2 * j + 1][1] += w0 * bf_hi(a.z) + w1 * bf_hi(b.z);
                    v[2 * j + 1][2] += w0 * bf_lo(a.w) + w1 * bf_lo(b.w); v[2 * j + 1][3] += w0 * bf_hi(a.w) + w1 * bf_hi(b.w); }
            }
            float ss = 0.f;
#pragma unroll
            for (int j = 0; j < 8; ++j) ss += (v[j][0] * v[j][0] + v[j][1] * v[j][1]) + (v[j][2] * v[j][2] + v[j][3] * v[j][3]);
            const float rstd = 1.0f / sqrtf(wave_sum(ss) * (1.0f / DM) + RMS_EPS);
            if (MODE == 1 || MODE == 2) { float* xw = WSP(float, WS_X) + (size_t)row * DM + 8 * lane;
#pragma unroll
                for (int j = 0; j < 4; ++j) { *(f32x4*)(xw + 512 * j) = v[2 * j]; *(f32x4*)(xw + 512 * j + 4) = v[2 * j + 1]; } }
            if (MODE == 3) { float* ow = F.out + (size_t)row * DM + 8 * lane;
#pragma unroll
                for (int j = 0; j < 4; ++j) { *(f32x4*)(ow + 512 * j) = v[2 * j] * rstd * g[2 * j]; *(f32x4*)(ow + 512 * j + 4) = v[2 * j + 1] * rstd * g[2 * j + 1]; } }
            else { bf16* hw = HN + (size_t)row * DM + 8 * lane;
#pragma unroll
                for (int j = 0; j < 4; ++j) { const f32x4 a = v[2 * j] * rstd * g[2 * j], b = v[2 * j + 1] * rstd * g[2 * j + 1];
                    v4u o; o.x = pk2(a[0], a[1]); o.y = pk2(a[2], a[3]); o.z = pk2(b[0], b[1]); o.w = pk2(b[2], b[3]); *(v4u*)(hw + 512 * j) = o; } }
        }
        if (MODE == 1 || MODE == 2) {
            VM_WAIT(); __syncthreads();
            if (MODE == 1) small_gemm<2>(F, HN + (size_t)row0 * DM, WSP(bf16, WS_WR) + (size_t)layer * 64 * 2048, lg);
            else small_gemm<1>(F, HN + (size_t)row0 * DM, WSP(bf16, WS_WF), lg);
            if (MODE == 1) {
                int e0 = 0, e1 = 0, rk0 = 0, rk1 = 0; float w0 = 0.f, w1 = 0.f;
                if (tid < 64) {
                    const LAS float* l = lg + tid * 65; const float* gb = F.rg_b + layer * 4; const float* eb = F.re_b + layer * 32;
                    float gl[4]; for (int j = 0; j < 4; ++j) gl[j] = l[j] + gb[j];
                    int gs = 0; float gm = gl[0]; for (int j = 1; j < 4; ++j) if (gl[j] > gm) { gm = gl[j]; gs = j; }
                    float den = 0.f; for (int j = 0; j < 4; ++j) den += __expf(gl[j] - gm);
                    const float pg = 1.0f / den;
                    float el[8]; for (int j = 0; j < 8; ++j) el[j] = l[4 + gs * 8 + j] + eb[gs * 8 + j];
                    int i1 = 0; float v1 = el[0]; for (int j = 1; j < 8; ++j) if (el[j] > v1) { v1 = el[j]; i1 = j; }
                    int i2 = -1; float v2 = -3.0e38f; for (int j = 0; j < 8; ++j) if (j != i1 && el[j] > v2) { v2 = el[j]; i2 = j; }
                    const float s = 1.0f / (1.0f + __expf(v2 - v1));
                    w0 = pg * s; w1 = pg * (1.0f - s); e0 = gs * 8 + i1; e1 = gs * 8 + i2;
                    rk0 = __hip_atomic_fetch_add(hist + e0, 1, __ATOMIC_RELAXED, __HIP_MEMORY_SCOPE_WORKGROUP);
                    rk1 = __hip_atomic_fetch_add(hist + e1, 1, __ATOMIC_RELAXED, __HIP_MEMORY_SCOPE_WORKGROUP);
                    LDS_WAIT(); asm volatile("" ::: "memory");
                    if (tid < 32) { const int c = hist[tid]; hist[32 + tid] = c ? (int)__hip_atomic_fetch_add(F.ctl + CW_CNT + 32 * layer + tid, (unsigned)c, RLX_AGENT) : 0; }
                    LDS_WAIT(); asm volatile("" ::: "memory");
                    const int p0 = hist[32 + e0] + rk0, p1 = hist[32 + e1] + rk1, row = row0 + tid;
                    WSP(int, WS_SLOT)[e0 * CAP + p0] = row; WSP(int, WS_SLOT)[e1 * CAP + p1] = row;
                    WSP(unsigned, WS_TOKE)[row] = (unsigned)e0 | ((unsigned)e1 << 8);
                    WSP(int, WS_TOKP0)[row] = p0; WSP(int, WS_TOKP1)[row] = p1; WSP(float, WS_TOKW0)[row] = w0; WSP(float, WS_TOKW1)[row] = w1;
                }
            } else {
                if (tid < 16) {
                    const float bfh = F.attn_b_f[tid]; float run = 0.f; float* lc = WSP(float, WS_LC) + (size_t)row0 * 16 + tid;
                    for (int r = 0; r < 64; ++r) { const float xv = lg[r * 33 + tid] + bfh; const float ls = fminf(xv, 0.f) - log1pf(__expf(-fabsf(xv))); run += ls; lc[r * 16] = run; }
                    WSP(float, WS_CT)[chunk * 16 + tid] = run;
                }
            }
            __syncthreads();
        }
    }
}
__device__ __forceinline__ void c_finalize(Frame& F) {
    LAS float* part = (LAS float*)(F.lds + RING_OFF);
    const int tid = F.tid;
    for (int chunk = F.vcu; chunk < SEQ / 64; chunk += F.G) {
        __syncthreads();
        { const int h = tid & 15, p = tid >> 4; float s = 0.f; const float* ct = WSP(float, WS_CT);
            for (int c = p * 8; c < p * 8 + 8; ++c) if (c < chunk) s += ct[c * 16 + h];
            part[p * 16 + h] = s; }
        __syncthreads();
        if (tid < 16) { float s = 0.f; for (int p = 0; p < 32; ++p) s += part[p * 16 + tid]; part[512 + tid] = s; }
        __syncthreads();
        for (int i = tid; i < 64 * 16; i += 512) { const int r = i >> 4, h = i & 15, row = chunk * 64 + r;
            const float cv = WSP(float, WS_LC)[(size_t)row * 16 + h] + part[512 + h];
            WSP(float, WS_KX)[(size_t)h * SEQ + row] = -cv * 11.313708498984761f; }
    }
    __syncthreads();
}
__device__ __forceinline__ void conv_phase(Frame& F) {
    const int tid = F.tid, c8 = (tid & 255) * 8, half = tid >> 8;
    float w[3][8];
#pragma unroll
    for (int k = 0; k < 3; ++k)
#pragma unroll
        for (int j = 0; j < 8; ++j) w[k][j] = F.conv_w[k * DM + c8 + j];
    const bf16* Z = WSP(bf16, WS_Z); const bf16* GO = WSP(bf16, WS_GO); bf16* A = WSP(bf16, WS_HN);
    for (int chunk = F.vcu; chunk < SEQ / 64; chunk += F.G) {
        const int t0 = chunk * 64 + half * 32;
        v4u zm2 = (v4u){0u, 0u, 0u, 0u}, zm1 = zm2;
        if (t0 >= 2) { zm2 = *(const v4u*)(Z + (size_t)(t0 - 2) * DM + c8); zm1 = *(const v4u*)(Z + (size_t)(t0 - 1) * DM + c8); }
#pragma unroll 4
        for (int t = t0; t < t0 + 32; ++t) {
            const v4u z0 = *(const v4u*)(Z + (size_t)t * DM + c8), go = *(const v4u*)(GO + (size_t)t * DM + c8);
            v4u o;
#define CV(q, j) (w[0][j] * (((j) & 1) ? bf_hi(zm2.q) : bf_lo(zm2.q)) + w[1][j] * (((j) & 1) ? bf_hi(zm1.q) : bf_lo(zm1.q)) + w[2][j] * (((j) & 1) ? bf_hi(z0.q) : bf_lo(z0.q)))
            o.x = pk2(bf_lo(go.x) * CV(x, 0), bf_hi(go.x) * CV(x, 1)); o.y = pk2(bf_lo(go.y) * CV(y, 2), bf_hi(go.y) * CV(y, 3));
            o.z = pk2(bf_lo(go.z) * CV(z, 4), bf_hi(go.z) * CV(z, 5)); o.w = pk2(bf_lo(go.w) * CV(w, 6), bf_hi(go.w) * CV(w, 7));
#undef CV
            *(v4u*)(A + (size_t)t * DM + c8) = o;
            zm2 = zm1; zm1 = z0;
        }
    }
}
__device__ __forceinline__ void gather_phase(Frame& F, int layer) {
    const int ntile = build_tiles(F, layer);
    const LAS int* tile_e = (const LAS int*)(F.lds + TILE_OFF); const LAS int* tst = (const LAS int*)(F.lds + TST_OFF);
    const int gw = F.vcu * NWAVES + F.wave, NGW = F.G * NWAVES, lane = F.lane;
    const bf16* HN = WSP(bf16, WS_HN); bf16* XS = WSP(bf16, WS_XS);
    for (int r = gw; r < ntile * 256; r += NGW) {
        const int t = r >> 8, e = tile_e[t], pos = r - tst[e] * 256;
        if (pos < tst[32 + e]) { const int tok = WSP(int, WS_SLOT)[e * CAP + pos];
            const v4u* s = (const v4u*)(HN + (size_t)tok * DM) + lane; v4u* d = (v4u*)(XS + (size_t)r * DM) + lane;
            const v4u a = s[0], b = s[64], c = s[128], dd = s[192]; d[0] = a; d[64] = b; d[128] = c; d[192] = dd; }
    }
}


constexpr float PRUNE_T = 30.0f;
template <int rep>
__device__ __forceinline__ void attn_phase(Frame& F, unsigned char* lds) {
    const unsigned lds32 = (unsigned)(size_t)F.lds;
    LAS unsigned short* jlo = (LAS unsigned short*)(F.lds + RING_OFF + fox::JLO_OFF);
    LAS float* kn2 = (LAS float*)(F.lds + RING_OFF + fox::KN2_OFF);
    LAS int* nxt_id = (LAS int*)(F.lds + RING_OFF + fox::NXT_OFF);
    const int tid = F.tid;
    const float* NBp = WSP(float, WS_NB); const float* Bp = WSP(float, WS_KX);
    for (int i = tid; i < 1024; i += 512) { const float* p = NBp + (size_t)(1024 + i) * 8;
        kn2[i] = (fmaxf(p[0], p[4]) + fmaxf(p[1], p[5])) + (fmaxf(p[2], p[6]) + fmaxf(p[3], p[7])); }
    __syncthreads();
    if (tid < 16) { float m = 0.f; for (int kb = 0; kb < 64; ++kb) { m = fmaxf(m, kn2[tid * 64 + kb]); kn2[tid * 64 + kb] = m; } }
    __syncthreads();
    for (int id = tid; id < 1024; id += 512) { const int h = id & 15, qb = 63 - (id >> 4);
        const float* p = NBp + (size_t)(h * 64 + qb) * 8;
        const float q2 = (fmaxf(p[0], p[4]) + fmaxf(p[1], p[5])) + (fmaxf(p[2], p[6]) + fmaxf(p[3], p[7]));
        const float thr = 2.0f * fox::SCALE * 1.02f * sqrtf(q2 * kn2[h * 64 + qb]) + PRUNE_T;
        const float* bh = Bp + (size_t)h * SEQ; const float b0 = bh[qb * 256];
        int lo = 0, hi = 4 * qb;
        while (lo < hi) { const int mid = (lo + hi) >> 1; if ((b0 - bh[mid * 64 + 63]) * fox::SCALE > thr) lo = mid + 1; else hi = mid; }
        jlo[id] = (unsigned short)lo; }
    __syncthreads();
    const fox::Bases BS{WSP(fox::bf16, WS_Q), WSP(fox::bf16, WS_K), WSP(fox::bf16, WS_V), WSP(float, WS_KX), WSP(fox::bf16, WS_HN)};
    const int total = 1024;
    int id = blockIdx.x;
    if (id < total) {
#define FOX_REF(r, k_) do { (r).h = (k_) & 15; (r).qb = 63 - ((k_) >> 4); (r).jlo = __builtin_amdgcn_readfirstlane((int)jlo[k_]); } while (0)
        fox::BlockRef cur, nxt; FOX_REF(cur, id);
        fox::Seam S;
        fox::fox_prime(BS, cur, (char*)lds + RING_OFF, lds32 + RING_OFF, S);
        for (;;) {
            if (tid == 0) *nxt_id = (int)F.G + (int)__hip_atomic_fetch_add(F.ctl + CW_ATT + rep, 1u, RLX_AGENT);
            fox::fox_block(BS, cur, (char*)lds + RING_OFF, lds32 + RING_OFF, S, nxt);
            if (nxt.h < 0) break;
            cur = nxt;
        }
#undef FOX_REF
    }
}
#define IN(k) (lo <= (k) && (k) < hi)
#ifndef EN_MASK
#define EN_MASK 0xFFFF
#endif
#define EN(b) (((EN_MASK) >> (b)) & 1)
#ifndef DBL_MASK
#define DBL_MASK 0
#endif
#define REPS(b) ((((DBL_MASK) >> (b)) & 1) ? 2 : 1)
#define SEAM(k) do { if (MK_N_LAUNCHES == 1 && IN(k) && IN((k) + 1)) xcd_barrier(bar); } while (0)
template <int layer>
__device__ __forceinline__ void layer_phases(Frame& F, const XcdBarrier& bar, unsigned char* lds, const int lo, const int hi) {
    const unsigned lds32 = (unsigned)(size_t)F.lds;
        const int pb = 1 + 8 * layer;
        if (IN(pb + 0) && EN(1)) {
            if constexpr (layer == 0) {
                pg8::Gemm g{WSP(bf16, WS_HN), WSP(bf16, WS_WCIN), SEQ, 3 * DM, DM}; pg8::StaticOrder S; S.init(SEQ, 3 * DM, F.G, (int)blockIdx.x);
                pg8::EpiConvIn E{WSP(bf16, WS_Z), WSP(bf16, WS_GO)};
                for (int rep = 0; rep < REPS(1); ++rep) pg8::gemm_phase<pg8::EpiConvIn, pg8::StaticOrder, true, true>(F.lds + RING_OFF, g, S, E);
            } else {
                c_finalize(F);
                pg8::Gemm g{WSP(bf16, WS_HN), WSP(bf16, WS_WAIN), SEQ, 3 * DM, DM}; pg8::StaticOrder S; S.init(SEQ, 3 * DM, F.G, (int)blockIdx.x);
                pg8::EpiQKV E{WSP(bf16, WS_Q), (size_t)(WS_K - WS_Q) / 2, WSP(float, WS_NB)};
                pg8::gemm_phase<pg8::EpiQKV, pg8::StaticOrder, true, true>(F.lds + RING_OFF, g, S, E);
            }
        }
        SEAM(pb + 0);
        if (IN(pb + 1)) {
            if constexpr (layer == 0) { if (EN(2)) for (int rep = 0; rep < REPS(2); ++rep) conv_phase(F); }
            else if (EN(3)) { attn_phase<0>(F, lds); if (REPS(3) == 2) attn_phase<1>(F, lds); }
        }
        SEAM(pb + 1);
        if (IN(pb + 2) && EN(4)) {
            pg8::Gemm g{WSP(bf16, WS_HN), layer == 0 ? WSP(bf16, WS_WCOUT) : WSP(bf16, WS_WAOUT), SEQ, DM, DM}; pg8::StaticOrder S; S.init(SEQ, DM, F.G, (int)blockIdx.x);
            pg8::EpiDown E{WSP(bf16, WS_Y)};
            for (int rep = 0; rep < ((layer == 0) ? REPS(4) : 1); ++rep) pg8::gemm_phase<pg8::EpiDown, pg8::StaticOrder, true, true>(F.lds + RING_OFF, g, S, E);
        }
        SEAM(pb + 2);
        if (IN(pb + 3) && EN(5)) row_phase<1>(F, layer);
        SEAM(pb + 3);
        if (IN(pb + 5) && EN(7)) {
            const int ntile = build_tiles(F, layer);
            const LAS int* tile_e = (const LAS int*)(F.lds + TILE_OFF); const LAS int* tst = (const LAS int*)(F.lds + TST_OFF); LAS unsigned* rtok = (LAS unsigned*)(F.lds + RTOK_OFF);
            for (int idx = F.tid; idx < 4 * 256; idx += 512) { const int L = (idx >> 8) * F.G + F.vcu, r = idx & 255; unsigned off = 0u;
                if (L < ntile * 4) { const int t = L >> 2, e = tile_e[t], pos = (t - tst[e]) * 256 + r; if (pos < tst[32 + e]) off = (unsigned)WSP(int, WS_SLOT)[e * CAP + pos] * (unsigned)(DM * 2); }
                rtok[idx] = off; }
            __syncthreads();
            pg8::Gemm g{WSP(bf16, WS_HN), WSP(bf16, WS_WGU) + (size_t)layer * 32 * 1024 * 2048, MAXT * 256, 32 * 1024, DM};
            pg8::ExpertOrder S{tile_e, ntile * 4, 4, F.G, F.vcu};
            pg8::EpiGateUp E{WSP(bf16, WS_H)};
            for (int rep = 0; rep < REPS(7); ++rep) pg8::gemm_phase_gather<pg8::EpiGateUp, pg8::ExpertOrder>(F.lds + RING_OFF, g, S, E, rtok);
        }
        SEAM(pb + 5);
        if (IN(pb + 6) && EN(8)) {
            const int ntile = build_tiles(F, layer);
            pg8::Gemm g{WSP(bf16, WS_H), WSP(bf16, WS_WD) + (size_t)layer * 32 * 2048 * 512, MAXT * 256, 32 * 2048, DEXP};
            pg8::ExpertOrder S{(const LAS int*)(F.lds + TILE_OFF), ntile * 8, 8, F.G, F.vcu};
            pg8::EpiDown E{WSP(bf16, WS_XS)};
            for (int rep = 0; rep < REPS(8); ++rep) pg8::gemm_phase<pg8::EpiDown, pg8::ExpertOrder, true, true>(F.lds + RING_OFF, g, S, E);
        }
        SEAM(pb + 6);
        if (IN(pb + 7) && EN(9)) { if (layer == 0) row_phase<2>(F, 0); else row_phase<3>(F, 1); }
        if (layer == 0) SEAM(pb + 7);
}

struct Args { const float* in[17]; float* out; unsigned char* ws; int ph_lo, ph_hi; };
__global__ void __launch_bounds__(NWAVES * 64, 2) trunk_fwd(Args args) {
    extern __shared__ __attribute__((aligned(16))) unsigned char lds[];
    Frame F;
    F.lds = (LAS unsigned char*)lds;
    F.MISC = (volatile LAS unsigned*)(F.lds + MISC_OFF);
    F.tid = threadIdx.x; F.lane = F.tid & 63; F.wave = __builtin_amdgcn_readfirstlane(F.tid >> 6);
    F.G = gridDim.x; { const int bx = blockIdx.x; F.vcu = (F.G % 8 == 0) ? (bx % 8) * (F.G / 8) + bx / 8 : bx; }
    F.ws = args.ws; F.out = args.out; F.ctl = (gu32*)(args.ws + WS_CTL);
    F.x = args.in[0]; F.mix_norm = args.in[1]; F.ffn_norm = args.in[2]; F.final_norm = args.in[3]; F.conv_w_in = args.in[4]; F.conv_w = args.in[5]; F.conv_w_out = args.in[6];
    F.attn_w_in = args.in[7]; F.attn_b_f = args.in[8]; F.attn_w_out = args.in[9]; F.rg_w = args.in[10]; F.rg_b = args.in[11]; F.re_w = args.in[12]; F.re_b = args.in[13];
    F.w_gate = args.in[14]; F.w_up = args.in[15]; F.w_down = args.in[16];
    if (F.tid < 32) F.MISC[F.tid] = 0u;
    __syncthreads();
    XcdBarrier bar; bar.bar = (unsigned*)(F.ctl + CW_BAR); bar.x = 0; bar.st = nullptr;
    if (MK_N_LAUNCHES == 1) bar = xcd_barrier_post((unsigned*)(F.ctl + CW_BAR), F.MISC + 8);
    const int lo = args.ph_lo, hi = args.ph_hi;

    if (IN(0) && EN(0)) { for (int rep = 0; rep < REPS(0); ++rep) p0_prologue(F); for (int rep = 0; rep < REPS(9); ++rep) row_phase<0>(F, 0); }
    SEAM(0);
    layer_phases<0>(F, bar, lds, lo, hi);
    layer_phases<1>(F, bar, lds, lo, hi);
}
#undef IN
#undef SEAM

extern "C" void kernel_launch(void* const* d_in, const int* in_sizes, int n_in, void* d_out, int out_size, void* d_ws, size_t ws_size, hipStream_t stream) {
    static int grid = 0;
    if (grid == 0) {
        if (n_in != 17 || in_sizes[0] != SEQ * DM || out_size != SEQ * DM || ws_size < WS_END) { fprintf(stderr, "kernel_launch: unexpected shapes (n_in %d, in0 %d, out %d, ws %zu < %zu); nothing launched\n", n_in, n_in > 0 ? in_sizes[0] : -1, out_size, ws_size, (size_t)WS_END); grid = -1; return; }
        int dev = 0, cus = 0, per_cu = 0;
        if (hipGetDevice(&dev) != hipSuccess || hipDeviceGetAttribute(&cus, hipDeviceAttributeMultiprocessorCount, dev) != hipSuccess) { fprintf(stderr, "kernel_launch: device query failed\n"); grid = -1; return; }
        if (hipFuncSetAttribute((const void*)trunk_fwd, hipFuncAttributeMaxDynamicSharedMemorySize, LDS_BYTES) != hipSuccess) { fprintf(stderr, "kernel_launch: hipFuncSetAttribute failed\n"); grid = -1; return; }
        if (hipOccupancyMaxActiveBlocksPerMultiprocessor(&per_cu, (const void*)trunk_fwd, NWAVES * 64, LDS_BYTES) != hipSuccess || per_cu < 1) { fprintf(stderr, "kernel_launch: occupancy query reports %d workgroups per CU\n", per_cu); (void)hipGetLastError(); grid = -1; return; }
        grid = cus;
    }
    if (grid < 0) return;
    if (hipMemsetAsync((char*)d_ws + WS_CTL, 0, CTL_ZERO_BYTES, stream) != hipSuccess) { fprintf(stderr, "kernel_launch: hipMemsetAsync failed\n"); return; }
    Args a{};
    for (int i = 0; i < 17; ++i) a.in[i] = (const float*)d_in[i];
    a.out = (float*)d_out; a.ws = (unsigned char*)d_ws;
#if MK_N_LAUNCHES == 1
    a.ph_lo = 0; a.ph_hi = N_PHASES;
    hipLaunchKernelGGL(trunk_fwd, dim3(grid), dim3(NWAVES * 64), LDS_BYTES, stream, a);
#else
    for (int p = 0; p < N_PHASES; ++p) { a.ph_lo = p; a.ph_hi = p + 1; hipLaunchKernelGGL(trunk_fwd, dim3(grid), dim3(NWAVES * 64), LDS_BYTES, stream, a); }
#endif
    const hipError_t le = hipPeekAtLastError();
    if (le != hipSuccess) fprintf(stderr, "kernel_launch: launch failed: %s\n", hipGetErrorName(le));
}
```

```cpp
#include <hip/hip_runtime.h>
#include <cstdio>
#include <cstdint>

constexpr int SEQ = 16384, DM = 2048, NH = 16, HD = 128, NEXP = 32, NGRP = 4, EPG = 8, DEXP = 512;
constexpr float RMS_EPS = 1e-6f;
constexpr int CAP = SEQ;
constexpr int MAXT = 160;

namespace pg8 {
#define PG8_LAS __attribute__((address_space(3)))
typedef unsigned short bf16_t;
typedef short bf16x8 __attribute__((ext_vector_type(8)));
typedef float f32x4 __attribute__((ext_vector_type(4)));
typedef unsigned u32x4 __attribute__((ext_vector_type(4)));
constexpr int BM = 256, BK = 64, HALF = 128, HTB = HALF * BK * 2  , STAGE_BYTES = 8 * HTB, NXCD = 8, WGM = 8;

__host__ __device__ __forceinline__ int lds_byte(int r, int c) { const int st = (r >> 4) * 2 + (c >> 5), rr = r & 15, cc = c & 31, ob = rr * 64 + cc * 2; return st * 1024 + (ob ^ (((ob >> 9) & 1) << 5)); }
__host__ __device__ __forceinline__ void stage_rc(int b, int& R, int& C) { const int st = b / 1024, sb = b % 1024, swz = sb ^ (((sb >> 9) & 1) << 5); R = (st >> 1) * 16 + swz / 64; C = (st & 1) * 32 + (swz % 64) / 2; }
__host__ __device__ __forceinline__ int perm32(int rho) { const int n = rho >> 4, i = rho & 15; return 8 * (i >> 2) + 4 * n + (i & 3); }

struct Unit { int pm, pn; };
struct Gemm { const bf16_t* A; const bf16_t* Bt; int M, N, K; };

struct StaticOrder {
    int nM, nN, nwg, G, c;
    __host__ __device__ void init(int M, int N, int G_, int c_) { nM = M / BM; nN = N / BM; nwg = nM * nN; G = G_; c = c_; }
    __host__ __device__ bool next(int i, Unit& u) const {
        const long L = (long)i * G + c; if (L >= nwg) return false;
        int wgid = (int)L; { const int q = nwg / NXCD, r = nwg % NXCD, xcd = wgid % NXCD, off = wgid / NXCD; wgid = (xcd < r ? xcd * (q + 1) : r * (q + 1) + (xcd - r) * q) + off; }
        const int nig = WGM * nN, gid = wgid / nig, fm = gid * WGM, gsz = (nM - fm) < WGM ? (nM - fm) : WGM;
        u.pm = fm + ((wgid % nig) % gsz); u.pn = (wgid % nig) / gsz; return true;
    }
    __device__ __forceinline__ void a_ready(const Unit&) const {}
    __device__ __forceinline__ void done(const Unit&) const {}
};
__device__ __forceinline__ unsigned cvt_pk_bf16(float lo, float hi) { unsigned r; asm volatile("v_cvt_pk_bf16_f32 %0, %1, %2" : "=v"(r) : "v"(lo), "v"(hi)); return r; }
__device__ __forceinline__ u32x4 pack8(f32x4 v0, f32x4 v1) { u32x4 w; w.x = cvt_pk_bf16(v0[0], v0[1]); w.y = cvt_pk_bf16(v0[2], v0[3]); w.z = cvt_pk_bf16(v1[0], v1[1]); w.w = cvt_pk_bf16(v1[2], v1[3]); return w; }
__device__ __forceinline__ float silu_f(float g) { return g * __builtin_amdgcn_rcpf(1.0f + __builtin_amdgcn_exp2f(g * -1.4426950408889634f)); }

struct EpiConvIn {
    static constexpr bool PERM = true, AFTER_DRAIN = false;
    bf16_t* Z; bf16_t* GO;
    __device__ __forceinline__ void operator()(const f32x4 (&acc)[2][2][4][2], const Unit& u, int wr, int wc, int fr, int fq) const {
        const int row0 = u.pm * BM + wr * 64 + fr;
        if (u.pn < 16) {
            const int col0 = u.pn * 128 + wc * 32 + 8 * fq;
#pragma unroll
            for (int ai = 0; ai < 2; ++ai)
#pragma unroll
                for (int m = 0; m < 4; ++m) { bf16_t* rowp = Z + (size_t)(row0 + ai * HALF + m * 16) * 2048 + col0;
                    *(u32x4*)rowp = pack8(acc[ai][0][m][0] * acc[ai][1][m][0], acc[ai][0][m][1] * acc[ai][1][m][1]); }
        } else {
            const int col0 = (u.pn - 16) * 256 + wc * 32 + 8 * fq;
#pragma unroll
            for (int ai = 0; ai < 2; ++ai)
#pragma unroll
                for (int m = 0; m < 4; ++m) { bf16_t* rowp = GO + (size_t)(row0 + ai * HALF + m * 16) * 2048 + col0;
#pragma unroll
                    for (int bj = 0; bj < 2; ++bj) *(u32x4*)(rowp + bj * HALF) = pack8(acc[ai][bj][m][0], acc[ai][bj][m][1]); }
        }
    }
};
struct EpiResF32 {
    static constexpr bool PERM = false, AFTER_DRAIN = false;
    const float* R; float* C;
    __device__ __forceinline__ void operator()(const f32x4 (&acc)[2][2][4][2], const Unit& u, int wr, int wc, int fr, int fq) const {
        const int row0 = u.pm * BM + wr * 64 + fr, col0 = u.pn * BM + wc * 32 + 4 * fq;
#pragma unroll
        for (int ai = 0; ai < 2; ++ai)
#pragma unroll
            for (int m = 0; m < 4; ++m) { const size_t ro = (size_t)(row0 + ai * HALF + m * 16) * 2048 + col0;
#pragma unroll
                for (int bj = 0; bj < 2; ++bj)
#pragma unroll
                    for (int n = 0; n < 2; ++n) { const size_t o = ro + bj * HALF + n * 16; *(f32x4*)(C + o) = *(const f32x4*)(R + o) + acc[ai][bj][m][n]; } }
    }
};
struct EpiGateUp {
    static constexpr bool PERM = true, AFTER_DRAIN = false;
    bf16_t* H;
    __device__ __forceinline__ void operator()(const f32x4 (&acc)[2][2][4][2], const Unit& u, int wr, int wc, int fr, int fq) const {
        const int row0 = u.pm * BM + wr * 64 + fr, col0 = (u.pn & 3) * 128 + wc * 32 + 8 * fq;
#pragma unroll
        for (int ai = 0; ai < 2; ++ai)
#pragma unroll
            for (int m = 0; m < 4; ++m) { bf16_t* rowp = H + (size_t)(row0 + ai * HALF + m * 16) * 512 + col0;
                f32x4 v0, v1;
#pragma unroll
                for (int j = 0; j < 4; ++j) { v0[j] = silu_f(acc[ai][0][m][0][j]) * acc[ai][1][m][0][j]; v1[j] = silu_f(acc[ai][0][m][1][j]) * acc[ai][1][m][1][j]; }
                *(u32x4*)rowp = pack8(v0, v1); }
    }
};
struct EpiDown {
    static constexpr bool PERM = true, AFTER_DRAIN = false;
    bf16_t* O;
    __device__ __forceinline__ void operator()(const f32x4 (&acc)[2][2][4][2], const Unit& u, int wr, int wc, int fr, int fq) const {
        const int row0 = u.pm * BM + wr * 64 + fr, col0 = (u.pn & 7) * 256 + wc * 32 + 8 * fq;
#pragma unroll
        for (int ai = 0; ai < 2; ++ai)
#pragma unroll
            for (int m = 0; m < 4; ++m) { bf16_t* rowp = O + (size_t)(row0 + ai * HALF + m * 16) * 2048 + col0;
#pragma unroll
                for (int bj = 0; bj < 2; ++bj) *(u32x4*)(rowp + bj * HALF) = pack8(acc[ai][bj][m][0], acc[ai][bj][m][1]); }
    }
};
struct EpiQKV {
    static constexpr bool PERM = true, AFTER_DRAIN = false;
    bf16_t* Q; size_t tstride; float* NB;
    __device__ __forceinline__ void operator()(const f32x4 (&acc)[2][2][4][2], const Unit& u, int wr, int wc, int fr, int fq) const {
        const int which = u.pn >> 3, hp = u.pn & 7; bf16_t* base = Q + (size_t)which * tstride;
        const int row0 = u.pm * BM + wr * 64 + fr, col0 = wc * 32 + 8 * fq;
#pragma unroll
        for (int bj = 0; bj < 2; ++bj) { bf16_t* hb = base + (size_t)(2 * hp + bj) * SEQ * 128 + col0;
            float pmx = 0.f;
#pragma unroll
            for (int ai = 0; ai < 2; ++ai)
#pragma unroll
                for (int m = 0; m < 4; ++m) { const f32x4 a = acc[ai][bj][m][0], b = acc[ai][bj][m][1];
                    *(u32x4*)(hb + (size_t)(row0 + ai * HALF + m * 16) * 128) = pack8(a, b);
                    if (which < 2) { float p = (a[0] * a[0] + a[1] * a[1]) + (a[2] * a[2] + a[3] * a[3]) + (b[0] * b[0] + b[1] * b[1]) + (b[2] * b[2] + b[3] * b[3]);
                        p += __shfl_xor(p, 16); p += __shfl_xor(p, 32); pmx = fmaxf(pmx, p); } }
            if (which < 2) {
#pragma unroll
                for (int o = 1; o < 16; o <<= 1) pmx = fmaxf(pmx, __shfl_xor(pmx, o));
                if (fr == 0 && fq == 0) NB[((which * 16 + 2 * hp + bj) * 64 + u.pm) * 8 + wr * 4 + wc] = pmx; }
        }
    }
};
struct ExpertOrder {
    const PG8_LAS int* tile_e; int n_units, nN, G, c;
    __device__ __forceinline__ bool next(int i, Unit& u) const {
        const int L = i * G + c; if (L >= n_units) return false;
        const int t = L / nN, j = L - t * nN; u.pm = t; u.pn = tile_e[t] * nN + j; return true;
    }
    __device__ __forceinline__ void a_ready(const Unit&) const {}
    __device__ __forceinline__ void done(const Unit&) const {}
};

template <class Epi, class Sched, bool ALIGN_EPI = false, bool SP2 = false>
__device__ __forceinline__ void gemm_phase(PG8_LAS unsigned char* lds, const Gemm g, const Sched& S, const Epi& E) {
    const int tid = threadIdx.x, wid = __builtin_amdgcn_readfirstlane(tid >> 6), lane = tid & 63, wr = wid >> 2, wc = wid & 3, fr = lane & 15, fq = lane >> 4;
    const int K = g.K, nt = K / BK;
    unsigned voffA[2], voffB[2];
#pragma unroll
    for (int i = 0; i < 2; ++i) { int R, C; stage_rc(tid * 16 + i * 8192, R, C); const int Rb = Epi::PERM ? ((R & ~31) + perm32(R & 31)) : R;
        voffA[i] = (unsigned)(R * K + C) * 2u; voffB[i] = (unsigned)(Rb * K + C) * 2u; }
    const size_t kstep = (size_t)(BK * 2);
    const size_t hstep = (size_t)HALF * K * 2;
    const size_t tstep = 2 * hstep;
    const unsigned ldsw = (unsigned)wid * 1024u;
    const int aoff = lds_byte(wr * 64 + fr, fq * 8), boff = lds_byte(wc * 32 + fr, fq * 8);
#define PG8_SA(b, h) (((b) * 2 + (h)) * HTB)
#define PG8_SB(b, h) ((4 + (b) * 2 + (h)) * HTB)
#define PG8_STAGE(bufoff, gbase, voff) do { _Pragma("unroll") for (int _i = 0; _i < 2; ++_i) \
        __builtin_amdgcn_global_load_lds((const unsigned*)((const char*)(gbase) + (voff)[_i]), (PG8_LAS unsigned*)(lds + (bufoff) + ldsw + _i * 8192), 16, 0, 0); } while (0)
#define PG8_LDA(dst, b, h) do { _Pragma("unroll") for (int m = 0; m < 4; ++m) _Pragma("unroll") for (int k = 0; k < 2; ++k) dst[m][k] = *(const PG8_LAS bf16x8*)(lds + PG8_SA(b, h) + aoff + m * 2048 + k * 1024); } while (0)
#define PG8_LDB(dst, b, h) do { _Pragma("unroll") for (int n = 0; n < 2; ++n) _Pragma("unroll") for (int k = 0; k < 2; ++k) dst[n][k] = *(const PG8_LAS bf16x8*)(lds + PG8_SB(b, h) + boff + n * 2048 + k * 1024); } while (0)
#define PG8_MMA(ai, bj, At, Bt) do { __builtin_amdgcn_s_setprio(1); _Pragma("unroll") for (int m = 0; m < 4; ++m) _Pragma("unroll") for (int n = 0; n < 2; ++n) _Pragma("unroll") for (int k = 0; k < 2; ++k) \
        acc[ai][bj][m][n] = __builtin_amdgcn_mfma_f32_16x16x32_bf16(Bt[n][k], At[m][k], acc[ai][bj][m][n], 0, 0, 0); __builtin_amdgcn_s_setprio(0); } while (0)
#define PG8_WAIT_V(n) asm volatile("s_waitcnt vmcnt(" #n ")" ::: "memory")
#define PG8_WAIT_L(n) asm volatile("s_waitcnt lgkmcnt(" #n ")" ::: "memory")
#define PG8_BAR __builtin_amdgcn_s_barrier()
#define PG8_SCHED __builtin_amdgcn_sched_barrier(0)
    Unit cur, nxt; int ui = 0;
    if (!S.next(0, cur)) return;
    f32x4 acc[2][2][4][2];
#pragma unroll
    for (int a = 0; a < 2; ++a)
#pragma unroll
        for (int b = 0; b < 2; ++b)
#pragma unroll
            for (int m = 0; m < 4; ++m)
#pragma unroll
                for (int n = 0; n < 2; ++n) acc[a][b][m][n] = (f32x4){0.f, 0.f, 0.f, 0.f};
    bf16x8 At[4][2], B0[2][2], B1[2][2];
    const char* cA = (const char*)g.A + (size_t)cur.pm * tstep; const char* cB = (const char*)g.Bt + (size_t)cur.pn * tstep;
    S.a_ready(cur);
    if constexpr (SP2) {
        PG8_STAGE(PG8_SB(0, 0), cB, voffB); PG8_STAGE(PG8_SB(0, 1), cB + hstep, voffB); PG8_STAGE(PG8_SA(0, 0), cA, voffA); PG8_STAGE(PG8_SA(0, 1), cA + hstep, voffA);
        if (wr == 1) PG8_BAR;
        PG8_WAIT_V(2); PG8_BAR;
        PG8_STAGE(PG8_SB(1, 0), cB + kstep, voffB); PG8_STAGE(PG8_SA(1, 0), cA + kstep, voffA); PG8_STAGE(PG8_SB(1, 1), cB + hstep + kstep, voffB);
        PG8_WAIT_V(6); PG8_BAR;
    } else {
        PG8_STAGE(PG8_SB(0, 0), cB, voffB); PG8_STAGE(PG8_SA(0, 0), cA, voffA); PG8_STAGE(PG8_SB(0, 1), cB + hstep, voffB); PG8_STAGE(PG8_SA(0, 1), cA + hstep, voffA);
        if (wr == 1) PG8_BAR;
        PG8_WAIT_V(4); PG8_BAR;
        PG8_STAGE(PG8_SB(1, 0), cB + kstep, voffB); PG8_STAGE(PG8_SA(1, 0), cA + kstep, voffA); PG8_STAGE(PG8_SB(1, 1), cB + hstep + kstep, voffB);
        PG8_WAIT_V(6); PG8_BAR;
    }
    for (;;) {
        const bool has_next = S.next(ui + 1, nxt);
        const char* nA = has_next ? (const char*)g.A + (size_t)nxt.pm * tstep : cA; const char* nB = has_next ? (const char*)g.Bt + (size_t)nxt.pn * tstep : cB;
        for (int t = 0; t < nt; t += 2) {
            const bool last = (t == nt - 2);
            const char* a1 = cA + (size_t)(t + 1) * kstep;
            const char* a2 = last ? nA : cA + (size_t)(t + 2) * kstep; const char* b2 = last ? nB : cB + (size_t)(t + 2) * kstep;
            const char* a3 = a2 + kstep; const char* b3 = b2 + kstep;
            if (last && has_next) S.a_ready(nxt);
            if constexpr (SP2) {
            PG8_LDB(B0, 0, 0); PG8_LDB(B1, 0, 1); PG8_SCHED; PG8_LDA(At, 0, 0); PG8_STAGE(PG8_SA(1, 1), a1 + hstep, voffA);
            PG8_WAIT_V(8); PG8_WAIT_L(0); PG8_BAR; PG8_MMA(0, 0, At, B0); PG8_MMA(0, 1, At, B1); PG8_BAR; PG8_SCHED;
            PG8_LDA(At, 0, 1); PG8_STAGE(PG8_SB(0, 0), b2, voffB); PG8_STAGE(PG8_SB(0, 1), b2 + hstep, voffB); PG8_STAGE(PG8_SA(0, 0), a2, voffA);
            PG8_WAIT_V(8); PG8_WAIT_L(0); PG8_BAR; PG8_MMA(1, 0, At, B0); PG8_MMA(1, 1, At, B1); PG8_BAR; PG8_SCHED;
            PG8_LDB(B0, 1, 0); PG8_LDB(B1, 1, 1); PG8_SCHED; PG8_LDA(At, 1, 0); PG8_STAGE(PG8_SA(0, 1), a2 + hstep, voffA);
            PG8_WAIT_V(8); PG8_WAIT_L(0); PG8_BAR; PG8_MMA(0, 0, At, B0); PG8_MMA(0, 1, At, B1); PG8_BAR; PG8_SCHED;
            PG8_LDA(At, 1, 1); PG8_STAGE(PG8_SB(1, 0), b3, voffB); PG8_STAGE(PG8_SB(1, 1), b3 + hstep, voffB); PG8_STAGE(PG8_SA(1, 0), a3, voffA);
            PG8_WAIT_V(8); PG8_WAIT_L(0); PG8_BAR; PG8_MMA(1, 0, At, B0); PG8_MMA(1, 1, At, B1); PG8_BAR; PG8_SCHED;
            } else {
            PG8_LDB(B0, 0, 0); PG8_SCHED; PG8_LDA(At, 0, 0); PG8_STAGE(PG8_SA(1, 1), a1 + hstep, voffA);
            PG8_WAIT_L(8); PG8_BAR; PG8_WAIT_L(0); PG8_MMA(0, 0, At, B0); PG8_BAR; PG8_SCHED;
            PG8_LDB(B1, 0, 1); PG8_STAGE(PG8_SB(0, 0), b2, voffB);
            PG8_BAR; PG8_WAIT_L(0); PG8_MMA(0, 1, At, B1); PG8_BAR;
            PG8_LDA(At, 0, 1); PG8_STAGE(PG8_SA(0, 0), a2, voffA);
            PG8_BAR; PG8_WAIT_L(0); PG8_MMA(1, 0, At, B0); PG8_BAR; PG8_SCHED;
            PG8_STAGE(PG8_SB(0, 1), b2 + hstep, voffB);
            PG8_WAIT_V(6); PG8_BAR; PG8_MMA(1, 1, At, B1); PG8_BAR;
            PG8_LDB(B0, 1, 0); PG8_SCHED; PG8_LDA(At, 1, 0); PG8_STAGE(PG8_SA(0, 1), a2 + hstep, voffA);
            PG8_WAIT_L(8); PG8_BAR; PG8_WAIT_L(0); PG8_MMA(0, 0, At, B0); PG8_BAR; PG8_SCHED;
            PG8_LDB(B1, 1, 1); PG8_STAGE(PG8_SB(1, 0), b3, voffB);
            PG8_BAR; PG8_WAIT_L(0); PG8_MMA(0, 1, At, B1); PG8_BAR;
            PG8_LDA(At, 1, 1); PG8_STAGE(PG8_SA(1, 0), a3, voffA);
            PG8_BAR; PG8_WAIT_L(0); PG8_MMA(1, 0, At, B0); PG8_BAR; PG8_SCHED;
            PG8_STAGE(PG8_SB(1, 1), b3 + hstep, voffB);
            PG8_WAIT_V(6); PG8_BAR; PG8_MMA(1, 1, At, B1); PG8_BAR;
            }
        }
        if constexpr (ALIGN_EPI) { if (wr == 0) PG8_BAR; }
        if constexpr (!Epi::AFTER_DRAIN) { E(acc, cur, wr, wc, fr, fq); S.done(cur); }
        if (!has_next) break;
#pragma unroll
        for (int a = 0; a < 2; ++a)
#pragma unroll
            for (int b = 0; b < 2; ++b)
#pragma unroll
                for (int m = 0; m < 4; ++m)
#pragma unroll
                    for (int n = 0; n < 2; ++n) acc[a][b][m][n] = (f32x4){0.f, 0.f, 0.f, 0.f};
        cur = nxt; cA = nA; cB = nB; ++ui;
        if constexpr (ALIGN_EPI) { if (wr == 1) PG8_BAR; }
    }
    PG8_WAIT_V(0);
    if constexpr (!ALIGN_EPI) { if (wr == 0) PG8_BAR; }
    PG8_BAR;
    if constexpr (Epi::AFTER_DRAIN) { E.fused(acc, cur, wr, wc, fr, fq, lds, wid, lane); S.done(cur); }
#undef PG8_SA
#undef PG8_SB
#undef PG8_STAGE
#undef PG8_LDA
#undef PG8_LDB
#undef PG8_MMA
#undef PG8_WAIT_V
#undef PG8_WAIT_L
#undef PG8_BAR
#undef PG8_SCHED
}
template <class Epi, class Sched>
__device__ __forceinline__ void gemm_phase_gather(PG8_LAS unsigned char* lds, const Gemm g, const Sched& S, const Epi& E, const PG8_LAS unsigned* rtok) {
    const int tid = threadIdx.x, wid = __builtin_amdgcn_readfirstlane(tid >> 6), lane = tid & 63, wr = wid >> 2, wc = wid & 3, fr = lane & 15, fq = lane >> 4;
    const int K = g.K, nt = K / BK;
    unsigned voffB[2];
#pragma unroll
    for (int i = 0; i < 2; ++i) { int R, C; stage_rc(tid * 16 + i * 8192, R, C); const int Rb = Epi::PERM ? ((R & ~31) + perm32(R & 31)) : R;
        voffB[i] = (unsigned)(Rb * K + C) * 2u; }
    unsigned vA[2][2], vN[2][2];
    const size_t kstep = (size_t)(BK * 2);
    const size_t hstep = (size_t)HALF * K * 2;
    const size_t tstep = 2 * hstep;
    const unsigned ldsw = (unsigned)wid * 1024u;
    const int aoff = lds_byte(wr * 64 + fr, fq * 8), boff = lds_byte(wc * 32 + fr, fq * 8);
#define PG8_SA(b, h) (((b) * 2 + (h)) * HTB)
#define PG8_SB(b, h) ((4 + (b) * 2 + (h)) * HTB)
#define PG8_STAGE(bufoff, gbase, voff) do { _Pragma("unroll") for (int _i = 0; _i < 2; ++_i) \
        __builtin_amdgcn_global_load_lds((const unsigned*)((const char*)(gbase) + (voff)[_i]), (PG8_LAS unsigned*)(lds + (bufoff) + ldsw + _i * 8192), 16, 0, 0); } while (0)
#define PG8_STAGE_A(bufoff, kptr, h, usenext) do { _Pragma("unroll") for (int _i = 0; _i < 2; ++_i) \
        __builtin_amdgcn_global_load_lds((const unsigned*)((const char*)(kptr) + ((usenext) ? vN[h][_i] : vA[h][_i])), (PG8_LAS unsigned*)(lds + (bufoff) + ldsw + _i * 8192), 16, 0, 0); } while (0)
#define PG8_LDA(dst, b, h) do { _Pragma("unroll") for (int m = 0; m < 4; ++m) _Pragma("unroll") for (int k = 0; k < 2; ++k) dst[m][k] = *(const PG8_LAS bf16x8*)(lds + PG8_SA(b, h) + aoff + m * 2048 + k * 1024); } while (0)
#define PG8_LDB(dst, b, h) do { _Pragma("unroll") for (int n = 0; n < 2; ++n) _Pragma("unroll") for (int k = 0; k < 2; ++k) dst[n][k] = *(const PG8_LAS bf16x8*)(lds + PG8_SB(b, h) + boff + n * 2048 + k * 1024); } while (0)
#define PG8_MMA(ai, bj, At, Bt) do { __builtin_amdgcn_s_setprio(1); _Pragma("unroll") for (int m = 0; m < 4; ++m) _Pragma("unroll") for (int n = 0; n < 2; ++n) _Pragma("unroll") for (int k = 0; k < 2; ++k) \
        acc[ai][bj][m][n] = __builtin_amdgcn_mfma_f32_16x16x32_bf16(Bt[n][k], At[m][k], acc[ai][bj][m][n], 0, 0, 0); __builtin_amdgcn_s_setprio(0); } while (0)
#define PG8_WAIT_V(n) asm volatile("s_waitcnt vmcnt(" #n ")" ::: "memory")
#define PG8_WAIT_L(n) asm volatile("s_waitcnt lgkmcnt(" #n ")" ::: "memory")
#define PG8_BAR __builtin_amdgcn_s_barrier()
#define PG8_SCHED __builtin_amdgcn_sched_barrier(0)
#define PG8_LOADTOK(dst, ui_) do { int tz_ = threadIdx.x; asm volatile("" : "+v"(tz_)); _Pragma("unroll") for (int i_ = 0; i_ < 2; ++i_) { int R_, C_; stage_rc(tz_ * 16 + i_ * 8192, R_, C_); \
        _Pragma("unroll") for (int h_ = 0; h_ < 2; ++h_) dst[h_][i_] = rtok[(ui_) * 256 + h_ * 128 + R_] + (unsigned)C_ * 2u; } } while (0)
    Unit cur, nxt; int ui = 0;
    if (!S.next(0, cur)) return;
    f32x4 acc[2][2][4][2];
#pragma unroll
    for (int a = 0; a < 2; ++a)
#pragma unroll
        for (int b = 0; b < 2; ++b)
#pragma unroll
            for (int m = 0; m < 4; ++m)
#pragma unroll
                for (int n = 0; n < 2; ++n) acc[a][b][m][n] = (f32x4){0.f, 0.f, 0.f, 0.f};
    bf16x8 At[4][2], B0[2][2], B1[2][2];
    const char* const gA = (const char*)g.A; const char* cB = (const char*)g.Bt + (size_t)cur.pn * tstep;
    PG8_LOADTOK(vA, 0);
#pragma unroll
    for (int h_ = 0; h_ < 2; ++h_)
#pragma unroll
        for (int i_ = 0; i_ < 2; ++i_) vN[h_][i_] = vA[h_][i_];
    PG8_STAGE(PG8_SB(0, 0), cB, voffB); PG8_STAGE(PG8_SB(0, 1), cB + hstep, voffB); PG8_STAGE_A(PG8_SA(0, 0), gA, 0, false); PG8_STAGE_A(PG8_SA(0, 1), gA, 1, false);
    if (wr == 1) PG8_BAR;
    PG8_WAIT_V(2); PG8_BAR;
    PG8_STAGE(PG8_SB(1, 0), cB + kstep, voffB); PG8_STAGE_A(PG8_SA(1, 0), gA + kstep, 0, false); PG8_STAGE(PG8_SB(1, 1), cB + hstep + kstep, voffB);
    PG8_WAIT_V(6); PG8_BAR;
    for (;;) {
        const bool has_next = S.next(ui + 1, nxt);
        const char* nB = has_next ? (const char*)g.Bt + (size_t)nxt.pn * tstep : cB;
        for (int t = 0; t < nt; t += 2) {
            const bool last = (t == nt - 2);
            const char* a1 = gA + (size_t)(t + 1) * kstep;
            const char* a2 = last ? gA : gA + (size_t)(t + 2) * kstep; const char* b2 = last ? nB : cB + (size_t)(t + 2) * kstep;
            const char* a3 = a2 + kstep; const char* b3 = b2 + kstep;
            if (last && has_next) PG8_LOADTOK(vN, ui + 1);
            const bool un = last && has_next;
            PG8_LDB(B0, 0, 0); PG8_LDB(B1, 0, 1); PG8_SCHED; PG8_LDA(At, 0, 0); PG8_STAGE_A(PG8_SA(1, 1), a1, 1, false);
            PG8_WAIT_V(8); PG8_WAIT_L(0); PG8_BAR; PG8_MMA(0, 0, At, B0); PG8_MMA(0, 1, At, B1); PG8_BAR; PG8_SCHED;
            PG8_LDA(At, 0, 1); PG8_STAGE(PG8_SB(0, 0), b2, voffB); PG8_STAGE(PG8_SB(0, 1), b2 + hstep, voffB); PG8_STAGE_A(PG8_SA(0, 0), a2, 0, un);
            PG8_WAIT_V(8); PG8_WAIT_L(0); PG8_BAR; PG8_MMA(1, 0, At, B0); PG8_MMA(1, 1, At, B1); PG8_BAR; PG8_SCHED;
            PG8_LDB(B0, 1, 0); PG8_LDB(B1, 1, 1); PG8_SCHED; PG8_LDA(At, 1, 0); PG8_STAGE_A(PG8_SA(0, 1), a2, 1, un);
            PG8_WAIT_V(8); PG8_WAIT_L(0); PG8_BAR; PG8_MMA(0, 0, At, B0); PG8_MMA(0, 1, At, B1); PG8_BAR; PG8_SCHED;
            PG8_LDA(At, 1, 1); PG8_STAGE(PG8_SB(1, 0), b3, voffB); PG8_STAGE(PG8_SB(1, 1), b3 + hstep, voffB); PG8_STAGE_A(PG8_SA(1, 0), a3, 0, un);
            PG8_WAIT_V(8); PG8_WAIT_L(0); PG8_BAR; PG8_MMA(1, 0, At, B0); PG8_MMA(1, 1, At, B1); PG8_BAR; PG8_SCHED;
        }
        if (wr == 0) PG8_BAR;
        E(acc, cur, wr, wc, fr, fq);
        if (!has_next) break;
#pragma unroll
        for (int a = 0; a < 2; ++a)
#pragma unroll
            for (int b = 0; b < 2; ++b)
#pragma unroll
                for (int m = 0; m < 4; ++m)
#pragma unroll
                    for (int n = 0; n < 2; ++n) acc[a][b][m][n] = (f32x4){0.f, 0.f, 0.f, 0.f};
        cur = nxt; cB = nB; ++ui;
#pragma unroll
        for (int h_ = 0; h_ < 2; ++h_)
#pragma unroll
            for (int i_ = 0; i_ < 2; ++i_) vA[h_][i_] = vN[h_][i_];
        if (wr == 1) PG8_BAR;
    }
    PG8_WAIT_V(0);
    PG8_BAR;
#undef PG8_SA
#undef PG8_SB
#undef PG8_STAGE
#undef PG8_STAGE_A
#undef PG8_LDA
#undef PG8_LDB
#undef PG8_MMA
#undef PG8_WAIT_V
#undef PG8_WAIT_L
#undef PG8_BAR
#undef PG8_SCHED
#undef PG8_LOADTOK
}
}
namespace fox {
#define FOX_LAS __attribute__((address_space(3)))
typedef unsigned short bf16;
typedef short bf16x8 __attribute__((ext_vector_type(8)));
typedef short s16x4 __attribute__((ext_vector_type(4)));
typedef float f32x16 __attribute__((ext_vector_type(16)));
typedef float f32x4 __attribute__((ext_vector_type(4)));
typedef unsigned u32x4 __attribute__((ext_vector_type(4)));
constexpr int D = 128, OPITCH = 2048;
constexpr float SCALE = 0.08838834764831845f;
constexpr float THR = 8.f;
constexpr int NW = 8, QBLK = 32, KVBLK = 64, QB = NW * QBLK;
constexpr int SHM_V = KVBLK * D * 2, SHM_K = KVBLK * D * 2, SHM_X = KVBLK * 4;
constexpr int QN2_OFF = 73728, KN2_OFF = QN2_OFF + 4096, NXT_OFF = KN2_OFF + 4096, WMIN_OFF = NXT_OFF + 16, NPR_OFF = WMIN_OFF + 32;
constexpr float PRUNE_T = 30.0f;
constexpr int LDS_WS_OFF = 2 * SHM_V + 2 * SHM_K, LDS_X_OFF = LDS_WS_OFF + NW * 64 * 4, LDS_BYTES = LDS_X_OFF + 2 * SHM_X;

#define KSWZ(row, colB) ((row) * 256 + ((colB) ^ (((row) & 7) << 4)))
#define SBAR() __builtin_amdgcn_sched_barrier(0)
__device__ __forceinline__ int v_st(int k, int c) { const int kk = (k & ~0xC) | ((k & 4) << 1) | ((k & 8) >> 1); return ((kk >> 3) * 4 + (c >> 5)) * 512 + ((kk & 7) * 32 + (c & 31)) * 2; }
__device__ __forceinline__ int v_rd_base(int lane) { return ((lane & 3) << 3) | (((lane >> 2) & 3) << 6) | (((lane >> 4) & 1) << 5) | (((lane >> 5) & 1) << 8); }
constexpr int v_rd_off(int d0, int ks, int half) { return d0 * 512 + ks * 4096 + half * 2048; }
__device__ __forceinline__ int crow(int r, int hi) { return (r & 3) + 8 * (r >> 2) + 4 * hi; }
__device__ __forceinline__ unsigned cvtpk(float lo, float hi) { unsigned r; asm volatile("v_cvt_pk_bf16_f32 %0, %1, %2" : "=v"(r) : "v"(lo), "v"(hi)); return r; }
__device__ __forceinline__ bf16x8 load8(const bf16* p) { return *reinterpret_cast<const bf16x8*>(p); }
__device__ __forceinline__ void glds16(const void* gsrc, unsigned lds_dst) { unsigned keep;
    asm volatile("s_mov_b32 %0, m0\n\ts_mov_b32 m0, %2\n\ts_nop 0\n\tglobal_load_lds_dwordx4 %1, off\n\ts_mov_b32 m0, %0" : "=&s"(keep) : "v"(gsrc), "s"(lds_dst) : "memory"); }
__device__ __forceinline__ void glds4(const void* gsrc, unsigned lds_dst) { unsigned keep;
    asm volatile("s_mov_b32 %0, m0\n\ts_mov_b32 m0, %2\n\ts_nop 0\n\tglobal_load_lds_dword %1, off\n\ts_mov_b32 m0, %0" : "=&s"(keep) : "v"(gsrc), "s"(lds_dst) : "memory"); }
__device__ __forceinline__ void mask_tile(f32x16& p0, f32x16& p1, int dq) {
    const float NEG = -__builtin_inff();
#pragma unroll
    for (int r = 0; r < 16; ++r) {
        const int c = (r & 3) + 8 * (r >> 2);
        if (dq - c < 0) p0[r] = NEG;
        if (dq - c - 32 < 0) p1[r] = NEG;
    }
}
__device__ __forceinline__ void partialSM(f32x16& p0, f32x16& p1, float& m_reg, float& mn, float& alpha) {
    float pmax = p0[0]; for (int r = 1; r < 16; ++r) pmax = fmaxf(pmax, p0[r]); for (int r = 0; r < 16; ++r) pmax = fmaxf(pmax, p1[r]);
    { auto rr = __builtin_amdgcn_permlane32_swap(__float_as_uint(pmax), __float_as_uint(pmax), false, false);
      pmax = fmaxf(__uint_as_float(rr[0]), __uint_as_float(rr[1])); }
    constexpr float C2 = 1.4426950408889634f * SCALE;
    if (__builtin_expect(__all((pmax - m_reg) * SCALE <= THR), 1)) { mn = m_reg; alpha = 1.f; }
    else { mn = fmaxf(m_reg, pmax); alpha = __builtin_amdgcn_exp2f((m_reg - mn) * C2); m_reg = mn; }
    const float mnL = -mn * C2;
    for (int r = 0; r < 16; ++r) p0[r] = fmaf(p0[r], C2, mnL); for (int r = 0; r < 16; ++r) p1[r] = fmaf(p1[r], C2, mnL);
    for (int r = 0; r < 16; ++r) p0[r] = __builtin_amdgcn_exp2f(p0[r]);
}
__device__ __forceinline__ void finishSM(f32x16& p0, f32x16& p1, float alpha, float& l_reg, bf16x8& pa0, bf16x8& pa1, bf16x8& pa2, bf16x8& pa3) {
    for (int r = 0; r < 16; ++r) p1[r] = __builtin_amdgcn_exp2f(p1[r]);
    float ps = 0; for (int r = 0; r < 16; ++r) ps += p0[r]; for (int r = 0; r < 16; ++r) ps += p1[r];
    { auto rr = __builtin_amdgcn_permlane32_swap(__float_as_uint(ps), __float_as_uint(ps), false, false);
      ps = __uint_as_float(rr[0]) + __uint_as_float(rr[1]); }
    l_reg = l_reg * alpha + ps;
#define PK4(P, B_, OUT) do { unsigned a0 = cvtpk(P[B_+0], P[B_+1]), a1 = cvtpk(P[B_+2], P[B_+3]);                          \
        unsigned b0 = cvtpk(P[B_+4], P[B_+5]), b1 = cvtpk(P[B_+6], P[B_+7]);                                             \
        auto r0 = __builtin_amdgcn_permlane32_swap(a0, b0, false, false); auto r1 = __builtin_amdgcn_permlane32_swap(a1, b1, false, false); \
        u32x4 w = {r0[0], r1[0], r0[1], r1[1]}; OUT = *reinterpret_cast<bf16x8*>(&w); } while (0)
    PK4(p0, 0, pa0); PK4(p0, 8, pa1); PK4(p1, 0, pa2); PK4(p1, 8, pa3);
#undef PK4
}
template <int KB>
__device__ __forceinline__ void qkt(f32x16& p0, f32x16& p1, const char* K_lds, const char* X_lds, int r32, int hi, const bf16x8* qr) {
    { const char* xb = X_lds + KB * SHM_X + hi * 16;
#pragma unroll
      for (int g = 0; g < 4; ++g) { const f32x4 a = *reinterpret_cast<const f32x4*>(xb + g * 32), b = *reinterpret_cast<const f32x4*>(xb + 128 + g * 32);
          p0[4 * g] = a[0]; p0[4 * g + 1] = a[1]; p0[4 * g + 2] = a[2]; p0[4 * g + 3] = a[3]; p1[4 * g] = b[0]; p1[4 * g + 1] = b[1]; p1[4 * g + 2] = b[2]; p1[4 * g + 3] = b[3]; } }
    const char* kb[4];
#pragma unroll
    for (int dd = 0; dd < 4; ++dd) kb[dd] = K_lds + KB * SHM_K + KSWZ(r32, (dd * 16 + hi * 8) * 2);
#pragma unroll
    for (int d0 = 0; d0 < 8; ++d0) { const char* a = kb[d0 & 3] + (d0 >> 2) * 128;
        bf16x8 b0 = *reinterpret_cast<const bf16x8*>(a);
        bf16x8 b1 = *reinterpret_cast<const bf16x8*>(a + 32 * 256);
        p0 = __builtin_amdgcn_mfma_f32_32x32x16_bf16(b0, qr[d0], p0, 0, 0, 0);
        p1 = __builtin_amdgcn_mfma_f32_32x32x16_bf16(b1, qr[d0], p1, 0, 0, 0); }
}
template <int VB>
__device__ __forceinline__ void pv_tile(f32x16* o, int vb0, bf16x8 pa0, bf16x8 pa1, bf16x8 pa2, bf16x8 pa3) {
#define TRRD(dst, off) asm volatile("ds_read_b64_tr_b16 %0, %1 offset:%2" : "=&v"(dst) : "v"(vb0), "i"(off) : "memory")
#define PV_D0(d0) do { s16x4 l0, l1, l2, l3, h0, h1, h2, h3; constexpr int b_ = VB * SHM_V + v_rd_off(d0, 0, 0);     \
        TRRD(l0, b_); TRRD(h0, b_ + 2048); TRRD(l1, b_ + 4096); TRRD(h1, b_ + 6144); TRRD(l2, b_ + 8192); TRRD(h2, b_ + 10240); TRRD(l3, b_ + 12288); TRRD(h3, b_ + 14336); \
        asm volatile("s_waitcnt lgkmcnt(0)" ::: "memory"); SBAR();                                                        \
        o[d0] = __builtin_amdgcn_mfma_f32_32x32x16_bf16(pa0, (bf16x8){l0[0], l0[1], l0[2], l0[3], h0[0], h0[1], h0[2], h0[3]}, o[d0], 0, 0, 0);   \
        o[d0] = __builtin_amdgcn_mfma_f32_32x32x16_bf16(pa1, (bf16x8){l1[0], l1[1], l1[2], l1[3], h1[0], h1[1], h1[2], h1[3]}, o[d0], 0, 0, 0);   \
        o[d0] = __builtin_amdgcn_mfma_f32_32x32x16_bf16(pa2, (bf16x8){l2[0], l2[1], l2[2], l2[3], h2[0], h2[1], h2[2], h2[3]}, o[d0], 0, 0, 0);   \
        o[d0] = __builtin_amdgcn_mfma_f32_32x32x16_bf16(pa3, (bf16x8){l3[0], l3[1], l3[2], l3[3], h3[0], h3[1], h3[2], h3[3]}, o[d0], 0, 0, 0); } while (0)
    PV_D0(0); PV_D0(1); PV_D0(2); PV_D0(3);
#undef PV_D0
#undef TRRD
}
struct Bases { const bf16* Q; const bf16* K; const bf16* V; const float* KX; bf16* O; };
struct BlockRef { int h, qb; };
constexpr int SEQL = 16384;
#define REF_Q(B_, r) ((B_).Q + ((size_t)(r).h * SEQL + (size_t)(r).qb * QB) * D)
#define REF_K(B_, r) ((B_).K + (size_t)(r).h * SEQL * D)
#define REF_V(B_, r) ((B_).V + (size_t)(r).h * SEQL * D)
#define REF_X(B_, r) ((B_).KX + (size_t)(r).h * SEQL)
#define REF_O(B_, r) ((B_).O + (size_t)(r).qb * QB * OPITCH + (r).h * D)
struct Seam { bf16x8 qr[8]; };
__device__ __forceinline__ unsigned k_src_off(int wid, int i, int lane) { const int r7 = 4 * i + (lane >> 4), row = 8 * wid + r7; return (unsigned)(row * 256 + (((lane & 15) ^ r7) << 4)); }
__device__ __forceinline__ unsigned v_src_off(int wid, int i, int lane) { const int st = 4 * wid + 2 * i + (lane >> 5), kk = 8 * (st >> 2) + ((lane & 31) >> 2);
    const int k = (kk & ~0xC) | ((kk & 4) << 1) | ((kk & 8) >> 1); return (unsigned)(k * 256 + ((st & 3) * 32 + (lane & 3) * 8) * 2); }
#define VMWN(n) asm volatile("s_waitcnt vmcnt(%0)" :: "i"(n) : "memory")
#define KDMA(Kp, k0, bf) do { int tz_ = threadIdx.x; asm volatile("" : "+v"(tz_)); const char* g_ = (const char*)(Kp) + (size_t)(k0) * 256;                     \
        glds16(g_ + k_src_off(wid, 0, tz_ & 63), lds32 + 2 * SHM_V + (bf) * SHM_K + wid * 2048); glds16(g_ + k_src_off(wid, 1, tz_ & 63), lds32 + 2 * SHM_V + (bf) * SHM_K + wid * 2048 + 1024); } while (0)
#define VDMA(Vp, k0, bf) do { int tz_ = threadIdx.x; asm volatile("" : "+v"(tz_)); const char* g_ = (const char*)(Vp) + (size_t)(k0) * 256;                     \
        glds16(g_ + v_src_off(wid, 0, tz_ & 63), lds32 + (bf) * SHM_V + wid * 2048); glds16(g_ + v_src_off(wid, 1, tz_ & 63), lds32 + (bf) * SHM_V + wid * 2048 + 1024); } while (0)
#define XDMA(Xp, k0, bf) do { if (wid == 0) glds4((Xp) + (k0) + lane, lds32 + LDS_X_OFF + (bf) * SHM_X); } while (0)
__device__ __forceinline__ void fox_prime(const Bases& BS, const BlockRef& cur, char* lds, unsigned lds32, Seam& S) {
    const int tid = threadIdx.x, wid = __builtin_amdgcn_readfirstlane(tid >> 6), lane = tid & 63, r32 = lane & 31, hi = lane >> 5;
    const int kb0 = cur.qb * QB;
    KDMA(REF_K(BS, cur), kb0, 0); XDMA(REF_X(BS, cur), kb0, 0);
    for (int d0 = 0; d0 < 8; ++d0) S.qr[d0] = load8(REF_Q(BS, cur) + (size_t)(wid * QBLK + r32) * D + d0 * 16 + hi * 8);
    VMWN(8);
    __syncthreads();
}
__device__ __forceinline__ void fox_block(const Bases& BS, const BlockRef& cur, char* lds, unsigned lds32, Seam& S, BlockRef& nxo) {
    const int tid = threadIdx.x, wid = __builtin_amdgcn_readfirstlane(tid >> 6), lane = tid & 63, r32 = lane & 31, hi = lane >> 5;
    const int P0 = cur.qb * QB;
    const int jd = 4 * cur.qb;
    int NT = 4 + jd;
    const int qlo = P0 + wid * QBLK, qm = qlo + r32 - 4 * hi;
    const char* K_lds = lds + 2 * SHM_V; const char* X_lds = lds + LDS_X_OFF;
    float* ws = (float*)(lds + LDS_WS_OFF) + wid * 64; float* li_l = ws, * al_l = ws + 32;
    float m_reg = -1e30f, l_reg = 0; f32x16 o[4] = {};
    const int vb0 = (int)lds32 + v_rd_base(lane);
    const bf16* Kh = REF_K(BS, cur); const bf16* Vh = REF_V(BS, cur); const float* Xh = REF_X(BS, cur);
    const float qkb = ((const float*)(lds + QN2_OFF))[cur.h * 64 + cur.qb];
    if (tid == 0) *(int*)(lds + NPR_OFF) = 0;
#define RESC(a) do { if (__any((a) < 1.f)) { if (hi == 0) al_l[r32] = (a); asm volatile("s_waitcnt lgkmcnt(0)" ::: "memory");              \
                     for (int d_ = 0; d_ < 4; ++d_) for (int r = 0; r < 16; ++r) o[d_][r] *= al_l[crow(r, hi)]; } } while (0)
#define KBASE(t) (((t) < 4 ? jd + (t) : jd + 3 - (t)) * KVBLK)
#define MASKT(P0_, P1_, t) do { const int kb_ = KBASE(t); if (kb_ + KVBLK - 1 > qlo) mask_tile(P0_, P1_, qm - kb_); } while (0)
    f32x16 pA0, pA1, pB0, pB1; float mnA, mnB, alA, alB; bf16x8 pa0, pa1, pa2, pa3;
    VDMA(Vh, KBASE(0), 0); KDMA(Kh, KBASE(1), 1); XDMA(Xh, KBASE(1), 1); VDMA(Vh, KBASE(1), 1);
    SBAR(); qkt<0>(pA0, pA1, K_lds, X_lds, r32, hi, S.qr);
    MASKT(pA0, pA1, 0); partialSM(pA0, pA1, m_reg, mnA, alA);
    VMWN(0);
    __syncthreads();
#define HALF_STEP(PX0, PX1, mnX, alX, PY0, PY1, alY, t, KB, VB, SB) do {                                                      \
        if ((t) + 1 < NT) { KDMA(Kh, KBASE((t) + 1), SB); XDMA(Xh, KBASE((t) + 1), SB); }                                      \
        SBAR(); qkt<KB>(PX0, PX1, K_lds, X_lds, r32, hi, S.qr);                                                               \
        finishSM(PY0, PY1, alY, l_reg, pa0, pa1, pa2, pa3); SBAR();                                                           \
        pv_tile<VB>(o, vb0, pa0, pa1, pa2, pa3); MASKT(PX0, PX1, (t)); partialSM(PX0, PX1, m_reg, mnX, alX);                  \
        if ((t) == 2) { float wm_ = m_reg; _Pragma("unroll") for (int o_ = 1; o_ < 32; o_ <<= 1) wm_ = fminf(wm_, __shfl_xor(wm_, o_));                       \
                        if (lane == 0) ((float*)(lds + WMIN_OFF))[wid] = wm_; }                                                \
        __syncthreads();                                                                                                      \
        float bv_ = 0.f; if ((t) == 2 && tid < jd) bv_ = Xh[tid * KVBLK + KVBLK - 1];                                           \
        if ((t) + 1 < NT) VDMA(Vh, KBASE((t) + 1), SB);                                                                        \
        RESC(alX);                                                                                                            \
        if ((t) + 1 < NT) VMWN(2); else VMWN(0);                                                                               \
        if ((t) == 2 && tid < jd) { const float* wm_ = (const float*)(lds + WMIN_OFF);                                          \
            const float mm_ = fminf(fminf(fminf(wm_[0], wm_[1]), fminf(wm_[2], wm_[3])), fminf(fminf(wm_[4], wm_[5]), fminf(wm_[6], wm_[7])));                   \
            if (bv_ < mm_ - qkb - PRUNE_T * (1.0f / SCALE)) __hip_atomic_fetch_add((int*)(lds + NPR_OFF), 1, __ATOMIC_RELAXED, __HIP_MEMORY_SCOPE_WORKGROUP); } \
        __syncthreads();                                                                                                      \
        if ((t) == 2) NT = 4 + jd - __builtin_amdgcn_readfirstlane(*(const int*)(lds + NPR_OFF)); } while (0)
    for (int t = 1; t + 1 < NT; t += 2) {
        HALF_STEP(pB0, pB1, mnB, alB, pA0, pA1, alA, t, 1, 0, 0);
        HALF_STEP(pA0, pA1, mnA, alA, pB0, pB1, alB, t + 1, 0, 1, 1);
    }
    const bool even = (NT & 1) == 0;
    if (even) { SBAR(); qkt<1>(pB0, pB1, K_lds, X_lds, r32, hi, S.qr); SBAR(); }
    BlockRef nxt = cur; { const int nid = __builtin_amdgcn_readfirstlane(*(const int*)(lds + NXT_OFF)); nxo.h = -1; nxo.qb = 0;
        if (nid < 1024) { nxt.h = nid & 15; nxt.qb = 63 - (nid >> 4); nxo = nxt; } }
    const int kbn = nxt.qb * QB;
    VMWN(0);
    KDMA(REF_K(BS, nxt), kbn, 0); XDMA(REF_X(BS, nxt), kbn, 0); SBAR();
#pragma unroll
    for (int d0 = 0; d0 < 8; ++d0) S.qr[d0] = load8(REF_Q(BS, nxt) + (size_t)(wid * QBLK + r32) * D + d0 * 16 + hi * 8);
    SBAR();
    finishSM(pA0, pA1, alA, l_reg, pa0, pa1, pa2, pa3); SBAR();
    __syncthreads();
    pv_tile<0>(o, vb0, pa0, pa1, pa2, pa3);
    if (even) { MASKT(pB0, pB1, NT - 1); partialSM(pB0, pB1, m_reg, mnB, alB); RESC(alB);
        finishSM(pB0, pB1, alB, l_reg, pa0, pa1, pa2, pa3); SBAR(); pv_tile<1>(o, vb0, pa0, pa1, pa2, pa3); }
    SBAR(); VMWN(8); SBAR();
    if (hi == 0) li_l[r32] = l_reg; asm volatile("s_waitcnt lgkmcnt(0)" ::: "memory");
    float rli[16];
#pragma unroll
    for (int r = 0; r < 16; ++r) rli[r] = __builtin_amdgcn_rcpf(li_l[crow(r, hi)]);
    bf16* Ow = REF_O(BS, cur) + (size_t)(wid * QBLK) * OPITCH;
#pragma unroll
    for (int r = 0; r < 16; ++r) { const int orow = crow(r, hi);
#pragma unroll
        for (int d0 = 0; d0 < 4; ++d0) { const float v = o[d0][r] * rli[r];
            const float vn = __shfl_xor(v, 1);
            if ((r32 & 1) == 0) *(unsigned*)(Ow + (size_t)orow * OPITCH + d0 * 32 + r32) = cvtpk(v, vn); } }
    __syncthreads();
#undef RESC
#undef KBASE
#undef MASKT
#undef HALF_STEP
}
#undef REF_Q
#undef REF_K
#undef REF_V
#undef REF_X
#undef REF_O
#undef VMWN
#undef XDMA
#undef KDMA
#undef VDMA
#undef KSWZ
#undef SBAR
}

constexpr int NWAVES = 8;
#ifndef MK_N_LAUNCHES
#define MK_N_LAUNCHES 1
#endif
constexpr int N_PHASES = 17;

constexpr size_t MiB = 1u << 20;
constexpr size_t WS_CTL = 0, CTL_ZERO_BYTES = 64 * 1024;
constexpr size_t WS_TOKE = 1 * MiB, WS_TOKW0 = WS_TOKE + 65536, WS_TOKW1 = WS_TOKW0 + 65536, WS_TOKP0 = WS_TOKW1 + 65536, WS_TOKP1 = WS_TOKP0 + 65536;
constexpr size_t WS_SLOT = 2 * MiB;
constexpr size_t WS_LC = 4 * MiB;
constexpr size_t WS_CT = 5 * MiB;
constexpr size_t WS_WR = 5 * MiB + 512 * 1024;
constexpr size_t WS_WF = 6 * MiB;
constexpr size_t WS_NB = 7 * MiB + 512 * 1024;
constexpr size_t WS_KX = 8 * MiB;
constexpr size_t WS_WCIN = 16 * MiB, WS_WCOUT = 40 * MiB, WS_WAIN = 48 * MiB, WS_WAOUT = 72 * MiB;
constexpr size_t WS_WGU = 80 * MiB;
constexpr size_t WS_WD = 336 * MiB;
constexpr size_t WS_HN = 464 * MiB;
constexpr size_t WS_X = 528 * MiB;
constexpr size_t WS_STAGE = 656 * MiB;
constexpr size_t WS_Y = WS_STAGE;
constexpr size_t WS_Z = WS_STAGE, WS_GO = WS_STAGE + 64 * MiB;
constexpr size_t WS_XS = WS_STAGE, WS_H = WS_STAGE + 160 * MiB;
constexpr size_t WS_Q = WS_STAGE, WS_K = WS_STAGE + 64 * MiB, WS_V = WS_STAGE + 128 * MiB;
constexpr size_t WS_END = 856 * MiB;
constexpr int CW_ATT = 32;
constexpr int CW_CNT = 64;
constexpr int CW_BAR = 4096;
constexpr int RING_OFF = 0, RING_BYTES = 131072;
constexpr int TILE_OFF = RING_BYTES;
constexpr int TST_OFF = TILE_OFF + 1024;
constexpr int MISC_OFF = TST_OFF + 512;
constexpr int RTOK_OFF = MISC_OFF + 128;
constexpr int LDS_BYTES = 147456;
static_assert(RTOK_OFF + 4096 <= LDS_BYTES && fox::LDS_BYTES <= RING_BYTES, "LDS map");

#define GAS __attribute__((address_space(1)))
#define LAS __attribute__((address_space(3)))
typedef unsigned short bf16;
typedef unsigned v4u __attribute__((ext_vector_type(4)));
typedef unsigned v2u __attribute__((ext_vector_type(2)));
typedef float f32x4 __attribute__((ext_vector_type(4)));
typedef float f32x16 __attribute__((ext_vector_type(16)));
typedef short bf16x8 __attribute__((ext_vector_type(8)));
typedef GAS unsigned gu32;
#define RLX_AGENT __ATOMIC_RELAXED, __HIP_MEMORY_SCOPE_AGENT
#define LDS_WAIT() asm volatile("s_waitcnt lgkmcnt(0)" ::: "memory")
#define VM_WAIT() asm volatile("s_waitcnt vmcnt(0)" ::: "memory")
__device__ __forceinline__ unsigned f2bf(float f) { unsigned u = __builtin_bit_cast(unsigned, f); return (u + 0x7fffu + ((u >> 16) & 1u)) >> 16; }
__device__ __forceinline__ unsigned pk2(float lo, float hi) { return f2bf(lo) | (f2bf(hi) << 16); }
__device__ __forceinline__ float bf_lo(unsigned w) { return __builtin_bit_cast(float, w << 16); }
__device__ __forceinline__ float bf_hi(unsigned w) { return __builtin_bit_cast(float, w & 0xffff0000u); }
__device__ __forceinline__ float wave_sum(float v) {
#pragma unroll
    for (int o = 1; o < 64; o <<= 1) v += __shfl_xor(v, o);
    return v;
}

#define XB_TMO      128
#define XB_XCNT(j)  (256  + 64 * (j))
#define XB_XSUB(j)  (1280 + 64 * (j))
#define XB_XGEN(j)  (2304 + 64 * (j))
#define XB_TOP      3328
#define XB_TOPGEN   3392
#define XCD_BAR_WORDS 3456
#define XB_SPIN_CAP (1u << 18)

__device__ __forceinline__ unsigned xb_ld(unsigned* p)              { return __hip_atomic_load(p, __ATOMIC_RELAXED, __HIP_MEMORY_SCOPE_AGENT); }
__device__ __forceinline__ unsigned xb_add(unsigned* p, unsigned v) { return __hip_atomic_fetch_add(p, v, __ATOMIC_RELAXED, __HIP_MEMORY_SCOPE_AGENT); }
__device__ __forceinline__ unsigned xb_xcc_id() { return (unsigned)__builtin_amdgcn_s_getreg((3 << 11) | 20) & 0xFu; }
#define XB_SPIN(cond, bar) do { unsigned _sp = 0; while (cond) { __builtin_amdgcn_s_sleep(1); \
    if ((++_sp & 255u) == 0u) { if (xb_ld(&(bar)[XB_TMO])) break; if (_sp > XB_SPIN_CAP) { atomicAdd(&(bar)[XB_TMO], 1u); break; } } } } while (0)

struct XcdBarrier {
    unsigned* bar; unsigned x;
    volatile LAS unsigned* st;
};

__device__ __forceinline__ XcdBarrier xcd_barrier_post(unsigned* bar, volatile LAS unsigned* st) {
    XcdBarrier b; b.bar = bar; b.x = xb_xcc_id(); b.st = st;
    if (threadIdx.x == 0) (void)xb_add(&bar[XB_XCNT(b.x)], 1u);
    return b;
}
__device__ __forceinline__ void xcd_barrier_complete(unsigned* bar, unsigned x, unsigned& nloc, unsigned& nx) {
    const unsigned G = gridDim.x * gridDim.y * gridDim.z;
    unsigned sum, cnt, mine, sp = 0u;
    for (;;) {
        sum = 0u; cnt = 0u; mine = 0u;
#pragma unroll
        for (unsigned j = 0; j < 16; ++j) { const unsigned c = xb_ld(&bar[XB_XCNT(j)]); sum += c; cnt += (c > 0u) ? 1u : 0u; mine = (j == x) ? c : mine; }
        if (sum == G) break;
        __builtin_amdgcn_s_sleep(1);
        if ((++sp & 255u) == 0u) { if (xb_ld(&bar[XB_TMO])) break; if (sp > XB_SPIN_CAP) { atomicAdd(&bar[XB_TMO], 1u); break; } }
    }
    nloc = mine > 0u ? mine : 1u; nx = cnt > 0u ? cnt : 1u;
}

__device__ __forceinline__ void xcd_barrier(const XcdBarrier& b) {
    asm volatile("s_waitcnt vmcnt(0)" ::: "memory");
    __syncthreads();
    if (threadIdx.x == 0) {
        unsigned* bar = b.bar;
        __builtin_amdgcn_s_waitcnt(0);
        unsigned nloc = b.st[0], nx = b.st[1];
        if (nloc == 0u) { xcd_barrier_complete(bar, b.x, nloc, nx); b.st[0] = nloc; b.st[1] = nx; }
        const unsigned old = xb_add(&bar[XB_XSUB(b.x)], 1u);
        const unsigned gen = old / nloc;
        if (old + 1u == (gen + 1u) * nloc) {
            __builtin_amdgcn_fence(__ATOMIC_RELEASE, "agent");
            asm volatile("s_waitcnt vmcnt(0)" ::: "memory");
            const unsigned og = xb_add(&bar[XB_TOP], 1u);
            const unsigned tg = og / nx;
            if (og + 1u == (tg + 1u) * nx) xb_add(&bar[XB_TOPGEN], 1u);
            else XB_SPIN(xb_ld(&bar[XB_TOPGEN]) == tg, bar);
            __builtin_amdgcn_fence(__ATOMIC_ACQUIRE, "agent");
            xb_add(&bar[XB_XGEN(b.x)], 1u);
            asm volatile("s_waitcnt vmcnt(0)" ::: "memory");
        } else {
            XB_SPIN(xb_ld(&bar[XB_XGEN(b.x)]) == gen, bar);
            __builtin_amdgcn_fence(__ATOMIC_ACQUIRE, "agent");
            asm volatile("s_waitcnt vmcnt(0)" ::: "memory");
        }
    }
    __syncthreads();
}

struct Frame {
    LAS unsigned char* lds;
    volatile LAS unsigned* MISC;
    gu32* ctl;
    int tid, lane, wave;
    int vcu, G;
    const float *x, *mix_norm, *ffn_norm, *final_norm, *conv_w_in, *conv_w, *conv_w_out, *attn_w_in, *attn_b_f, *attn_w_out, *rg_w, *rg_b, *re_w, *re_b, *w_gate, *w_up, *w_down;
    float* out; unsigned char* ws;
};
#define WSP(T, off) ((T*)(F.ws + (off)))

struct TrItem { const float* src; bf16* dst; int ldw, ldd; };
__device__ __forceinline__ bool tr_decode(const Frame& F, int it, TrItem& d) {
    if (it < 6144) { const int kb = it / 192, nb = it % 192, n0 = nb * 32; d.src = F.conv_w_in + (size_t)(kb * 64) * 6144 + n0; d.ldw = 6144; d.ldd = 2048;
        int dr; if (n0 < 2048) dr = 4096 + n0; else if (n0 < 4096) { const int i = n0 - 2048; dr = 256 * (i >> 7) + (i & 127); } else { const int i = n0 - 4096; dr = 256 * (i >> 7) + 128 + (i & 127); }
        d.dst = WSP(bf16, WS_WCIN) + (size_t)dr * 2048 + kb * 64; return true; }
    it -= 6144;
    if (it < 2048) { const int kb = it / 64, nb = it % 64; d.src = F.conv_w_out + (size_t)(kb * 64) * 2048 + nb * 32; d.ldw = 2048; d.ldd = 2048; d.dst = WSP(bf16, WS_WCOUT) + (size_t)(nb * 32) * 2048 + kb * 64; return true; }
    it -= 2048;
    if (it < 6144) { const int kb = it / 192, nb = it % 192; d.src = F.attn_w_in + (size_t)(kb * 64) * 6160 + nb * 32; d.ldw = 6160; d.ldd = 2048; d.dst = WSP(bf16, WS_WAIN) + (size_t)(nb * 32) * 2048 + kb * 64; return true; }
    it -= 6144;
    if (it < 2048) { const int kb = it / 64, nb = it % 64; d.src = F.attn_w_out + (size_t)(kb * 64) * 2048 + nb * 32; d.ldw = 2048; d.ldd = 2048; d.dst = WSP(bf16, WS_WAOUT) + (size_t)(nb * 32) * 2048 + kb * 64; return true; }
    it -= 2048;
    if (it < 65536) { const int up = it >> 15, r = it & 32767, le = r >> 9, q = r & 511, kb = q >> 4, nb = q & 15, n0 = nb * 32;
        d.src = (up ? F.w_up : F.w_gate) + (size_t)le * 2048 * 512 + (size_t)(kb * 64) * 512 + n0; d.ldw = 512; d.ldd = 2048;
        const int dr = 256 * (n0 >> 7) + 128 * up + (n0 & 127);
        d.dst = WSP(bf16, WS_WGU) + ((size_t)le * 1024 + dr) * 2048 + kb * 64; return true; }
    it -= 65536;
    if (it < 32768) { const int le = it >> 9, q = it & 511, kb = q >> 6, nb = q & 63;
        d.src = F.w_down + (size_t)le * 512 * 2048 + (size_t)(kb * 64) * 2048 + nb * 32; d.ldw = 2048; d.ldd = 512;
        d.dst = WSP(bf16, WS_WD) + ((size_t)le * 2048 + nb * 32) * 512 + kb * 64; return true; }
    return false;
}
constexpr int TR_NITEMS = 6144 + 2048 + 6144 + 2048 + 65536 + 32768;
__device__ __forceinline__ void p0_prologue(Frame& F) {
    LAS float* scr = (LAS float*)(F.lds + RING_OFF + F.wave * 16384);
    const int gw = F.vcu * NWAVES + F.wave, NGW = F.G * NWAVES, lane = F.lane;
#define TR_LOAD(v, d) do { _Pragma("unroll") for (int i = 0; i < 32; ++i) v[i] = (d).src[(size_t)(2 * i + (lane >> 5)) * (d).ldw + (lane & 31)]; } while (0)
#define TR_FLUSH(v, d, sc) do { _Pragma("unroll") for (int i = 0; i < 32; ++i) { const int kk = 2 * i + (lane >> 5); (sc)[kk * 32 + ((lane ^ kk) & 31)] = v[i]; } } while (0)
#define TR_STORE(d, sc) do { LDS_WAIT(); asm volatile("" ::: "memory"); const int c = lane & 7;                                                                       \
        _Pragma("unroll") for (int j = 0; j < 4; ++j) { const int n = (lane >> 3) + 8 * j; float t[8];                                                               \
            _Pragma("unroll") for (int q = 0; q < 8; ++q) { const int kk = 8 * c + q; t[q] = (sc)[kk * 32 + ((n ^ kk) & 31)]; }                                       \
            v4u o; o.x = pk2(t[0], t[1]); o.y = pk2(t[2], t[3]); o.z = pk2(t[4], t[5]); o.w = pk2(t[6], t[7]);                                                        \
            *(GAS v4u*)((d).dst + (size_t)n * (d).ldd + 8 * c) = o; }                                                                                                 \
        LDS_WAIT(); asm volatile("" ::: "memory"); } while (0)
    float va[32], vb[32]; TrItem da, db, na, nb; int it = gw;
    bool ha = tr_decode(F, it, da), hb = tr_decode(F, it + NGW, db);
    if (ha) TR_LOAD(va, da);
    if (hb) TR_LOAD(vb, db);
    while (ha) {
        TR_FLUSH(va, da, scr);
        const bool hna = tr_decode(F, it + 2 * NGW, na);
        if (hna) TR_LOAD(va, na);
        TR_STORE(da, scr);
        if (hb) {
            TR_FLUSH(vb, db, scr + 2048);
            const bool hnb = tr_decode(F, it + 3 * NGW, nb);
            if (hnb) TR_LOAD(vb, nb);
            TR_STORE(db, scr + 2048);
            db = nb; hb = hnb;
        }
        da = na; ha = hna; it += 2 * NGW;
    }
#undef TR_LOAD
#undef TR_FLUSH
#undef TR_STORE
    const int gt = (F.vcu * NWAVES + F.wave) * 64 + lane, NGT = F.G * NWAVES * 64;
    for (int i = gt; i < 2 * 64 * 2048; i += NGT) { const int l = i >> 17, r = (i >> 11) & 63, k = i & 2047; float w = 0.f;
        if (r < 4) w = F.rg_w[((size_t)l * 2048 + k) * 4 + r];
        else if (r < 36) { const int g = (r - 4) >> 3, e = (r - 4) & 7; w = F.re_w[(((size_t)l * 4 + g) * 2048 + k) * 8 + e]; }
        WSP(bf16, WS_WR)[i] = (bf16)f2bf(w); }
    for (int i = gt; i < 32 * 2048; i += NGT) { const int r = i >> 11, k = i & 2047; const float w = r < 16 ? F.attn_w_in[(size_t)k * 6160 + 6144 + r] : 0.f; WSP(bf16, WS_WF)[i] = (bf16)f2bf(w); }
}

template <int NB>
__device__ __forceinline__ void small_gemm(const Frame& F, const bf16* hn_rows, const bf16* Wt, LAS float* lg) {
    constexpr int NC = NB * 32, NE = 64 * NC, PER = NE / 512;
    const int lane = F.lane, r32 = lane & 31, hi = lane >> 5, kw = F.wave * 256;
    f32x16 acc[2][NB];
#pragma unroll
    for (int a = 0; a < 2; ++a)
#pragma unroll
        for (int b = 0; b < NB; ++b) acc[a][b] = f32x16{};
    const bf16* ap = hn_rows + (size_t)r32 * 2048 + kw + hi * 8; const bf16* bp = Wt + (size_t)r32 * 2048 + kw + hi * 8;
#pragma unroll 4
    for (int ks = 0; ks < 16; ++ks) {
        const bf16x8 a0 = *(const bf16x8*)(ap + ks * 16), a1 = *(const bf16x8*)(ap + 32 * 2048 + ks * 16);
#pragma unroll
        for (int b = 0; b < NB; ++b) { const bf16x8 bv = *(const bf16x8*)(bp + (size_t)b * 32 * 2048 + ks * 16);
            acc[0][b] = __builtin_amdgcn_mfma_f32_32x32x16_bf16(a0, bv, acc[0][b], 0, 0, 0);
            acc[1][b] = __builtin_amdgcn_mfma_f32_32x32x16_bf16(a1, bv, acc[1][b], 0, 0, 0); }
    }
    LAS float* part = lg + F.wave * NE;
#pragma unroll
    for (int a = 0; a < 2; ++a)
#pragma unroll
        for (int b = 0; b < NB; ++b)
#pragma unroll
            for (int r = 0; r < 16; ++r) { const int row = a * 32 + (r & 3) + 8 * (r >> 2) + 4 * hi; part[row * NC + b * 32 + r32] = acc[a][b][r]; }
    LDS_WAIT(); __syncthreads();
    float s[PER];
#pragma unroll
    for (int q = 0; q < PER; ++q) { const int i = F.tid + 512 * q; float t = lg[i];
#pragma unroll
        for (int w = 1; w < 8; ++w) t += lg[w * NE + i];
        s[q] = t; }
    LDS_WAIT(); __syncthreads();
#pragma unroll
    for (int q = 0; q < PER; ++q) { const int i = F.tid + 512 * q; lg[(i / NC) * (NC + 1) + (i % NC)] = s[q]; }
    LDS_WAIT(); __syncthreads();
}
__device__ __forceinline__ int build_tiles(Frame& F, int layer) {
    LAS int* tile_e = (LAS int*)(F.lds + TILE_OFF); LAS int* tst = (LAS int*)(F.lds + TST_OFF);
    __syncthreads();
    if (F.tid < 64) {
        const int c = F.tid < 32 ? (int)__hip_atomic_load(F.ctl + CW_CNT + 32 * layer + F.tid, RLX_AGENT) : 0;
        const int nt = (c + 255) >> 8; int inc = nt;
#pragma unroll
        for (int o = 1; o < 32; o <<= 1) { const int t = __shfl_up(inc, o); if ((F.tid & 63) >= o) inc += t; }
        const int st = inc - nt;
        if (F.tid < 32) { tst[F.tid] = st; tst[32 + F.tid] = c; for (int t = 0; t < nt; ++t) tile_e[st + t] = F.tid; }
        if (F.tid == 31) tst[64] = inc;
    }
    __syncthreads();
    return tst[64];
}
template <int MODE>
__device__ __forceinline__ void row_phase(Frame& F, int layer) {
    const int lane = F.lane, wave = F.wave, tid = F.tid;
    const float* gain = MODE == 0 ? F.mix_norm : (MODE == 1 ? F.ffn_norm + layer * DM : (MODE == 2 ? F.mix_norm + DM : F.final_norm));
    f32x4 g[8];
#pragma unroll
    for (int j = 0; j < 4; ++j) { g[2 * j] = *(const f32x4*)(gain + 512 * j + 8 * lane); g[2 * j + 1] = *(const f32x4*)(gain + 512 * j + 8 * lane + 4); }
    LAS float* lg = (LAS float*)(F.lds + RING_OFF);
    LAS int* hist = (LAS int*)(F.lds + TILE_OFF);
    LAS int* tst = (LAS int*)(F.lds + TST_OFF);
    if (MODE >= 2) (void)build_tiles(F, MODE == 2 ? 0 : 1);
    const bool XF32 = (MODE == 0 || (MODE == 1 && layer == 0));
    bf16* HN = WSP(bf16, WS_HN);
    for (int chunk = F.vcu; chunk < SEQ / 64; chunk += F.G) {
        const int row0 = chunk * 64;
        if (MODE == 1) { if (tid < 64) hist[tid] = 0; }
        for (int i = 0; i < 8; ++i) {
            const int row = row0 + wave * 8 + i;
            f32x4 v[8];
            if (XF32) { const float* xr = F.x + (size_t)row * DM + 8 * lane;
#pragma unroll
                for (int j = 0; j < 4; ++j) { v[2 * j] = *(const f32x4*)(xr + 512 * j); v[2 * j + 1] = *(const f32x4*)(xr + 512 * j + 4); } }
            else { const bf16* xr = WSP(bf16, WS_X) + (size_t)row * DM + 8 * lane;
#pragma unroll
                for (int j = 0; j < 4; ++j) { const v4u a = *(const v4u*)(xr + 512 * j);
                    v[2 * j] = (f32x4){bf_lo(a.x), bf_hi(a.x), bf_lo(a.y), bf_hi(a.y)}; v[2 * j + 1] = (f32x4){bf_lo(a.z), bf_hi(a.z), bf_lo(a.w), bf_hi(a.w)}; } }
            if (MODE == 1) { const bf16* yr = WSP(bf16, WS_Y) + (size_t)row * DM + 8 * lane;
#pragma unroll
                for (int j = 0; j < 4; ++j) { const v4u a = *(const v4u*)(yr + 512 * j);
                    v[2 * j][0] += bf_lo(a.x); v[2 * j][1] += bf_hi(a.x); v[2 * j][2] += bf_lo(a.y); v[2 * j][3] += bf_hi(a.y);
                    v[2 * j + 1][0] += bf_lo(a.z); v[2 * j + 1][1] += bf_hi(a.z); v[2 * j + 1][2] += bf_lo(a.w); v[2 * j + 1][3] += bf_hi(a.w); } }
            if (MODE >= 2) {
                const unsigned ee = WSP(unsigned, WS_TOKE)[row]; const int e0 = ee & 255, e1 = (ee >> 8) & 255;
                const int r0 = tst[e0] * 256 + WSP(int, WS_TOKP0)[row], r1 = tst[e1] * 256 + WSP(int, WS_TOKP1)[row];
                const float w0 = WSP(float, WS_TOKW0)[row], w1 = WSP(float, WS_TOKW1)[row];
                const bf16* o0 = WSP(bf16, WS_XS) + (size_t)r0 * DM + 8 * lane; const bf16* o1 = WSP(bf16, WS_XS) + (size_t)r1 * DM + 8 * lane;
#pragma unroll
                for (int j = 0; j < 4; ++j) { const v4u a = *(const v4u*)(o0 + 512 * j), b = *(const v4u*)(o1 + 512 * j);
                    v[2 * j][0] += w0 * bf_lo(a.x) + w1 * bf_lo(b.x); v[2 * j][1] += w0 * bf_hi(a.x) + w1 * bf_hi(b.x);
                    v[2 * j][2] += w0 * bf_lo(a.y) + w1 * bf_lo(b.y); v[2 * j][3] += w0 * bf_hi(a.y) + w1 * bf_hi(b.y);
                    v[2 * j + 1][0] += w0 * bf_lo(a.z) + w1 * bf_lo(b.z); v[2 * j + 1][1] += w0 * bf_hi(a.z) + w1 * bf_hi(b.z);
                    v[2 * j + 1][2] += w0 * bf_lo(a.w) + w1 * bf_lo(b.w); v[2 * j + 1][3] += w0 * bf_hi(a.w) + w1 * bf_hi(b.w); }
            }
            float ss = 0.f;
#pragma unroll
            for (int j = 0; j < 8; ++j) ss += (v[j][0] * v[j][0] + v[j][1] * v[j][1]) + (v[j][2] * v[j][2] + v[j][3] * v[j][3]);
            const float rstd = 1.0f / sqrtf(wave_sum(ss) * (1.0f / DM) + RMS_EPS);
            if (MODE == 1 || MODE == 2) { bf16* xw = WSP(bf16, WS_X) + (size_t)row * DM + 8 * lane;
#pragma unroll
                for (int j = 0; j < 4; ++j) { v4u o; o.x = pk2(v[2 * j][0], v[2 * j][1]); o.y = pk2(v[2 * j][2], v[2 * j][3]); o.z = pk2(v[2 * j + 1][0], v[2 * j + 1][1]); o.w = pk2(v[2 * j + 1][2], v[2 * j + 1][3]); *(v4u*)(xw + 512 * j) = o; } }
            if (MODE == 3) { float* ow = F.out + (size_t)row * DM + 8 * lane;
#pragma unroll
                for (int j = 0; j < 4; ++j) { *(f32x4*)(ow + 512 * j) = v[2 * j] * rstd * g[2 * j]; *(f32x4*)(ow + 512 * j + 4) = v[2 * j + 1] * rstd * g[2 * j + 1]; } }
            else { bf16* hw = HN + (size_t)row * DM + 8 * lane;
#pragma unroll
                for (int j = 0; j < 4; ++j) { const f32x4 a = v[2 * j] * rstd * g[2 * j], b = v[2 * j + 1] * rstd * g[2 * j + 1];
                    v4u o; o.x = pk2(a[0], a[1]); o.y = pk2(a[2], a[3]); o.z = pk2(b[0], b[1]); o.w = pk2(b[2], b[3]); *(v4u*)(hw + 512 * j) = o; } }
        }
        if (MODE == 1 || MODE == 2) {
            VM_WAIT(); __syncthreads();
            if (MODE == 1) small_gemm<2>(F, HN + (size_t)row0 * DM, WSP(bf16, WS_WR) + (size_t)layer * 64 * 2048, lg);
            else small_gemm<1>(F, HN + (size_t)row0 * DM, WSP(bf16, WS_WF), lg);
            if (MODE == 1) {
                int e0 = 0, e1 = 0, rk0 = 0, rk1 = 0; float w0 = 0.f, w1 = 0.f;
                if (tid < 64) {
                    const LAS float* l = lg + tid * 65; const float* gb = F.rg_b + layer * 4; const float* eb = F.re_b + layer * 32;
                    float gl[4]; for (int j = 0; j < 4; ++j) gl[j] = l[j] + gb[j];
                    int gs = 0; float gm = gl[0]; for (int j = 1; j < 4; ++j) if (gl[j] > gm) { gm = gl[j]; gs = j; }
                    float den = 0.f; for (int j = 0; j < 4; ++j) den += __expf(gl[j] - gm);
                    const float pg = 1.0f / den;
                    float el[8]; for (int j = 0; j < 8; ++j) el[j] = l[4 + gs * 8 + j] + eb[gs * 8 + j];
                    int i1 = 0; float v1 = el[0]; for (int j = 1; j < 8; ++j) if (el[j] > v1) { v1 = el[j]; i1 = j; }
                    int i2 = -1; float v2 = -3.0e38f; for (int j = 0; j < 8; ++j) if (j != i1 && el[j] > v2) { v2 = el[j]; i2 = j; }
                    const float s = 1.0f / (1.0f + __expf(v2 - v1));
                    w0 = pg * s; w1 = pg * (1.0f - s); e0 = gs * 8 + i1; e1 = gs * 8 + i2;
                    rk0 = __hip_atomic_fetch_add(hist + e0, 1, __ATOMIC_RELAXED, __HIP_MEMORY_SCOPE_WORKGROUP);
                    rk1 = __hip_atomic_fetch_add(hist + e1, 1, __ATOMIC_RELAXED, __HIP_MEMORY_SCOPE_WORKGROUP);
                    LDS_WAIT(); asm volatile("" ::: "memory");
                    if (tid < 32) { const int c = hist[tid]; hist[32 + tid] = c ? (int)__hip_atomic_fetch_add(F.ctl + CW_CNT + 32 * layer + tid, (unsigned)c, RLX_AGENT) : 0; }
                    LDS_WAIT(); asm volatile("" ::: "memory");
                    const int p0 = hist[32 + e0] + rk0, p1 = hist[32 + e1] + rk1, row = row0 + tid;
                    WSP(int, WS_SLOT)[e0 * CAP + p0] = row; WSP(int, WS_SLOT)[e1 * CAP + p1] = row;
                    WSP(unsigned, WS_TOKE)[row] = (unsigned)e0 | ((unsigned)e1 << 8);
                    WSP(int, WS_TOKP0)[row] = p0; WSP(int, WS_TOKP1)[row] = p1; WSP(float, WS_TOKW0)[row] = w0; WSP(float, WS_TOKW1)[row] = w1;
                }
            } else {
                if (tid < 16) {
                    const float bfh = F.attn_b_f[tid]; float run = 0.f; float* lc = WSP(float, WS_LC) + (size_t)row0 * 16 + tid;
                    for (int r = 0; r < 64; ++r) { const float xv = lg[r * 33 + tid] + bfh; const float ls = fminf(xv, 0.f) - log1pf(__expf(-fabsf(xv))); run += ls; lc[r * 16] = run; }
                    WSP(float, WS_CT)[chunk * 16 + tid] = run;
                }
            }
            __syncthreads();
        }
    }
}
__device__ __forceinline__ void c_finalize(Frame& F) {
    LAS float* part = (LAS float*)(F.lds + RING_OFF);
    const int tid = F.tid;
    for (int chunk = F.vcu; chunk < SEQ / 64; chunk += F.G) {
        __syncthreads();
        { const int h = tid & 15, p = tid >> 4; float s = 0.f; const float* ct = WSP(float, WS_CT);
            for (int c = p * 8; c < p * 8 + 8; ++c) if (c < chunk) s += ct[c * 16 + h];
            part[p * 16 + h] = s; }
        __syncthreads();
        if (tid < 16) { float s = 0.f; for (int p = 0; p < 32; ++p) s += part[p * 16 + tid]; part[512 + tid] = s; }
        __syncthreads();
        for (int i = tid; i < 64 * 16; i += 512) { const int r = i >> 4, h = i & 15, row = chunk * 64 + r;
            const float cv = WSP(float, WS_LC)[(size_t)row * 16 + h] + part[512 + h];
            WSP(float, WS_KX)[(size_t)h * SEQ + row] = -cv * 11.313708498984761f; }
    }
    __syncthreads();
}
__device__ __forceinline__ void conv_phase(Frame& F) {
    const int tid = F.tid, c8 = (tid & 255) * 8, half = tid >> 8;
    float w[3][8];
#pragma unroll
    for (int k = 0; k < 3; ++k)
#pragma unroll
        for (int j = 0; j < 8; ++j) w[k][j] = F.conv_w[k * DM + c8 + j];
    const bf16* Z = WSP(bf16, WS_Z); const bf16* GO = WSP(bf16, WS_GO); bf16* A = WSP(bf16, WS_HN);
    for (int chunk = F.vcu; chunk < SEQ / 64; chunk += F.G) {
        const int t0 = chunk * 64 + half * 32;
        v4u zm2 = (v4u){0u, 0u, 0u, 0u}, zm1 = zm2;
        if (t0 >= 2) { zm2 = *(const v4u*)(Z + (size_t)(t0 - 2) * DM + c8); zm1 = *(const v4u*)(Z + (size_t)(t0 - 1) * DM + c8); }
#pragma unroll 4
        for (int t = t0; t < t0 + 32; ++t) {
            const v4u z0 = *(const v4u*)(Z + (size_t)t * DM + c8), go = *(const v4u*)(GO + (size_t)t * DM + c8);
            v4u o;
#define CV(q, j) (w[0][j] * (((j) & 1) ? bf_hi(zm2.q) : bf_lo(zm2.q)) + w[1][j] * (((j) & 1) ? bf_hi(zm1.q) : bf_lo(zm1.q)) + w[2][j] * (((j) & 1) ? bf_hi(z0.q) : bf_lo(z0.q)))
            o.x = pk2(bf_lo(go.x) * CV(x, 0), bf_hi(go.x) * CV(x, 1)); o.y = pk2(bf_lo(go.y) * CV(y, 2), bf_hi(go.y) * CV(y, 3));
            o.z = pk2(bf_lo(go.z) * CV(z, 4), bf_hi(go.z) * CV(z, 5)); o.w = pk2(bf_lo(go.w) * CV(w, 6), bf_hi(go.w) * CV(w, 7));
#undef CV
            *(v4u*)(A + (size_t)t * DM + c8) = o;
            zm2 = zm1; zm1 = z0;
        }
    }
}
__device__ __forceinline__ void gather_phase(Frame& F, int layer) {
    const int ntile = build_tiles(F, layer);
    const LAS int* tile_e = (const LAS int*)(F.lds + TILE_OFF); const LAS int* tst = (const LAS int*)(F.lds + TST_OFF);
    const int gw = F.vcu * NWAVES + F.wave, NGW = F.G * NWAVES, lane = F.lane;
    const bf16* HN = WSP(bf16, WS_HN); bf16* XS = WSP(bf16, WS_XS);
    for (int r = gw; r < ntile * 256; r += NGW) {
        const int t = r >> 8, e = tile_e[t], pos = r - tst[e] * 256;
        if (pos < tst[32 + e]) { const int tok = WSP(int, WS_SLOT)[e * CAP + pos];
            const v4u* s = (const v4u*)(HN + (size_t)tok * DM) + lane; v4u* d = (v4u*)(XS + (size_t)r * DM) + lane;
            const v4u a = s[0], b = s[64], c = s[128], dd = s[192]; d[0] = a; d[64] = b; d[128] = c; d[192] = dd; }
    }
}


__device__ __forceinline__ void attn_phase(Frame& F, unsigned char* lds) {
    const unsigned lds32 = (unsigned)(size_t)F.lds;
    LAS float* qk = (LAS float*)(F.lds + RING_OFF + fox::QN2_OFF);
    LAS float* kn2 = (LAS float*)(F.lds + RING_OFF + fox::KN2_OFF);
    LAS int* nxt_id = (LAS int*)(F.lds + RING_OFF + fox::NXT_OFF);
    const int tid = F.tid;
    const float* NBp = WSP(float, WS_NB);
    for (int i = tid; i < 1024; i += 512) { const float* p = NBp + (size_t)(1024 + i) * 8;
        kn2[i] = (fmaxf(p[0], p[4]) + fmaxf(p[1], p[5])) + (fmaxf(p[2], p[6]) + fmaxf(p[3], p[7])); }
    __syncthreads();
    if (tid < 16) { float m = 0.f; for (int kb = 0; kb < 64; ++kb) { m = fmaxf(m, kn2[tid * 64 + kb]); kn2[tid * 64 + kb] = m; } }
    __syncthreads();
    for (int i = tid; i < 1024; i += 512) { const float* p = NBp + (size_t)i * 8;
        const float q2 = (fmaxf(p[0], p[4]) + fmaxf(p[1], p[5])) + (fmaxf(p[2], p[6]) + fmaxf(p[3], p[7]));
        qk[i] = 1.02f * sqrtf(q2 * kn2[i]); }
    __syncthreads();
    const fox::Bases BS{WSP(fox::bf16, WS_Q), WSP(fox::bf16, WS_K), WSP(fox::bf16, WS_V), WSP(float, WS_KX), WSP(fox::bf16, WS_HN)};
    const int total = 1024;
    int id = blockIdx.x;
    if (id < total) {
        fox::BlockRef cur, nxt; cur.h = id & 15; cur.qb = 63 - (id >> 4);
        fox::Seam S;
        fox::fox_prime(BS, cur, (char*)lds + RING_OFF, lds32 + RING_OFF, S);
        for (;;) {
            if (tid == 0) *nxt_id = (int)F.G + (int)__hip_atomic_fetch_add(F.ctl + CW_ATT, 1u, RLX_AGENT);
            fox::fox_block(BS, cur, (char*)lds + RING_OFF, lds32 + RING_OFF, S, nxt);
            if (nxt.h < 0) break;
            cur = nxt;
        }
    }
}
#define IN(k) (lo <= (k) && (k) < hi)
#ifndef EN_MASK
#define EN_MASK 0xFFFF
#endif
#define EN(b) (((EN_MASK) >> (b)) & 1)
#ifndef DBL_MASK
#define DBL_MASK 0
#endif
#define REPS(b) ((((DBL_MASK) >> (b)) & 1) ? 2 : 1)
#define SEAM(k) do { if (MK_N_LAUNCHES == 1 && IN(k) && IN((k) + 1)) xcd_barrier(bar); } while (0)
template <int layer>
__device__ __forceinline__ void layer_phases(Frame& F, const XcdBarrier& bar, unsigned char* lds, const int lo, const int hi) {
    const unsigned lds32 = (unsigned)(size_t)F.lds;
        const int pb = 1 + 8 * layer;
        if (IN(pb + 0) && EN(1)) {
            if constexpr (layer == 0) {
                pg8::Gemm g{WSP(bf16, WS_HN), WSP(bf16, WS_WCIN), SEQ, 3 * DM, DM}; pg8::StaticOrder S; S.init(SEQ, 3 * DM, F.G, (int)blockIdx.x);
                pg8::EpiConvIn E{WSP(bf16, WS_Z), WSP(bf16, WS_GO)};
                for (int rep = 0; rep < REPS(1); ++rep) pg8::gemm_phase<pg8::EpiConvIn, pg8::StaticOrder, true, true>(F.lds + RING_OFF, g, S, E);
            } else {
                c_finalize(F);
                pg8::Gemm g{WSP(bf16, WS_HN), WSP(bf16, WS_WAIN), SEQ, 3 * DM, DM}; pg8::StaticOrder S; S.init(SEQ, 3 * DM, F.G, (int)blockIdx.x);
                pg8::EpiQKV E{WSP(bf16, WS_Q), (size_t)(WS_K - WS_Q) / 2, WSP(float, WS_NB)};
                pg8::gemm_phase<pg8::EpiQKV, pg8::StaticOrder, true, true>(F.lds + RING_OFF, g, S, E);
            }
        }
        SEAM(pb + 0);
        if (IN(pb + 1)) {
            if constexpr (layer == 0) { if (EN(2)) for (int rep = 0; rep < REPS(2); ++rep) conv_phase(F); }
            else if (EN(3)) attn_phase(F, lds);
        }
        SEAM(pb + 1);
        if (IN(pb + 2) && EN(4)) {
            pg8::Gemm g{WSP(bf16, WS_HN), layer == 0 ? WSP(bf16, WS_WCOUT) : WSP(bf16, WS_WAOUT), SEQ, DM, DM}; pg8::StaticOrder S; S.init(SEQ, DM, F.G, (int)blockIdx.x);
            pg8::EpiDown E{WSP(bf16, WS_Y)};
            for (int rep = 0; rep < ((layer == 0) ? REPS(4) : 1); ++rep) pg8::gemm_phase<pg8::EpiDown, pg8::StaticOrder, true, true>(F.lds + RING_OFF, g, S, E);
        }
        SEAM(pb + 2);
        if (IN(pb + 3) && EN(5)) row_phase<1>(F, layer);
        SEAM(pb + 3);
        if (IN(pb + 5) && EN(7)) {
            const int ntile = build_tiles(F, layer);
            const LAS int* tile_e = (const LAS int*)(F.lds + TILE_OFF); const LAS int* tst = (const LAS int*)(F.lds + TST_OFF); LAS unsigned* rtok = (LAS unsigned*)(F.lds + RTOK_OFF);
            for (int idx = F.tid; idx < 4 * 256; idx += 512) { const int L = (idx >> 8) * F.G + F.vcu, r = idx & 255; unsigned off = 0u;
                if (L < ntile * 4) { const int t = L >> 2, e = tile_e[t], pos = (t - tst[e]) * 256 + r; if (pos < tst[32 + e]) off = (unsigned)WSP(int, WS_SLOT)[e * CAP + pos] * (unsigned)(DM * 2); }
                rtok[idx] = off; }
            __syncthreads();
            pg8::Gemm g{WSP(bf16, WS_HN), WSP(bf16, WS_WGU) + (size_t)layer * 32 * 1024 * 2048, MAXT * 256, 32 * 1024, DM};
            pg8::ExpertOrder S{tile_e, ntile * 4, 4, F.G, F.vcu};
            pg8::EpiGateUp E{WSP(bf16, WS_H)};
            for (int rep = 0; rep < REPS(7); ++rep) pg8::gemm_phase_gather<pg8::EpiGateUp, pg8::ExpertOrder>(F.lds + RING_OFF, g, S, E, rtok);
        }
        SEAM(pb + 5);
        if (IN(pb + 6) && EN(8)) {
            const int ntile = build_tiles(F, layer);
            pg8::Gemm g{WSP(bf16, WS_H), WSP(bf16, WS_WD) + (size_t)layer * 32 * 2048 * 512, MAXT * 256, 32 * 2048, DEXP};
            pg8::ExpertOrder S{(const LAS int*)(F.lds + TILE_OFF), ntile * 8, 8, F.G, F.vcu};
            pg8::EpiDown E{WSP(bf16, WS_XS)};
            for (int rep = 0; rep < REPS(8); ++rep) pg8::gemm_phase<pg8::EpiDown, pg8::ExpertOrder, true, true>(F.lds + RING_OFF, g, S, E);
        }
        SEAM(pb + 6);
        if (IN(pb + 7) && EN(9)) { if (layer == 0) row_phase<2>(F, 0); else row_phase<3>(F, 1); }
        if (layer == 0) SEAM(pb + 7);
}

struct Args { const float* in[17]; float* out; unsigned char* ws; int ph_lo, ph_hi; };
__global__ void __launch_bounds__(NWAVES * 64, 2) trunk_fwd(Args args) {
    extern __shared__ __attribute__((aligned(16))) unsigned char lds[];
    Frame F;
    F.lds = (LAS unsigned char*)lds;
    F.MISC = (volatile LAS unsigned*)(F.lds + MISC_OFF);
    F.tid = threadIdx.x; F.lane = F.tid & 63; F.wave = __builtin_amdgcn_readfirstlane(F.tid >> 6);
    F.G = gridDim.x; { const int bx = blockIdx.x; F.vcu = (F.G % 8 == 0) ? (bx % 8) * (F.G / 8) + bx / 8 : bx; }
    F.ws = args.ws; F.out = args.out; F.ctl = (gu32*)(args.ws + WS_CTL);
    F.x = args.in[0]; F.mix_norm = args.in[1]; F.ffn_norm = args.in[2]; F.final_norm = args.in[3]; F.conv_w_in = args.in[4]; F.conv_w = args.in[5]; F.conv_w_out = args.in[6];
    F.attn_w_in = args.in[7]; F.attn_b_f = args.in[8]; F.attn_w_out = args.in[9]; F.rg_w = args.in[10]; F.rg_b = args.in[11]; F.re_w = args.in[12]; F.re_b = args.in[13];
    F.w_gate = args.in[14]; F.w_up = args.in[15]; F.w_down = args.in[16];
    if (F.tid < 32) F.MISC[F.tid] = 0u;
    __syncthreads();
    XcdBarrier bar; bar.bar = (unsigned*)(F.ctl + CW_BAR); bar.x = 0; bar.st = nullptr;
    if (MK_N_LAUNCHES == 1) bar = xcd_barrier_post((unsigned*)(F.ctl + CW_BAR), F.MISC + 8);
    const int lo = args.ph_lo, hi = args.ph_hi;

    if (IN(0) && EN(0)) { for (int rep = 0; rep < REPS(0); ++rep) p0_prologue(F); for (int rep = 0; rep < REPS(9); ++rep) row_phase<0>(F, 0); }
    SEAM(0);
    layer_phases<0>(F, bar, lds, lo, hi);
    layer_phases<1>(F, bar, lds, lo, hi);
}
#undef IN
#undef SEAM

extern "C" void kernel_launch(void* const* d_in, const int* in_sizes, int n_in, void* d_out, int out_size, void* d_ws, size_t ws_size, hipStream_t stream) {
    static int grid = 0;
    if (grid == 0) {
        if (n_in != 17 || in_sizes[0] != SEQ * DM || out_size != SEQ * DM || ws_size < WS_END) { fprintf(stderr, "kernel_launch: unexpected shapes (n_in %d, in0 %d, out %d, ws %zu < %zu); nothing launched\n", n_in, n_in > 0 ? in_sizes[0] : -1, out_size, ws_size, (size_t)WS_END); grid = -1; return; }
        int dev = 0, cus = 0, per_cu = 0;
        if (hipGetDevice(&dev) != hipSuccess || hipDeviceGetAttribute(&cus, hipDeviceAttributeMultiprocessorCount, dev) != hipSuccess) { fprintf(stderr, "kernel_launch: device query failed\n"); grid = -1; return; }
        if (hipFuncSetAttribute((const void*)trunk_fwd, hipFuncAttributeMaxDynamicSharedMemorySize, LDS_BYTES) != hipSuccess) { fprintf(stderr, "kernel_launch: hipFuncSetAttribute failed\n"); grid = -1; return; }
        if (hipOccupancyMaxActiveBlocksPerMultiprocessor(&per_cu, (const void*)trunk_fwd, NWAVES * 64, LDS_BYTES) != hipSuccess || per_cu < 1) { fprintf(stderr, "kernel_launch: occupancy query reports %d workgroups per CU\n", per_cu); (void)hipGetLastError(); grid = -1; return; }
        grid = cus;
    }
    if (grid < 0) return;
    if (hipMemsetAsync((char*)d_ws + WS_CTL, 0, CTL_ZERO_BYTES, stream) != hipSuccess) { fprintf(stderr, "kernel_launch: hipMemsetAsync failed\n"); return; }
    Args a{};
    for (int i = 0; i < 17; ++i) a.in[i] = (const float*)d_in[i];
    a.out = (float*)d_out; a.ws = (unsigned char*)d_ws;
#if MK_N_LAUNCHES == 1
    a.ph_lo = 0; a.ph_hi = N_PHASES;
    hipLaunchKernelGGL(trunk_fwd, dim3(grid), dim3(NWAVES * 64), LDS_BYTES, stream, a);
#ifdef PROBE_PHASE
    (void)hipMemsetAsync((char*)d_ws + WS_CTL + CW_ATT * 4, 0, 4, stream);
    a.ph_lo = PROBE_PHASE; a.ph_hi = PROBE_PHASE + 1;
    hipLaunchKernelGGL(trunk_fwd, dim3(grid), dim3(NWAVES * 64), LDS_BYTES, stream, a);
#endif
#else
    for (int p = 0; p < N_PHASES; ++p) { a.ph_lo = p; a.ph_hi = p + 1; hipLaunchKernelGGL(trunk_fwd, dim3(grid), dim3(NWAVES * 64), LDS_BYTES, stream, a); }
#endif
    const hipError_t le = hipPeekAtLastError();
    if (le != hipSuccess) fprintf(stderr, "kernel_launch: launch failed: %s\n", hipGetErrorName(le));
}
```

```cpp
#include <hip/hip_runtime.h>
#include <cstdio>
#include <cstdint>

constexpr int SEQ = 16384, DM = 2048, NH = 16, HD = 128, NEXP = 32, NGRP = 4, EPG = 8, DEXP = 512;
constexpr float RMS_EPS = 1e-6f;
constexpr int CAP = SEQ;
constexpr int MAXT = 160;

namespace pg8 {
#define PG8_LAS __attribute__((address_space(3)))
typedef unsigned short bf16_t;
typedef short bf16x8 __attribute__((ext_vector_type(8)));
typedef float f32x4 __attribute__((ext_vector_type(4)));
typedef unsigned u32x4 __attribute__((ext_vector_type(4)));
constexpr int BM = 256, BK = 64, HALF = 128, HTB = HALF * BK * 2  , STAGE_BYTES = 8 * HTB, NXCD = 8, WGM = 8;

__host__ __device__ __forceinline__ int lds_byte(int r, int c) { const int st = (r >> 4) * 2 + (c >> 5), rr = r & 15, cc = c & 31, ob = rr * 64 + cc * 2; return st * 1024 + (ob ^ (((ob >> 9) & 1) << 5)); }
__host__ __device__ __forceinline__ void stage_rc(int b, int& R, int& C) { const int st = b / 1024, sb = b % 1024, swz = sb ^ (((sb >> 9) & 1) << 5); R = (st >> 1) * 16 + swz / 64; C = (st & 1) * 32 + (swz % 64) / 2; }
__host__ __device__ __forceinline__ int perm32(int rho) { const int n = rho >> 4, i = rho & 15; return 8 * (i >> 2) + 4 * n + (i & 3); }

struct Unit { int pm, pn; };
struct Gemm { const bf16_t* A; const bf16_t* Bt; int M, N, K; };

struct StaticOrder {
    int nM, nN, nwg, G, c;
    __host__ __device__ void init(int M, int N, int G_, int c_) { nM = M / BM; nN = N / BM; nwg = nM * nN; G = G_; c = c_; }
    __host__ __device__ bool next(int i, Unit& u) const {
        const long L = (long)i * G + c; if (L >= nwg) return false;
        int wgid = (int)L; { const int q = nwg / NXCD, r = nwg % NXCD, xcd = wgid % NXCD, off = wgid / NXCD; wgid = (xcd < r ? xcd * (q + 1) : r * (q + 1) + (xcd - r) * q) + off; }
        const int nig = WGM * nN, gid = wgid / nig, fm = gid * WGM, gsz = (nM - fm) < WGM ? (nM - fm) : WGM;
        u.pm = fm + ((wgid % nig) % gsz); u.pn = (wgid % nig) / gsz; return true;
    }
    __device__ __forceinline__ void a_ready(const Unit&) const {}
    __device__ __forceinline__ void done(const Unit&) const {}
};
__device__ __forceinline__ unsigned cvt_pk_bf16(float lo, float hi) { unsigned r; asm volatile("v_cvt_pk_bf16_f32 %0, %1, %2" : "=v"(r) : "v"(lo), "v"(hi)); return r; }
__device__ __forceinline__ u32x4 pack8(f32x4 v0, f32x4 v1) { u32x4 w; w.x = cvt_pk_bf16(v0[0], v0[1]); w.y = cvt_pk_bf16(v0[2], v0[3]); w.z = cvt_pk_bf16(v1[0], v1[1]); w.w = cvt_pk_bf16(v1[2], v1[3]); return w; }
__device__ __forceinline__ float silu_f(float g) { return g * __builtin_amdgcn_rcpf(1.0f + __builtin_amdgcn_exp2f(g * -1.4426950408889634f)); }

struct EpiConvIn {
    static constexpr bool PERM = true, AFTER_DRAIN = false;
    bf16_t* Z; bf16_t* GO;
    __device__ __forceinline__ void operator()(const f32x4 (&acc)[2][2][4][2], const Unit& u, int wr, int wc, int fr, int fq) const {
        const int row0 = u.pm * BM + wr * 64 + fr;
        if (u.pn < 16) {
            const int col0 = u.pn * 128 + wc * 32 + 8 * fq;
#pragma unroll
            for (int ai = 0; ai < 2; ++ai)
#pragma unroll
                for (int m = 0; m < 4; ++m) { bf16_t* rowp = Z + (size_t)(row0 + ai * HALF + m * 16) * 2048 + col0;
                    *(u32x4*)rowp = pack8(acc[ai][0][m][0] * acc[ai][1][m][0], acc[ai][0][m][1] * acc[ai][1][m][1]); }
        } else {
            const int col0 = (u.pn - 16) * 256 + wc * 32 + 8 * fq;
#pragma unroll
            for (int ai = 0; ai < 2; ++ai)
#pragma unroll
                for (int m = 0; m < 4; ++m) { bf16_t* rowp = GO + (size_t)(row0 + ai * HALF + m * 16) * 2048 + col0;
#pragma unroll
                    for (int bj = 0; bj < 2; ++bj) *(u32x4*)(rowp + bj * HALF) = pack8(acc[ai][bj][m][0], acc[ai][bj][m][1]); }
        }
    }
};
struct EpiResF32 {
    static constexpr bool PERM = false, AFTER_DRAIN = false;
    const float* R; float* C;
    __device__ __forceinline__ void operator()(const f32x4 (&acc)[2][2][4][2], const Unit& u, int wr, int wc, int fr, int fq) const {
        const int row0 = u.pm * BM + wr * 64 + fr, col0 = u.pn * BM + wc * 32 + 4 * fq;
#pragma unroll
        for (int ai = 0; ai < 2; ++ai)
#pragma unroll
            for (int m = 0; m < 4; ++m) { const size_t ro = (size_t)(row0 + ai * HALF + m * 16) * 2048 + col0;
#pragma unroll
                for (int bj = 0; bj < 2; ++bj)
#pragma unroll
                    for (int n = 0; n < 2; ++n) { const size_t o = ro + bj * HALF + n * 16; *(f32x4*)(C + o) = *(const f32x4*)(R + o) + acc[ai][bj][m][n]; } }
    }
};
struct EpiGateUp {
    static constexpr bool PERM = true, AFTER_DRAIN = false;
    bf16_t* H;
    __device__ __forceinline__ void operator()(const f32x4 (&acc)[2][2][4][2], const Unit& u, int wr, int wc, int fr, int fq) const {
        const int row0 = u.pm * BM + wr * 64 + fr, col0 = (u.pn & 3) * 128 + wc * 32 + 8 * fq;
#pragma unroll
        for (int ai = 0; ai < 2; ++ai)
#pragma unroll
            for (int m = 0; m < 4; ++m) { bf16_t* rowp = H + (size_t)(row0 + ai * HALF + m * 16) * 512 + col0;
                f32x4 v0, v1;
#pragma unroll
                for (int j = 0; j < 4; ++j) { v0[j] = silu_f(acc[ai][0][m][0][j]) * acc[ai][1][m][0][j]; v1[j] = silu_f(acc[ai][0][m][1][j]) * acc[ai][1][m][1][j]; }
                *(u32x4*)rowp = pack8(v0, v1); }
    }
};
struct EpiDown {
    static constexpr bool PERM = true, AFTER_DRAIN = false;
    bf16_t* O;
    __device__ __forceinline__ void operator()(const f32x4 (&acc)[2][2][4][2], const Unit& u, int wr, int wc, int fr, int fq) const {
        const int row0 = u.pm * BM + wr * 64 + fr, col0 = (u.pn & 7) * 256 + wc * 32 + 8 * fq;
#pragma unroll
        for (int ai = 0; ai < 2; ++ai)
#pragma unroll
            for (int m = 0; m < 4; ++m) { bf16_t* rowp = O + (size_t)(row0 + ai * HALF + m * 16) * 2048 + col0;
#pragma unroll
                for (int bj = 0; bj < 2; ++bj) *(u32x4*)(rowp + bj * HALF) = pack8(acc[ai][bj][m][0], acc[ai][bj][m][1]); }
    }
};
struct EpiQKV {
    static constexpr bool PERM = true, AFTER_DRAIN = false;
    bf16_t* Q; size_t tstride; float* NB; PG8_LAS float* nrm;
    __device__ __forceinline__ void operator()(const f32x4 (&acc)[2][2][4][2], const Unit& u, int wr, int wc, int fr, int fq) const {
        const int which = u.pn >> 3, hp = u.pn & 7; bf16_t* base = Q + (size_t)which * tstride;
        const int row0 = u.pm * BM + wr * 64 + fr, col0 = wc * 32 + 8 * fq;
#pragma unroll
        for (int bj = 0; bj < 2; ++bj) { bf16_t* hb = base + (size_t)(2 * hp + bj) * SEQ * 128 + col0;
#pragma unroll
            for (int ai = 0; ai < 2; ++ai)
#pragma unroll
                for (int m = 0; m < 4; ++m) { const f32x4 a = acc[ai][bj][m][0], b = acc[ai][bj][m][1];
                    *(u32x4*)(hb + (size_t)(row0 + ai * HALF + m * 16) * 128) = pack8(a, b);
                    if (which < 2) { float p = (a[0] * a[0] + a[1] * a[1]) + (a[2] * a[2] + a[3] * a[3]) + (b[0] * b[0] + b[1] * b[1]) + (b[2] * b[2] + b[3] * b[3]);
                        p += __shfl_xor(p, 16); p += __shfl_xor(p, 32);
                        if (fq == 0) nrm[((wr * 4 + wc) * 2 + bj) * 128 + (ai * 4 + m) * 16 + fr] = p; } }
        }
        if (which < 2) {
            asm volatile("s_waitcnt lgkmcnt(0)" ::: "memory"); __builtin_amdgcn_s_barrier(); asm volatile("" ::: "memory");
            const int bj = wc & 1, ai = wc >> 1, lane = fq * 16 + fr;
            const PG8_LAS float* q = nrm + (wr * 4 * 2 + bj) * 128 + ai * 64 + lane;
            float p = (q[0] + q[256]) + (q[512] + q[768]);
#pragma unroll
            for (int o = 1; o < 64; o <<= 1) p = fmaxf(p, __shfl_xor(p, o));
            if (lane == 0) { float* d = NB + ((which * 16 + 2 * hp + bj) * 64 + u.pm) * 8 + wr * 4 + ai * 2; d[0] = p; d[1] = 0.f; }
        }
    }
};
struct ExpertOrder {
    const PG8_LAS int* tile_e; int n_units, nN, G, c;
    __device__ __forceinline__ bool next(int i, Unit& u) const {
        const int L = i * G + c; if (L >= n_units) return false;
        const int t = L / nN, j = L - t * nN; u.pm = t; u.pn = tile_e[t] * nN + j; return true;
    }
    __device__ __forceinline__ void a_ready(const Unit&) const {}
    __device__ __forceinline__ void done(const Unit&) const {}
};

template <class Epi, class Sched, bool ALIGN_EPI = false, bool SP2 = false>
__device__ __forceinline__ void gemm_phase(PG8_LAS unsigned char* lds, const Gemm g, const Sched& S, const Epi& E) {
    const int tid = threadIdx.x, wid = __builtin_amdgcn_readfirstlane(tid >> 6), lane = tid & 63, wr = wid >> 2, wc = wid & 3, fr = lane & 15, fq = lane >> 4;
    const int K = g.K, nt = K / BK;
    unsigned voffA[2], voffB[2];
#pragma unroll
    for (int i = 0; i < 2; ++i) { int R, C; stage_rc(tid * 16 + i * 8192, R, C); const int Rb = Epi::PERM ? ((R & ~31) + perm32(R & 31)) : R;
        voffA[i] = (unsigned)(R * K + C) * 2u; voffB[i] = (unsigned)(Rb * K + C) * 2u; }
    const size_t kstep = (size_t)(BK * 2);
    const size_t hstep = (size_t)HALF * K * 2;
    const size_t tstep = 2 * hstep;
    const unsigned ldsw = (unsigned)wid * 1024u;
    const int aoff = lds_byte(wr * 64 + fr, fq * 8), boff = lds_byte(wc * 32 + fr, fq * 8);
#define PG8_SA(b, h) (((b) * 2 + (h)) * HTB)
#define PG8_SB(b, h) ((4 + (b) * 2 + (h)) * HTB)
#define PG8_STAGE(bufoff, gbase, voff) do { _Pragma("unroll") for (int _i = 0; _i < 2; ++_i) \
        __builtin_amdgcn_global_load_lds((const unsigned*)((const char*)(gbase) + (voff)[_i]), (PG8_LAS unsigned*)(lds + (bufoff) + ldsw + _i * 8192), 16, 0, 0); } while (0)
#define PG8_LDA(dst, b, h) do { _Pragma("unroll") for (int m = 0; m < 4; ++m) _Pragma("unroll") for (int k = 0; k < 2; ++k) dst[m][k] = *(const PG8_LAS bf16x8*)(lds + PG8_SA(b, h) + aoff + m * 2048 + k * 1024); } while (0)
#define PG8_LDB(dst, b, h) do { _Pragma("unroll") for (int n = 0; n < 2; ++n) _Pragma("unroll") for (int k = 0; k < 2; ++k) dst[n][k] = *(const PG8_LAS bf16x8*)(lds + PG8_SB(b, h) + boff + n * 2048 + k * 1024); } while (0)
#define PG8_MMA(ai, bj, At, Bt) do { __builtin_amdgcn_s_setprio(1); _Pragma("unroll") for (int m = 0; m < 4; ++m) _Pragma("unroll") for (int n = 0; n < 2; ++n) _Pragma("unroll") for (int k = 0; k < 2; ++k) \
        acc[ai][bj][m][n] = __builtin_amdgcn_mfma_f32_16x16x32_bf16(Bt[n][k], At[m][k], acc[ai][bj][m][n], 0, 0, 0); __builtin_amdgcn_s_setprio(0); } while (0)
#define PG8_WAIT_V(n) asm volatile("s_waitcnt vmcnt(" #n ")" ::: "memory")
#define PG8_WAIT_L(n) asm volatile("s_waitcnt lgkmcnt(" #n ")" ::: "memory")
#define PG8_BAR __builtin_amdgcn_s_barrier()
#define PG8_SCHED __builtin_amdgcn_sched_barrier(0)
    Unit cur, nxt; int ui = 0;
    if (!S.next(0, cur)) return;
    f32x4 acc[2][2][4][2];
#pragma unroll
    for (int a = 0; a < 2; ++a)
#pragma unroll
        for (int b = 0; b < 2; ++b)
#pragma unroll
            for (int m = 0; m < 4; ++m)
#pragma unroll
                for (int n = 0; n < 2; ++n) acc[a][b][m][n] = (f32x4){0.f, 0.f, 0.f, 0.f};
    bf16x8 At[4][2], B0[2][2], B1[2][2];
    const char* cA = (const char*)g.A + (size_t)cur.pm * tstep; const char* cB = (const char*)g.Bt + (size_t)cur.pn * tstep;
    S.a_ready(cur);
    if constexpr (SP2) {
        PG8_STAGE(PG8_SB(0, 0), cB, voffB); PG8_STAGE(PG8_SB(0, 1), cB + hstep, voffB); PG8_STAGE(PG8_SA(0, 0), cA, voffA); PG8_STAGE(PG8_SA(0, 1), cA + hstep, voffA);
        if (wr == 1) PG8_BAR;
        PG8_WAIT_V(2); PG8_BAR;
        PG8_STAGE(PG8_SB(1, 0), cB + kstep, voffB); PG8_STAGE(PG8_SA(1, 0), cA + kstep, voffA); PG8_STAGE(PG8_SB(1, 1), cB + hstep + kstep, voffB);
        PG8_WAIT_V(6); PG8_BAR;
    } else {
        PG8_STAGE(PG8_SB(0, 0), cB, voffB); PG8_STAGE(PG8_SA(0, 0), cA, voffA); PG8_STAGE(PG8_SB(0, 1), cB + hstep, voffB); PG8_STAGE(PG8_SA(0, 1), cA + hstep, voffA);
        if (wr == 1) PG8_BAR;
        PG8_WAIT_V(4); PG8_BAR;
        PG8_STAGE(PG8_SB(1, 0), cB + kstep, voffB); PG8_STAGE(PG8_SA(1, 0), cA + kstep, voffA); PG8_STAGE(PG8_SB(1, 1), cB + hstep + kstep, voffB);
        PG8_WAIT_V(6); PG8_BAR;
    }
    for (;;) {
        const bool has_next = S.next(ui + 1, nxt);
        const char* nA = has_next ? (const char*)g.A + (size_t)nxt.pm * tstep : cA; const char* nB = has_next ? (const char*)g.Bt + (size_t)nxt.pn * tstep : cB;
        for (int t = 0; t < nt; t += 2) {
            const bool last = (t == nt - 2);
            const char* a1 = cA + (size_t)(t + 1) * kstep;
            const char* a2 = last ? nA : cA + (size_t)(t + 2) * kstep; const char* b2 = last ? nB : cB + (size_t)(t + 2) * kstep;
            const char* a3 = a2 + kstep; const char* b3 = b2 + kstep;
            if (last && has_next) S.a_ready(nxt);
            if constexpr (SP2) {
            PG8_LDB(B0, 0, 0); PG8_LDB(B1, 0, 1); PG8_SCHED; PG8_LDA(At, 0, 0); PG8_STAGE(PG8_SA(1, 1), a1 + hstep, voffA);
            PG8_WAIT_V(8); PG8_WAIT_L(0); PG8_BAR; PG8_MMA(0, 0, At, B0); PG8_MMA(0, 1, At, B1); PG8_BAR; PG8_SCHED;
            PG8_LDA(At, 0, 1); PG8_STAGE(PG8_SB(0, 0), b2, voffB); PG8_STAGE(PG8_SB(0, 1), b2 + hstep, voffB); PG8_STAGE(PG8_SA(0, 0), a2, voffA);
            PG8_WAIT_V(8); PG8_WAIT_L(0); PG8_BAR; PG8_MMA(1, 0, At, B0); PG8_MMA(1, 1, At, B1); PG8_BAR; PG8_SCHED;
            PG8_LDB(B0, 1, 0); PG8_LDB(B1, 1, 1); PG8_SCHED; PG8_LDA(At, 1, 0); PG8_STAGE(PG8_SA(0, 1), a2 + hstep, voffA);
            PG8_WAIT_V(8); PG8_WAIT_L(0); PG8_BAR; PG8_MMA(0, 0, At, B0); PG8_MMA(0, 1, At, B1); PG8_BAR; PG8_SCHED;
            PG8_LDA(At, 1, 1); PG8_STAGE(PG8_SB(1, 0), b3, voffB); PG8_STAGE(PG8_SB(1, 1), b3 + hstep, voffB); PG8_STAGE(PG8_SA(1, 0), a3, voffA);
            PG8_WAIT_V(8); PG8_WAIT_L(0); PG8_BAR; PG8_MMA(1, 0, At, B0); PG8_MMA(1, 1, At, B1); PG8_BAR; PG8_SCHED;
            } else {
            PG8_LDB(B0, 0, 0); PG8_SCHED; PG8_LDA(At, 0, 0); PG8_STAGE(PG8_SA(1, 1), a1 + hstep, voffA);
            PG8_WAIT_L(8); PG8_BAR; PG8_WAIT_L(0); PG8_MMA(0, 0, At, B0); PG8_BAR; PG8_SCHED;
            PG8_LDB(B1, 0, 1); PG8_STAGE(PG8_SB(0, 0), b2, voffB);
            PG8_BAR; PG8_WAIT_L(0); PG8_MMA(0, 1, At, B1); PG8_BAR;
            PG8_LDA(At, 0, 1); PG8_STAGE(PG8_SA(0, 0), a2, voffA);
            PG8_BAR; PG8_WAIT_L(0); PG8_MMA(1, 0, At, B0); PG8_BAR; PG8_SCHED;
            PG8_STAGE(PG8_SB(0, 1), b2 + hstep, voffB);
            PG8_WAIT_V(6); PG8_BAR; PG8_MMA(1, 1, At, B1); PG8_BAR;
            PG8_LDB(B0, 1, 0); PG8_SCHED; PG8_LDA(At, 1, 0); PG8_STAGE(PG8_SA(0, 1), a2 + hstep, voffA);
            PG8_WAIT_L(8); PG8_BAR; PG8_WAIT_L(0); PG8_MMA(0, 0, At, B0); PG8_BAR; PG8_SCHED;
            PG8_LDB(B1, 1, 1); PG8_STAGE(PG8_SB(1, 0), b3, voffB);
            PG8_BAR; PG8_WAIT_L(0); PG8_MMA(0, 1, At, B1); PG8_BAR;
            PG8_LDA(At, 1, 1); PG8_STAGE(PG8_SA(1, 0), a3, voffA);
            PG8_BAR; PG8_WAIT_L(0); PG8_MMA(1, 0, At, B0); PG8_BAR; PG8_SCHED;
            PG8_STAGE(PG8_SB(1, 1), b3 + hstep, voffB);
            PG8_WAIT_V(6); PG8_BAR; PG8_MMA(1, 1, At, B1); PG8_BAR;
            }
        }
        if constexpr (ALIGN_EPI) { if (wr == 0) PG8_BAR; }
        if constexpr (!Epi::AFTER_DRAIN) { E(acc, cur, wr, wc, fr, fq); S.done(cur); }
        if (!has_next) break;
#pragma unroll
        for (int a = 0; a < 2; ++a)
#pragma unroll
            for (int b = 0; b < 2; ++b)
#pragma unroll
                for (int m = 0; m < 4; ++m)
#pragma unroll
                    for (int n = 0; n < 2; ++n) acc[a][b][m][n] = (f32x4){0.f, 0.f, 0.f, 0.f};
        cur = nxt; cA = nA; cB = nB; ++ui;
        if constexpr (ALIGN_EPI) { if (wr == 1) PG8_BAR; }
    }
    PG8_WAIT_V(0);
    if constexpr (!ALIGN_EPI) { if (wr == 0) PG8_BAR; }
    PG8_BAR;
    if constexpr (Epi::AFTER_DRAIN) { E.fused(acc, cur, wr, wc, fr, fq, lds, wid, lane); S.done(cur); }
#undef PG8_SA
#undef PG8_SB
#undef PG8_STAGE
#undef PG8_LDA
#undef PG8_LDB
#undef PG8_MMA
#undef PG8_WAIT_V
#undef PG8_WAIT_L
#undef PG8_BAR
#undef PG8_SCHED
}
template <class Epi, class Sched>
__device__ __forceinline__ void gemm_phase_gather(PG8_LAS unsigned char* lds, const Gemm g, const Sched& S, const Epi& E, const PG8_LAS unsigned* rtok) {
    const int tid = threadIdx.x, wid = __builtin_amdgcn_readfirstlane(tid >> 6), lane = tid & 63, wr = wid >> 2, wc = wid & 3, fr = lane & 15, fq = lane >> 4;
    const int K = g.K, nt = K / BK;
    unsigned voffB[2];
#pragma unroll
    for (int i = 0; i < 2; ++i) { int R, C; stage_rc(tid * 16 + i * 8192, R, C); const int Rb = Epi::PERM ? ((R & ~31) + perm32(R & 31)) : R;
        voffB[i] = (unsigned)(Rb * K + C) * 2u; }
    unsigned vA[2][2], vN[2][2];
    const size_t kstep = (size_t)(BK * 2);
    const size_t hstep = (size_t)HALF * K * 2;
    const size_t tstep = 2 * hstep;
    const unsigned ldsw = (unsigned)wid * 1024u;
    const int aoff = lds_byte(wr * 64 + fr, fq * 8), boff = lds_byte(wc * 32 + fr, fq * 8);
#define PG8_SA(b, h) (((b) * 2 + (h)) * HTB)
#define PG8_SB(b, h) ((4 + (b) * 2 + (h)) * HTB)
#define PG8_STAGE(bufoff, gbase, voff) do { _Pragma("unroll") for (int _i = 0; _i < 2; ++_i) \
        __builtin_amdgcn_global_load_lds((const unsigned*)((const char*)(gbase) + (voff)[_i]), (PG8_LAS unsigned*)(lds + (bufoff) + ldsw + _i * 8192), 16, 0, 0); } while (0)
#define PG8_STAGE_A(bufoff, kptr, h, usenext) do { _Pragma("unroll") for (int _i = 0; _i < 2; ++_i) \
        __builtin_amdgcn_global_load_lds((const unsigned*)((const char*)(kptr) + ((usenext) ? vN[h][_i] : vA[h][_i])), (PG8_LAS unsigned*)(lds + (bufoff) + ldsw + _i * 8192), 16, 0, 0); } while (0)
#define PG8_LDA(dst, b, h) do { _Pragma("unroll") for (int m = 0; m < 4; ++m) _Pragma("unroll") for (int k = 0; k < 2; ++k) dst[m][k] = *(const PG8_LAS bf16x8*)(lds + PG8_SA(b, h) + aoff + m * 2048 + k * 1024); } while (0)
#define PG8_LDB(dst, b, h) do { _Pragma("unroll") for (int n = 0; n < 2; ++n) _Pragma("unroll") for (int k = 0; k < 2; ++k) dst[n][k] = *(const PG8_LAS bf16x8*)(lds + PG8_SB(b, h) + boff + n * 2048 + k * 1024); } while (0)
#define PG8_MMA(ai, bj, At, Bt) do { __builtin_amdgcn_s_setprio(1); _Pragma("unroll") for (int m = 0; m < 4; ++m) _Pragma("unroll") for (int n = 0; n < 2; ++n) _Pragma("unroll") for (int k = 0; k < 2; ++k) \
        acc[ai][bj][m][n] = __builtin_amdgcn_mfma_f32_16x16x32_bf16(Bt[n][k], At[m][k], acc[ai][bj][m][n], 0, 0, 0); __builtin_amdgcn_s_setprio(0); } while (0)
#define PG8_WAIT_V(n) asm volatile("s_waitcnt vmcnt(" #n ")" ::: "memory")
#define PG8_WAIT_L(n) asm volatile("s_waitcnt lgkmcnt(" #n ")" ::: "memory")
#define PG8_BAR __builtin_amdgcn_s_barrier()
#define PG8_SCHED __builtin_amdgcn_sched_barrier(0)
#define PG8_LOADTOK(dst, ui_) do { int tz_ = threadIdx.x; asm volatile("" : "+v"(tz_)); _Pragma("unroll") for (int i_ = 0; i_ < 2; ++i_) { int R_, C_; stage_rc(tz_ * 16 + i_ * 8192, R_, C_); \
        _Pragma("unroll") for (int h_ = 0; h_ < 2; ++h_) dst[h_][i_] = rtok[(ui_) * 256 + h_ * 128 + R_] + (unsigned)C_ * 2u; } } while (0)
    Unit cur, nxt; int ui = 0;
    if (!S.next(0, cur)) return;
    f32x4 acc[2][2][4][2];
#pragma unroll
    for (int a = 0; a < 2; ++a)
#pragma unroll
        for (int b = 0; b < 2; ++b)
#pragma unroll
            for (int m = 0; m < 4; ++m)
#pragma unroll
                for (int n = 0; n < 2; ++n) acc[a][b][m][n] = (f32x4){0.f, 0.f, 0.f, 0.f};
    bf16x8 At[4][2], B0[2][2], B1[2][2];
    const char* const gA = (const char*)g.A; const char* cB = (const char*)g.Bt + (size_t)cur.pn * tstep;
    PG8_LOADTOK(vA, 0);
#pragma unroll
    for (int h_ = 0; h_ < 2; ++h_)
#pragma unroll
        for (int i_ = 0; i_ < 2; ++i_) vN[h_][i_] = vA[h_][i_];
    PG8_STAGE(PG8_SB(0, 0), cB, voffB); PG8_STAGE(PG8_SB(0, 1), cB + hstep, voffB); PG8_STAGE_A(PG8_SA(0, 0), gA, 0, false); PG8_STAGE_A(PG8_SA(0, 1), gA, 1, false);
    if (wr == 1) PG8_BAR;
    PG8_WAIT_V(2); PG8_BAR;
    PG8_STAGE(PG8_SB(1, 0), cB + kstep, voffB); PG8_STAGE_A(PG8_SA(1, 0), gA + kstep, 0, false); PG8_STAGE(PG8_SB(1, 1), cB + hstep + kstep, voffB);
    PG8_WAIT_V(6); PG8_BAR;
    for (;;) {
        const bool has_next = S.next(ui + 1, nxt);
        const char* nB = has_next ? (const char*)g.Bt + (size_t)nxt.pn * tstep : cB;
        for (int t = 0; t < nt; t += 2) {
            const bool last = (t == nt - 2);
            const char* a1 = gA + (size_t)(t + 1) * kstep;
            const char* a2 = last ? gA : gA + (size_t)(t + 2) * kstep; const char* b2 = last ? nB : cB + (size_t)(t + 2) * kstep;
            const char* a3 = a2 + kstep; const char* b3 = b2 + kstep;
            if (last && has_next) PG8_LOADTOK(vN, ui + 1);
            const bool un = last && has_next;
            PG8_LDB(B0, 0, 0); PG8_LDB(B1, 0, 1); PG8_SCHED; PG8_LDA(At, 0, 0); PG8_STAGE_A(PG8_SA(1, 1), a1, 1, false);
            PG8_WAIT_V(8); PG8_WAIT_L(0); PG8_BAR; PG8_MMA(0, 0, At, B0); PG8_MMA(0, 1, At, B1); PG8_BAR; PG8_SCHED;
            PG8_LDA(At, 0, 1); PG8_STAGE(PG8_SB(0, 0), b2, voffB); PG8_STAGE(PG8_SB(0, 1), b2 + hstep, voffB); PG8_STAGE_A(PG8_SA(0, 0), a2, 0, un);
            PG8_WAIT_V(8); PG8_WAIT_L(0); PG8_BAR; PG8_MMA(1, 0, At, B0); PG8_MMA(1, 1, At, B1); PG8_BAR; PG8_SCHED;
            PG8_LDB(B0, 1, 0); PG8_LDB(B1, 1, 1); PG8_SCHED; PG8_LDA(At, 1, 0); PG8_STAGE_A(PG8_SA(0, 1), a2, 1, un);
            PG8_WAIT_V(8); PG8_WAIT_L(0); PG8_BAR; PG8_MMA(0, 0, At, B0); PG8_MMA(0, 1, At, B1); PG8_BAR; PG8_SCHED;
            PG8_LDA(At, 1, 1); PG8_STAGE(PG8_SB(1, 0), b3, voffB); PG8_STAGE(PG8_SB(1, 1), b3 + hstep, voffB); PG8_STAGE_A(PG8_SA(1, 0), a3, 0, un);
            PG8_WAIT_V(8); PG8_WAIT_L(0); PG8_BAR; PG8_MMA(1, 0, At, B0); PG8_MMA(1, 1, At, B1); PG8_BAR; PG8_SCHED;
        }
        if (wr == 0) PG8_BAR;
        E(acc, cur, wr, wc, fr, fq);
        if (!has_next) break;
#pragma unroll
        for (int a = 0; a < 2; ++a)
#pragma unroll
            for (int b = 0; b < 2; ++b)
#pragma unroll
                for (int m = 0; m < 4; ++m)
#pragma unroll
                    for (int n = 0; n < 2; ++n) acc[a][b][m][n] = (f32x4){0.f, 0.f, 0.f, 0.f};
        cur = nxt; cB = nB; ++ui;
#pragma unroll
        for (int h_ = 0; h_ < 2; ++h_)
#pragma unroll
            for (int i_ = 0; i_ < 2; ++i_) vA[h_][i_] = vN[h_][i_];
        if (wr == 1) PG8_BAR;
    }
    PG8_WAIT_V(0);
    PG8_BAR;
#undef PG8_SA
#undef PG8_SB
#undef PG8_STAGE
#undef PG8_STAGE_A
#undef PG8_LDA
#undef PG8_LDB
#undef PG8_MMA
#undef PG8_WAIT_V
#undef PG8_WAIT_L
#undef PG8_BAR
#undef PG8_SCHED
#undef PG8_LOADTOK
}
}
namespace fox {
#define FOX_LAS __attribute__((address_space(3)))
typedef unsigned short bf16;
typedef short bf16x8 __attribute__((ext_vector_type(8)));
typedef short s16x4 __attribute__((ext_vector_type(4)));
typedef float f32x16 __attribute__((ext_vector_type(16)));
typedef float f32x4 __attribute__((ext_vector_type(4)));
typedef unsigned u32x4 __attribute__((ext_vector_type(4)));
constexpr int D = 128, OPITCH = 2048;
constexpr float SCALE = 0.08838834764831845f;
constexpr float THR = 8.f;
constexpr int NW = 8, QBLK = 32, KVBLK = 64, QB = NW * QBLK;
constexpr int SHM_V = KVBLK * D * 2, SHM_K = KVBLK * D * 2, SHM_X = KVBLK * 4;
constexpr int QN2_OFF = 73728, KN2_OFF = QN2_OFF + 4096, NXT_OFF = KN2_OFF + 4096, WMIN_OFF = NXT_OFF + 16, NPR_OFF = WMIN_OFF + 32;
constexpr float PRUNE_T = 24.0f;
constexpr int LDS_WS_OFF = 2 * SHM_V + 2 * SHM_K, LDS_X_OFF = LDS_WS_OFF + NW * 64 * 4, LDS_BYTES = LDS_X_OFF + 2 * SHM_X;

#define KSWZ(row, colB) ((row) * 256 + ((colB) ^ (((row) & 7) << 4)))
#define SBAR() __builtin_amdgcn_sched_barrier(0)
__device__ __forceinline__ int v_st(int k, int c) { const int kk = (k & ~0xC) | ((k & 4) << 1) | ((k & 8) >> 1); return ((kk >> 3) * 4 + (c >> 5)) * 512 + ((kk & 7) * 32 + (c & 31)) * 2; }
__device__ __forceinline__ int v_rd_base(int lane) { return ((lane & 3) << 3) | (((lane >> 2) & 3) << 6) | (((lane >> 4) & 1) << 5) | (((lane >> 5) & 1) << 8); }
constexpr int v_rd_off(int d0, int ks, int half) { return d0 * 512 + ks * 4096 + half * 2048; }
__device__ __forceinline__ int crow(int r, int hi) { return (r & 3) + 8 * (r >> 2) + 4 * hi; }
__device__ __forceinline__ unsigned cvtpk(float lo, float hi) { unsigned r; asm volatile("v_cvt_pk_bf16_f32 %0, %1, %2" : "=v"(r) : "v"(lo), "v"(hi)); return r; }
__device__ __forceinline__ bf16x8 load8(const bf16* p) { return *reinterpret_cast<const bf16x8*>(p); }
__device__ __forceinline__ void glds16(const void* gsrc, unsigned lds_dst) { unsigned keep;
    asm volatile("s_mov_b32 %0, m0\n\ts_mov_b32 m0, %2\n\ts_nop 0\n\tglobal_load_lds_dwordx4 %1, off\n\ts_mov_b32 m0, %0" : "=&s"(keep) : "v"(gsrc), "s"(lds_dst) : "memory"); }
__device__ __forceinline__ void glds4(const void* gsrc, unsigned lds_dst) { unsigned keep;
    asm volatile("s_mov_b32 %0, m0\n\ts_mov_b32 m0, %2\n\ts_nop 0\n\tglobal_load_lds_dword %1, off\n\ts_mov_b32 m0, %0" : "=&s"(keep) : "v"(gsrc), "s"(lds_dst) : "memory"); }
__device__ __forceinline__ void mask_tile(f32x16& p0, f32x16& p1, int dq) {
    const float NEG = -__builtin_inff();
#pragma unroll
    for (int r = 0; r < 16; ++r) {
        const int c = (r & 3) + 8 * (r >> 2);
        if (dq - c < 0) p0[r] = NEG;
        if (dq - c - 32 < 0) p1[r] = NEG;
    }
}
__device__ __forceinline__ void partialSM(f32x16& p0, f32x16& p1, float& m_reg, float& mn, float& alpha) {
    float pmax = p0[0]; for (int r = 1; r < 16; ++r) pmax = fmaxf(pmax, p0[r]); for (int r = 0; r < 16; ++r) pmax = fmaxf(pmax, p1[r]);
    { auto rr = __builtin_amdgcn_permlane32_swap(__float_as_uint(pmax), __float_as_uint(pmax), false, false);
      pmax = fmaxf(__uint_as_float(rr[0]), __uint_as_float(rr[1])); }
    constexpr float C2 = 1.4426950408889634f * SCALE;
    if (__builtin_expect(__all((pmax - m_reg) * SCALE <= THR), 1)) { mn = m_reg; alpha = 1.f; }
    else { mn = fmaxf(m_reg, pmax); alpha = __builtin_amdgcn_exp2f((m_reg - mn) * C2); m_reg = mn; }
    const float mnL = -mn * C2;
    for (int r = 0; r < 16; ++r) p0[r] = fmaf(p0[r], C2, mnL); for (int r = 0; r < 16; ++r) p1[r] = fmaf(p1[r], C2, mnL);
    for (int r = 0; r < 16; ++r) p0[r] = __builtin_amdgcn_exp2f(p0[r]);
}
__device__ __forceinline__ void finishSM(f32x16& p0, f32x16& p1, float alpha, float& l_reg, bf16x8& pa0, bf16x8& pa1, bf16x8& pa2, bf16x8& pa3) {
    for (int r = 0; r < 16; ++r) p1[r] = __builtin_amdgcn_exp2f(p1[r]);
    float ps = 0; for (int r = 0; r < 16; ++r) ps += p0[r]; for (int r = 0; r < 16; ++r) ps += p1[r];
    { auto rr = __builtin_amdgcn_permlane32_swap(__float_as_uint(ps), __float_as_uint(ps), false, false);
      ps = __uint_as_float(rr[0]) + __uint_as_float(rr[1]); }
    l_reg = l_reg * alpha + ps;
#define PK4(P, B_, OUT) do { unsigned a0 = cvtpk(P[B_+0], P[B_+1]), a1 = cvtpk(P[B_+2], P[B_+3]);                          \
        unsigned b0 = cvtpk(P[B_+4], P[B_+5]), b1 = cvtpk(P[B_+6], P[B_+7]);                                             \
        auto r0 = __builtin_amdgcn_permlane32_swap(a0, b0, false, false); auto r1 = __builtin_amdgcn_permlane32_swap(a1, b1, false, false); \
        u32x4 w = {r0[0], r1[0], r0[1], r1[1]}; OUT = *reinterpret_cast<bf16x8*>(&w); } while (0)
    PK4(p0, 0, pa0); PK4(p0, 8, pa1); PK4(p1, 0, pa2); PK4(p1, 8, pa3);
#undef PK4
}
template <int KB>
__device__ __forceinline__ void qkt(f32x16& p0, f32x16& p1, const char* K_lds, const char* X_lds, int r32, int hi, const bf16x8* qr) {
    { const char* xb = X_lds + KB * SHM_X + hi * 16;
#pragma unroll
      for (int g = 0; g < 4; ++g) { const f32x4 a = *reinterpret_cast<const f32x4*>(xb + g * 32), b = *reinterpret_cast<const f32x4*>(xb + 128 + g * 32);
          p0[4 * g] = a[0]; p0[4 * g + 1] = a[1]; p0[4 * g + 2] = a[2]; p0[4 * g + 3] = a[3]; p1[4 * g] = b[0]; p1[4 * g + 1] = b[1]; p1[4 * g + 2] = b[2]; p1[4 * g + 3] = b[3]; } }
    const char* kb[4];
#pragma unroll
    for (int dd = 0; dd < 4; ++dd) kb[dd] = K_lds + KB * SHM_K + KSWZ(r32, (dd * 16 + hi * 8) * 2);
#pragma unroll
    for (int d0 = 0; d0 < 8; ++d0) { const char* a = kb[d0 & 3] + (d0 >> 2) * 128;
        bf16x8 b0 = *reinterpret_cast<const bf16x8*>(a);
        bf16x8 b1 = *reinterpret_cast<const bf16x8*>(a + 32 * 256);
        p0 = __builtin_amdgcn_mfma_f32_32x32x16_bf16(b0, qr[d0], p0, 0, 0, 0);
        p1 = __builtin_amdgcn_mfma_f32_32x32x16_bf16(b1, qr[d0], p1, 0, 0, 0); }
}
template <int VB>
__device__ __forceinline__ void pv_tile(f32x16* o, int vb0, bf16x8 pa0, bf16x8 pa1, bf16x8 pa2, bf16x8 pa3) {
#define TRRD(dst, off) asm volatile("ds_read_b64_tr_b16 %0, %1 offset:%2" : "=&v"(dst) : "v"(vb0), "i"(off) : "memory")
#define PV_D0(d0) do { s16x4 l0, l1, l2, l3, h0, h1, h2, h3; constexpr int b_ = VB * SHM_V + v_rd_off(d0, 0, 0);     \
        TRRD(l0, b_); TRRD(h0, b_ + 2048); TRRD(l1, b_ + 4096); TRRD(h1, b_ + 6144); TRRD(l2, b_ + 8192); TRRD(h2, b_ + 10240); TRRD(l3, b_ + 12288); TRRD(h3, b_ + 14336); \
        asm volatile("s_waitcnt lgkmcnt(0)" ::: "memory"); SBAR();                                                        \
        o[d0] = __builtin_amdgcn_mfma_f32_32x32x16_bf16(pa0, (bf16x8){l0[0], l0[1], l0[2], l0[3], h0[0], h0[1], h0[2], h0[3]}, o[d0], 0, 0, 0);   \
        o[d0] = __builtin_amdgcn_mfma_f32_32x32x16_bf16(pa1, (bf16x8){l1[0], l1[1], l1[2], l1[3], h1[0], h1[1], h1[2], h1[3]}, o[d0], 0, 0, 0);   \
        o[d0] = __builtin_amdgcn_mfma_f32_32x32x16_bf16(pa2, (bf16x8){l2[0], l2[1], l2[2], l2[3], h2[0], h2[1], h2[2], h2[3]}, o[d0], 0, 0, 0);   \
        o[d0] = __builtin_amdgcn_mfma_f32_32x32x16_bf16(pa3, (bf16x8){l3[0], l3[1], l3[2], l3[3], h3[0], h3[1], h3[2], h3[3]}, o[d0], 0, 0, 0); } while (0)
    PV_D0(0); PV_D0(1); PV_D0(2); PV_D0(3);
#undef PV_D0
#undef TRRD
}
struct Bases { const bf16* Q; const bf16* K; const bf16* V; const float* KX; bf16* O; };
struct BlockRef { int h, qb; };
constexpr int SEQL = 16384;
#define REF_Q(B_, r) ((B_).Q + ((size_t)(r).h * SEQL + (size_t)(r).qb * QB) * D)
#define REF_K(B_, r) ((B_).K + (size_t)(r).h * SEQL * D)
#define REF_V(B_, r) ((B_).V + (size_t)(r).h * SEQL * D)
#define REF_X(B_, r) ((B_).KX + (size_t)(r).h * SEQL)
#define REF_O(B_, r) ((B_).O + (size_t)(r).qb * QB * OPITCH + (r).h * D)
struct Seam { bf16x8 qr[8]; };
__device__ __forceinline__ unsigned k_src_off(int wid, int i, int lane) { const int r7 = 4 * i + (lane >> 4), row = 8 * wid + r7; return (unsigned)(row * 256 + (((lane & 15) ^ r7) << 4)); }
__device__ __forceinline__ unsigned v_src_off(int wid, int i, int lane) { const int st = 4 * wid + 2 * i + (lane >> 5), kk = 8 * (st >> 2) + ((lane & 31) >> 2);
    const int k = (kk & ~0xC) | ((kk & 4) << 1) | ((kk & 8) >> 1); return (unsigned)(k * 256 + ((st & 3) * 32 + (lane & 3) * 8) * 2); }
#define VMWN(n) asm volatile("s_waitcnt vmcnt(%0)" :: "i"(n) : "memory")
#define KDMA(Kp, k0, bf) do { int tz_ = threadIdx.x; asm volatile("" : "+v"(tz_)); const char* g_ = (const char*)(Kp) + (size_t)(k0) * 256;                     \
        glds16(g_ + k_src_off(wid, 0, tz_ & 63), lds32 + 2 * SHM_V + (bf) * SHM_K + wid * 2048); glds16(g_ + k_src_off(wid, 1, tz_ & 63), lds32 + 2 * SHM_V + (bf) * SHM_K + wid * 2048 + 1024); } while (0)
#define VDMA(Vp, k0, bf) do { int tz_ = threadIdx.x; asm volatile("" : "+v"(tz_)); const char* g_ = (const char*)(Vp) + (size_t)(k0) * 256;                     \
        glds16(g_ + v_src_off(wid, 0, tz_ & 63), lds32 + (bf) * SHM_V + wid * 2048); glds16(g_ + v_src_off(wid, 1, tz_ & 63), lds32 + (bf) * SHM_V + wid * 2048 + 1024); } while (0)
#define XDMA(Xp, k0, bf) do { if (wid == 0) glds4((Xp) + (k0) + lane, lds32 + LDS_X_OFF + (bf) * SHM_X); } while (0)
__device__ __forceinline__ void fox_prime(const Bases& BS, const BlockRef& cur, char* lds, unsigned lds32, Seam& S) {
    const int tid = threadIdx.x, wid = __builtin_amdgcn_readfirstlane(tid >> 6), lane = tid & 63, r32 = lane & 31, hi = lane >> 5;
    const int kb0 = cur.qb * QB;
    KDMA(REF_K(BS, cur), kb0, 0); XDMA(REF_X(BS, cur), kb0, 0);
    for (int d0 = 0; d0 < 8; ++d0) S.qr[d0] = load8(REF_Q(BS, cur) + (size_t)(wid * QBLK + r32) * D + d0 * 16 + hi * 8);
    VMWN(8);
    __syncthreads();
}
__device__ __forceinline__ void fox_block(const Bases& BS, const BlockRef& cur, char* lds, unsigned lds32, Seam& S, BlockRef& nxo) {
    const int tid = threadIdx.x, wid = __builtin_amdgcn_readfirstlane(tid >> 6), lane = tid & 63, r32 = lane & 31, hi = lane >> 5;
    const int P0 = cur.qb * QB;
    const int jd = 4 * cur.qb;
    int NT = 4 + jd;
    const int qlo = P0 + wid * QBLK, qm = qlo + r32 - 4 * hi;
    const char* K_lds = lds + 2 * SHM_V; const char* X_lds = lds + LDS_X_OFF;
    float* ws = (float*)(lds + LDS_WS_OFF) + wid * 64; float* li_l = ws, * al_l = ws + 32;
    float m_reg = -1e30f, l_reg = 0; f32x16 o[4] = {};
    const int vb0 = (int)lds32 + v_rd_base(lane);
    const bf16* Kh = REF_K(BS, cur); const bf16* Vh = REF_V(BS, cur); const float* Xh = REF_X(BS, cur);
    const float qkb = ((const float*)(lds + QN2_OFF))[cur.h * 64 + cur.qb];
    if (tid == 0) { ((int*)(lds + NPR_OFF))[0] = 0; ((int*)(lds + NPR_OFF))[1] = 0; }
#define RESC(a) do { if (__any((a) < 1.f)) { if (hi == 0) al_l[r32] = (a); asm volatile("s_waitcnt lgkmcnt(0)" ::: "memory");              \
                     for (int d_ = 0; d_ < 4; ++d_) for (int r = 0; r < 16; ++r) o[d_][r] *= al_l[crow(r, hi)]; } } while (0)
#define KBASE(t) (((t) < 4 ? jd + (t) : jd + 3 - (t)) * KVBLK)
#define MASKT(P0_, P1_, t) do { const int kb_ = KBASE(t); if (kb_ + KVBLK - 1 > qlo) mask_tile(P0_, P1_, qm - kb_); } while (0)
    f32x16 pA0, pA1, pB0, pB1; float mnA, mnB, alA, alB; bf16x8 pa0, pa1, pa2, pa3;
    VDMA(Vh, KBASE(0), 0); KDMA(Kh, KBASE(1), 1); XDMA(Xh, KBASE(1), 1); VDMA(Vh, KBASE(1), 1);
    SBAR(); qkt<0>(pA0, pA1, K_lds, X_lds, r32, hi, S.qr);
    MASKT(pA0, pA1, 0); partialSM(pA0, pA1, m_reg, mnA, alA);
    VMWN(0);
    __syncthreads();
#define HALF_STEP(PX0, PX1, mnX, alX, PY0, PY1, alY, t, KB, VB, SB) do {                                                      \
        if ((t) + 1 < NT) { KDMA(Kh, KBASE((t) + 1), SB); XDMA(Xh, KBASE((t) + 1), SB); }                                      \
        SBAR(); qkt<KB>(PX0, PX1, K_lds, X_lds, r32, hi, S.qr);                                                               \
        finishSM(PY0, PY1, alY, l_reg, pa0, pa1, pa2, pa3); SBAR();                                                           \
        pv_tile<VB>(o, vb0, pa0, pa1, pa2, pa3); MASKT(PX0, PX1, (t)); partialSM(PX0, PX1, m_reg, mnX, alX);                  \
        const bool ev_ = (((t) & 1) == 0) && (t) <= 16 && jd > 0;                   \
        if (ev_) { float wm_ = m_reg; _Pragma("unroll") for (int o_ = 1; o_ < 32; o_ <<= 1) wm_ = fminf(wm_, __shfl_xor(wm_, o_));                            \
                   if (lane == 0) ((float*)(lds + WMIN_OFF))[wid] = wm_; }                                                     \
        __syncthreads();                                                                                                      \
        float bv_ = 0.f; if (ev_ && tid < jd) bv_ = Xh[tid * KVBLK + KVBLK - 1];                                                \
        if ((t) + 1 < NT) VDMA(Vh, KBASE((t) + 1), SB);                                                                        \
        RESC(alX);                                                                                                            \
        if ((t) + 1 < NT) VMWN(2); else VMWN(0);                                                                               \
        if (ev_ && tid < jd) { const float* wm_ = (const float*)(lds + WMIN_OFF);                                               \
            const float mm_ = fminf(fminf(fminf(wm_[0], wm_[1]), fminf(wm_[2], wm_[3])), fminf(fminf(wm_[4], wm_[5]), fminf(wm_[6], wm_[7])));                   \
            if (bv_ < mm_ - qkb - PRUNE_T * (1.0f / SCALE)) __hip_atomic_fetch_add((int*)(lds + NPR_OFF) + (((t) >> 1) & 1), 1, __ATOMIC_RELAXED, __HIP_MEMORY_SCOPE_WORKGROUP); } \
        __syncthreads();                                                                                                      \
        if (ev_) { const int n_ = 4 + jd - __builtin_amdgcn_readfirstlane(((const int*)(lds + NPR_OFF))[((t) >> 1) & 1]); NT = n_ > (t) + 1 ? n_ : (t) + 1;   \
                   if (tid == 0) ((int*)(lds + NPR_OFF))[(((t) >> 1) & 1) ^ 1] = 0; } } while (0)
    for (int t = 1; t + 1 < NT; t += 2) {
        HALF_STEP(pB0, pB1, mnB, alB, pA0, pA1, alA, t, 1, 0, 0);
        HALF_STEP(pA0, pA1, mnA, alA, pB0, pB1, alB, t + 1, 0, 1, 1);
    }
    const bool even = (NT & 1) == 0;
    if (even) { SBAR(); qkt<1>(pB0, pB1, K_lds, X_lds, r32, hi, S.qr); SBAR(); }
    BlockRef nxt = cur; { const int nid = __builtin_amdgcn_readfirstlane(*(const int*)(lds + NXT_OFF)); nxo.h = -1; nxo.qb = 0;
        if (nid < 1024) { nxt.h = nid & 15; nxt.qb = 63 - (nid >> 4); nxo = nxt; } }
    const int kbn = nxt.qb * QB;
    VMWN(0);
    KDMA(REF_K(BS, nxt), kbn, 0); XDMA(REF_X(BS, nxt), kbn, 0); SBAR();
#pragma unroll
    for (int d0 = 0; d0 < 8; ++d0) S.qr[d0] = load8(REF_Q(BS, nxt) + (size_t)(wid * QBLK + r32) * D + d0 * 16 + hi * 8);
    SBAR();
    finishSM(pA0, pA1, alA, l_reg, pa0, pa1, pa2, pa3); SBAR();
    __syncthreads();
    pv_tile<0>(o, vb0, pa0, pa1, pa2, pa3);
    if (even) { MASKT(pB0, pB1, NT - 1); partialSM(pB0, pB1, m_reg, mnB, alB); RESC(alB);
        finishSM(pB0, pB1, alB, l_reg, pa0, pa1, pa2, pa3); SBAR(); pv_tile<1>(o, vb0, pa0, pa1, pa2, pa3); }
    SBAR(); VMWN(8); SBAR();
    if (hi == 0) li_l[r32] = l_reg; asm volatile("s_waitcnt lgkmcnt(0)" ::: "memory");
    float rli[16];
#pragma unroll
    for (int r = 0; r < 16; ++r) rli[r] = __builtin_amdgcn_rcpf(li_l[crow(r, hi)]);
    bf16* Ow = REF_O(BS, cur) + (size_t)(wid * QBLK) * OPITCH;
#pragma unroll
    for (int r = 0; r < 16; ++r) { const int orow = crow(r, hi);
#pragma unroll
        for (int d0 = 0; d0 < 4; ++d0) { const float v = o[d0][r] * rli[r];
            const float vn = __shfl_xor(v, 1);
            if ((r32 & 1) == 0) *(unsigned*)(Ow + (size_t)orow * OPITCH + d0 * 32 + r32) = cvtpk(v, vn); } }
    __syncthreads();
#undef RESC
#undef KBASE
#undef MASKT
#undef HALF_STEP
}
#undef REF_Q
#undef REF_K
#undef REF_V
#undef REF_X
#undef REF_O
#undef VMWN
#undef XDMA
#undef KDMA
#undef VDMA
#undef KSWZ
#undef SBAR
}

constexpr int NWAVES = 8;
#ifndef MK_N_LAUNCHES
#define MK_N_LAUNCHES 1
#endif
constexpr int N_PHASES = 17;

constexpr size_t MiB = 1u << 20;
constexpr size_t WS_CTL = 0, CTL_ZERO_BYTES = 64 * 1024;
constexpr size_t WS_TOKE = 1 * MiB, WS_TOKW0 = WS_TOKE + 65536, WS_TOKW1 = WS_TOKW0 + 65536, WS_TOKP0 = WS_TOKW1 + 65536, WS_TOKP1 = WS_TOKP0 + 65536;
constexpr size_t WS_SLOT = 2 * MiB;
constexpr size_t WS_LC = 4 * MiB;
constexpr size_t WS_CT = 5 * MiB;
constexpr size_t WS_WR = 5 * MiB + 512 * 1024;
constexpr size_t WS_WF = 6 * MiB;
constexpr size_t WS_NB = 7 * MiB + 512 * 1024;
constexpr size_t WS_KX = 8 * MiB;
constexpr size_t WS_WCIN = 16 * MiB, WS_WCOUT = 40 * MiB, WS_WAIN = 48 * MiB, WS_WAOUT = 72 * MiB;
constexpr size_t WS_WGU = 80 * MiB;
constexpr size_t WS_WD = 336 * MiB;
constexpr size_t WS_HN = 464 * MiB;
constexpr size_t WS_X = 528 * MiB;
constexpr size_t WS_STAGE = 656 * MiB;
constexpr size_t WS_Y = WS_STAGE;
constexpr size_t WS_Z = WS_STAGE, WS_GO = WS_STAGE + 64 * MiB;
constexpr size_t WS_XS = WS_STAGE, WS_H = WS_STAGE + 160 * MiB;
constexpr size_t WS_Q = WS_STAGE, WS_K = WS_STAGE + 64 * MiB, WS_V = WS_STAGE + 128 * MiB;
constexpr size_t WS_END = 856 * MiB;
constexpr int CW_ATT = 32;
constexpr int CW_CNT = 64;
constexpr int CW_BAR = 4096;
constexpr int RING_OFF = 0, RING_BYTES = 131072;
constexpr int TILE_OFF = RING_BYTES;
constexpr int TST_OFF = TILE_OFF + 1024;
constexpr int MISC_OFF = TST_OFF + 512;
constexpr int RTOK_OFF = MISC_OFF + 128;
constexpr int NRM_OFF = RTOK_OFF + 4096;
constexpr int LDS_BYTES = 147456;
static_assert(NRM_OFF + 8192 <= LDS_BYTES && fox::LDS_BYTES <= RING_BYTES, "LDS map");

#define GAS __attribute__((address_space(1)))
#define LAS __attribute__((address_space(3)))
typedef unsigned short bf16;
typedef unsigned v4u __attribute__((ext_vector_type(4)));
typedef unsigned v2u __attribute__((ext_vector_type(2)));
typedef float f32x4 __attribute__((ext_vector_type(4)));
typedef float f32x16 __attribute__((ext_vector_type(16)));
typedef short bf16x8 __attribute__((ext_vector_type(8)));
typedef GAS unsigned gu32;
#define RLX_AGENT __ATOMIC_RELAXED, __HIP_MEMORY_SCOPE_AGENT
#define LDS_WAIT() asm volatile("s_waitcnt lgkmcnt(0)" ::: "memory")
#define VM_WAIT() asm volatile("s_waitcnt vmcnt(0)" ::: "memory")
__device__ __forceinline__ unsigned f2bf(float f) { unsigned u = __builtin_bit_cast(unsigned, f); return (u + 0x7fffu + ((u >> 16) & 1u)) >> 16; }
__device__ __forceinline__ unsigned pk2(float lo, float hi) { return f2bf(lo) | (f2bf(hi) << 16); }
__device__ __forceinline__ float bf_lo(unsigned w) { return __builtin_bit_cast(float, w << 16); }
__device__ __forceinline__ float bf_hi(unsigned w) { return __builtin_bit_cast(float, w & 0xffff0000u); }
__device__ __forceinline__ float wave_sum(float v) {
#pragma unroll
    for (int o = 1; o < 64; o <<= 1) v += __shfl_xor(v, o);
    return v;
}

#define XB_TMO      128
#define XB_XCNT(j)  (256  + 64 * (j))
#define XB_XSUB(j)  (1280 + 64 * (j))
#define XB_XGEN(j)  (2304 + 64 * (j))
#define XB_TOP      3328
#define XB_TOPGEN   3392
#define XCD_BAR_WORDS 3456
#define XB_SPIN_CAP (1u << 18)

__device__ __forceinline__ unsigned xb_ld(unsigned* p)              { return __hip_atomic_load(p, __ATOMIC_RELAXED, __HIP_MEMORY_SCOPE_AGENT); }
__device__ __forceinline__ unsigned xb_add(unsigned* p, unsigned v) { return __hip_atomic_fetch_add(p, v, __ATOMIC_RELAXED, __HIP_MEMORY_SCOPE_AGENT); }
__device__ __forceinline__ unsigned xb_xcc_id() { return (unsigned)__builtin_amdgcn_s_getreg((3 << 11) | 20) & 0xFu; }
#define XB_SPIN(cond, bar) do { unsigned _sp = 0; while (cond) { __builtin_amdgcn_s_sleep(1); \
    if ((++_sp & 255u) == 0u) { if (xb_ld(&(bar)[XB_TMO])) break; if (_sp > XB_SPIN_CAP) { atomicAdd(&(bar)[XB_TMO], 1u); break; } } } } while (0)

struct XcdBarrier {
    unsigned* bar; unsigned x;
    volatile LAS unsigned* st;
};

__device__ __forceinline__ XcdBarrier xcd_barrier_post(unsigned* bar, volatile LAS unsigned* st) {
    XcdBarrier b; b.bar = bar; b.x = xb_xcc_id(); b.st = st;
    if (threadIdx.x == 0) (void)xb_add(&bar[XB_XCNT(b.x)], 1u);
    return b;
}
__device__ __forceinline__ void xcd_barrier_complete(unsigned* bar, unsigned x, unsigned& nloc, unsigned& nx) {
    const unsigned G = gridDim.x * gridDim.y * gridDim.z;
    unsigned sum, cnt, mine, sp = 0u;
    for (;;) {
        sum = 0u; cnt = 0u; mine = 0u;
#pragma unroll
        for (unsigned j = 0; j < 16; ++j) { const unsigned c = xb_ld(&bar[XB_XCNT(j)]); sum += c; cnt += (c > 0u) ? 1u : 0u; mine = (j == x) ? c : mine; }
        if (sum == G) break;
        __builtin_amdgcn_s_sleep(1);
        if ((++sp & 255u) == 0u) { if (xb_ld(&bar[XB_TMO])) break; if (sp > XB_SPIN_CAP) { atomicAdd(&bar[XB_TMO], 1u); break; } }
    }
    nloc = mine > 0u ? mine : 1u; nx = cnt > 0u ? cnt : 1u;
}

__device__ __forceinline__ void xcd_barrier(const XcdBarrier& b) {
    asm volatile("s_waitcnt vmcnt(0)" ::: "memory");
    __syncthreads();
    if (threadIdx.x == 0) {
        unsigned* bar = b.bar;
        __builtin_amdgcn_s_waitcnt(0);
        unsigned nloc = b.st[0], nx = b.st[1];
        if (nloc == 0u) { xcd_barrier_complete(bar, b.x, nloc, nx); b.st[0] = nloc; b.st[1] = nx; }
        const unsigned old = xb_add(&bar[XB_XSUB(b.x)], 1u);
        const unsigned gen = old / nloc;
        if (old + 1u == (gen + 1u) * nloc) {
            __builtin_amdgcn_fence(__ATOMIC_RELEASE, "agent");
            asm volatile("s_waitcnt vmcnt(0)" ::: "memory");
            const unsigned og = xb_add(&bar[XB_TOP], 1u);
            const unsigned tg = og / nx;
            if (og + 1u == (tg + 1u) * nx) xb_add(&bar[XB_TOPGEN], 1u);
            else XB_SPIN(xb_ld(&bar[XB_TOPGEN]) == tg, bar);
            __builtin_amdgcn_fence(__ATOMIC_ACQUIRE, "agent");
            xb_add(&bar[XB_XGEN(b.x)], 1u);
            asm volatile("s_waitcnt vmcnt(0)" ::: "memory");
        } else {
            XB_SPIN(xb_ld(&bar[XB_XGEN(b.x)]) == gen, bar);
            __builtin_amdgcn_fence(__ATOMIC_ACQUIRE, "agent");
            asm volatile("s_waitcnt vmcnt(0)" ::: "memory");
        }
    }
    __syncthreads();
}

struct Frame {
    LAS unsigned char* lds;
    volatile LAS unsigned* MISC;
    gu32* ctl;
    int tid, lane, wave;
    int vcu, G;
    const float *x, *mix_norm, *ffn_norm, *final_norm, *conv_w_in, *conv_w, *conv_w_out, *attn_w_in, *attn_b_f, *attn_w_out, *rg_w, *rg_b, *re_w, *re_b, *w_gate, *w_up, *w_down;
    float* out; unsigned char* ws;
};
#define WSP(T, off) ((T*)(F.ws + (off)))

struct TrItem { const float* src; bf16* dst; int ldw, ldd; };
__device__ __forceinline__ bool tr_decode(const Frame& F, int it, TrItem& d) {
    if (it < 6144) { const int kb = it / 192, nb = it % 192, n0 = nb * 32; d.src = F.conv_w_in + (size_t)(kb * 64) * 6144 + n0; d.ldw = 6144; d.ldd = 2048;
        int dr; if (n0 < 2048) dr = 4096 + n0; else if (n0 < 4096) { const int i = n0 - 2048; dr = 256 * (i >> 7) + (i & 127); } else { const int i = n0 - 4096; dr = 256 * (i >> 7) + 128 + (i & 127); }
        d.dst = WSP(bf16, WS_WCIN) + (size_t)dr * 2048 + kb * 64; return true; }
    it -= 6144;
    if (it < 2048) { const int kb = it / 64, nb = it % 64; d.src = F.conv_w_out + (size_t)(kb * 64) * 2048 + nb * 32; d.ldw = 2048; d.ldd = 2048; d.dst = WSP(bf16, WS_WCOUT) + (size_t)(nb * 32) * 2048 + kb * 64; return true; }
    it -= 2048;
    if (it < 6144) { const int kb = it / 192, nb = it % 192; d.src = F.attn_w_in + (size_t)(kb * 64) * 6160 + nb * 32; d.ldw = 6160; d.ldd = 2048; d.dst = WSP(bf16, WS_WAIN) + (size_t)(nb * 32) * 2048 + kb * 64; return true; }
    it -= 6144;
    if (it < 2048) { const int kb = it / 64, nb = it % 64; d.src = F.attn_w_out + (size_t)(kb * 64) * 2048 + nb * 32; d.ldw = 2048; d.ldd = 2048; d.dst = WSP(bf16, WS_WAOUT) + (size_t)(nb * 32) * 2048 + kb * 64; return true; }
    it -= 2048;
    if (it < 65536) { const int up = it >> 15, r = it & 32767, le = r >> 9, q = r & 511, kb = q >> 4, nb = q & 15, n0 = nb * 32;
        d.src = (up ? F.w_up : F.w_gate) + (size_t)le * 2048 * 512 + (size_t)(kb * 64) * 512 + n0; d.ldw = 512; d.ldd = 2048;
        const int dr = 256 * (n0 >> 7) + 128 * up + (n0 & 127);
        d.dst = WSP(bf16, WS_WGU) + ((size_t)le * 1024 + dr) * 2048 + kb * 64; return true; }
    it -= 65536;
    if (it < 32768) { const int le = it >> 9, q = it & 511, kb = q >> 6, nb = q & 63;
        d.src = F.w_down + (size_t)le * 512 * 2048 + (size_t)(kb * 64) * 2048 + nb * 32; d.ldw = 2048; d.ldd = 512;
        d.dst = WSP(bf16, WS_WD) + ((size_t)le * 2048 + nb * 32) * 512 + kb * 64; return true; }
    return false;
}
constexpr int TR_NITEMS = 6144 + 2048 + 6144 + 2048 + 65536 + 32768;
__device__ __forceinline__ void p0_prologue(Frame& F) {
    LAS float* scr = (LAS float*)(F.lds + RING_OFF + F.wave * 16384);
    const int gw = F.vcu * NWAVES + F.wave, NGW = F.G * NWAVES, lane = F.lane;
#define TR_LOAD(v, d) do { _Pragma("unroll") for (int i = 0; i < 32; ++i) v[i] = (d).src[(size_t)(2 * i + (lane >> 5)) * (d).ldw + (lane & 31)]; } while (0)
#define TR_FLUSH(v, d, sc) do { _Pragma("unroll") for (int i = 0; i < 32; ++i) { const int kk = 2 * i + (lane >> 5); (sc)[kk * 32 + ((lane ^ kk) & 31)] = v[i]; } } while (0)
#define TR_STORE(d, sc) do { LDS_WAIT(); asm volatile("" ::: "memory"); const int c = lane & 7;                                                                       \
        _Pragma("unroll") for (int j = 0; j < 4; ++j) { const int n = (lane >> 3) + 8 * j; float t[8];                                                               \
            _Pragma("unroll") for (int q = 0; q < 8; ++q) { const int kk = 8 * c + q; t[q] = (sc)[kk * 32 + ((n ^ kk) & 31)]; }                                       \
            v4u o; o.x = pk2(t[0], t[1]); o.y = pk2(t[2], t[3]); o.z = pk2(t[4], t[5]); o.w = pk2(t[6], t[7]);                                                        \
            *(GAS v4u*)((d).dst + (size_t)n * (d).ldd + 8 * c) = o; }                                                                                                 \
        LDS_WAIT(); asm volatile("" ::: "memory"); } while (0)
    float va[32], vb[32]; TrItem da, db, na, nb; int it = gw;
    bool ha = tr_decode(F, it, da), hb = tr_decode(F, it + NGW, db);
    if (ha) TR_LOAD(va, da);
    if (hb) TR_LOAD(vb, db);
    while (ha) {
        TR_FLUSH(va, da, scr);
        const bool hna = tr_decode(F, it + 2 * NGW, na);
        if (hna) TR_LOAD(va, na);
        TR_STORE(da, scr);
        if (hb) {
            TR_FLUSH(vb, db, scr + 2048);
            const bool hnb = tr_decode(F, it + 3 * NGW, nb);
            if (hnb) TR_LOAD(vb, nb);
            TR_STORE(db, scr + 2048);
            db = nb; hb = hnb;
        }
        da = na; ha = hna; it += 2 * NGW;
    }
#undef TR_LOAD
#undef TR_FLUSH
#undef TR_STORE
    const int gt = (F.vcu * NWAVES + F.wave) * 64 + lane, NGT = F.G * NWAVES * 64;
    for (int i = gt; i < 2 * 64 * 2048; i += NGT) { const int l = i >> 17, r = (i >> 11) & 63, k = i & 2047; float w = 0.f;
        if (r < 4) w = F.rg_w[((size_t)l * 2048 + k) * 4 + r];
        else if (r < 36) { const int g = (r - 4) >> 3, e = (r - 4) & 7; w = F.re_w[(((size_t)l * 4 + g) * 2048 + k) * 8 + e]; }
        WSP(bf16, WS_WR)[i] = (bf16)f2bf(w); }
    for (int i = gt; i < 32 * 2048; i += NGT) { const int r = i >> 11, k = i & 2047; const float w = r < 16 ? F.attn_w_in[(size_t)k * 6160 + 6144 + r] : 0.f; WSP(bf16, WS_WF)[i] = (bf16)f2bf(w); }
}

template <int NB>
__device__ __forceinline__ void small_gemm(const Frame& F, const bf16* hn_rows, const bf16* Wt, LAS float* lg) {
    constexpr int NC = NB * 32, NE = 64 * NC, PER = NE / 512;
    const int lane = F.lane, r32 = lane & 31, hi = lane >> 5, kw = F.wave * 256;
    f32x16 acc[2][NB];
#pragma unroll
    for (int a = 0; a < 2; ++a)
#pragma unroll
        for (int b = 0; b < NB; ++b) acc[a][b] = f32x16{};
    const bf16* ap = hn_rows + (size_t)r32 * 2048 + kw + hi * 8; const bf16* bp = Wt + (size_t)r32 * 2048 + kw + hi * 8;
#pragma unroll 4
    for (int ks = 0; ks < 16; ++ks) {
        const bf16x8 a0 = *(const bf16x8*)(ap + ks * 16), a1 = *(const bf16x8*)(ap + 32 * 2048 + ks * 16);
#pragma unroll
        for (int b = 0; b < NB; ++b) { const bf16x8 bv = *(const bf16x8*)(bp + (size_t)b * 32 * 2048 + ks * 16);
            acc[0][b] = __builtin_amdgcn_mfma_f32_32x32x16_bf16(a0, bv, acc[0][b], 0, 0, 0);
            acc[1][b] = __builtin_amdgcn_mfma_f32_32x32x16_bf16(a1, bv, acc[1][b], 0, 0, 0); }
    }
    LAS float* part = lg + F.wave * NE;
#pragma unroll
    for (int a = 0; a < 2; ++a)
#pragma unroll
        for (int b = 0; b < NB; ++b)
#pragma unroll
            for (int r = 0; r < 16; ++r) { const int row = a * 32 + (r & 3) + 8 * (r >> 2) + 4 * hi; part[row * NC + b * 32 + r32] = acc[a][b][r]; }
    LDS_WAIT(); __syncthreads();
    float s[PER];
#pragma unroll
    for (int q = 0; q < PER; ++q) { const int i = F.tid + 512 * q; float t = lg[i];
#pragma unroll
        for (int w = 1; w < 8; ++w) t += lg[w * NE + i];
        s[q] = t; }
    LDS_WAIT(); __syncthreads();
#pragma unroll
    for (int q = 0; q < PER; ++q) { const int i = F.tid + 512 * q; lg[(i / NC) * (NC + 1) + (i % NC)] = s[q]; }
    LDS_WAIT(); __syncthreads();
}
__device__ __forceinline__ int build_tiles(Frame& F, int layer) {
    LAS int* tile_e = (LAS int*)(F.lds + TILE_OFF); LAS int* tst = (LAS int*)(F.lds + TST_OFF);
    __syncthreads();
    if (F.tid < 64) {
        const int c = F.tid < 32 ? (int)__hip_atomic_load(F.ctl + CW_CNT + 32 * layer + F.tid, RLX_AGENT) : 0;
        const int nt = (c + 255) >> 8; int inc = nt;
#pragma unroll
        for (int o = 1; o < 32; o <<= 1) { const int t = __shfl_up(inc, o); if ((F.tid & 63) >= o) inc += t; }
        const int st = inc - nt;
        if (F.tid < 32) { tst[F.tid] = st; tst[32 + F.tid] = c; for (int t = 0; t < nt; ++t) tile_e[st + t] = F.tid; }
        if (F.tid == 31) tst[64] = inc;
    }
    __syncthreads();
    return tst[64];
}
template <int MODE>
__device__ __forceinline__ void row_phase(Frame& F, int layer) {
    const int lane = F.lane, wave = F.wave, tid = F.tid;
    const float* gain = MODE == 0 ? F.mix_norm : (MODE == 1 ? F.ffn_norm + layer * DM : (MODE == 2 ? F.mix_norm + DM : F.final_norm));
    f32x4 g[8];
#pragma unroll
    for (int j = 0; j < 4; ++j) { g[2 * j] = *(const f32x4*)(gain + 512 * j + 8 * lane); g[2 * j + 1] = *(const f32x4*)(gain + 512 * j + 8 * lane + 4); }
    LAS float* lg = (LAS float*)(F.lds + RING_OFF);
    LAS int* hist = (LAS int*)(F.lds + TILE_OFF);
    LAS int* tst = (LAS int*)(F.lds + TST_OFF);
    if (MODE >= 2) (void)build_tiles(F, MODE == 2 ? 0 : 1);
    const bool XF32 = (MODE == 0 || (MODE == 1 && layer == 0));
    bf16* HN = WSP(bf16, WS_HN);
    for (int chunk = F.vcu; chunk < SEQ / 64; chunk += F.G) {
        const int row0 = chunk * 64;
        if (MODE == 1) { if (tid < 64) hist[tid] = 0; }
        int mr0[8], mr1[8]; float mw0[8], mw1[8];
        if (MODE >= 2) {
#pragma unroll
            for (int i = 0; i < 8; ++i) { const int row = row0 + wave * 8 + i;
                const unsigned ee = WSP(unsigned, WS_TOKE)[row]; const int p0 = WSP(int, WS_TOKP0)[row], p1 = WSP(int, WS_TOKP1)[row];
                mw0[i] = WSP(float, WS_TOKW0)[row]; mw1[i] = WSP(float, WS_TOKW1)[row];
                mr0[i] = tst[ee & 255] * 256 + p0; mr1[i] = tst[(ee >> 8) & 255] * 256 + p1; }
        }
#pragma unroll 2
        for (int i = 0; i < 8; ++i) {
            const int row = row0 + wave * 8 + i;
            f32x4 v[8];
            if (XF32) { const float* xr = F.x + (size_t)row * DM + 8 * lane;
#pragma unroll
                for (int j = 0; j < 4; ++j) { v[2 * j] = *(const f32x4*)(xr + 512 * j); v[2 * j + 1] = *(const f32x4*)(xr + 512 * j + 4); } }
            else { const bf16* xr = WSP(bf16, WS_X) + (size_t)row * DM + 8 * lane;
#pragma unroll
                for (int j = 0; j < 4; ++j) { const v4u a = *(const v4u*)(xr + 512 * j);
                    v[2 * j] = (f32x4){bf_lo(a.x), bf_hi(a.x), bf_lo(a.y), bf_hi(a.y)}; v[2 * j + 1] = (f32x4){bf_lo(a.z), bf_hi(a.z), bf_lo(a.w), bf_hi(a.w)}; } }
            if (MODE == 1) { const bf16* yr = WSP(bf16, WS_Y) + (size_t)row * DM + 8 * lane;
#pragma unroll
                for (int j = 0; j < 4; ++j) { const v4u a = *(const v4u*)(yr + 512 * j);
                    v[2 * j][0] += bf_lo(a.x); v[2 * j][1] += bf_hi(a.x); v[2 * j][2] += bf_lo(a.y); v[2 * j][3] += bf_hi(a.y);
                    v[2 * j + 1][0] += bf_lo(a.z); v[2 * j + 1][1] += bf_hi(a.z); v[2 * j + 1][2] += bf_lo(a.w); v[2 * j + 1][3] += bf_hi(a.w); } }
            if (MODE >= 2) {
                const int r0 = __builtin_amdgcn_readfirstlane(mr0[i]), r1 = __builtin_amdgcn_readfirstlane(mr1[i]); const float w0 = mw0[i], w1 = mw1[i];
                const bf16* o0 = WSP(bf16, WS_XS) + (size_t)r0 * DM + 8 * lane; const bf16* o1 = WSP(bf16, WS_XS) + (size_t)r1 * DM + 8 * lane;
#pragma unroll
                for (int j = 0; j < 4; ++j) { const v4u a = *(const v4u*)(o0 + 512 * j), b = *(const v4u*)(o1 + 512 * j);
                    v[2 * j][0] += w0 * bf_lo(a.x) + w1 * bf_lo(b.x); v[2 * j][1] += w0 * bf_hi(a.x) + w1 * bf_hi(b.x);
                    v[2 * j][2] += w0 * bf_lo(a.y) + w1 * bf_lo(b.y); v[2 * j][3] += w0 * bf_hi(a.y) + w1 * bf_hi(b.y);
                    v[2 * j + 1][0] += w0 * bf_lo(a.z) + w1 * bf_lo(b.z); v[2 * j + 1][1] += w0 * bf_hi(a.z) + w1 * bf_hi(b.z);
                    v[2 * j + 1][2] += w0 * bf_lo(a.w) + w1 * bf_lo(b.w); v[2 * j + 1][3] += w0 * bf_hi(a.w) + w1 * bf_hi(b.w); }
            }
            float ss = 0.f;
#pragma unroll
            for (int j = 0; j < 8; ++j) ss += (v[j][0] * v[j][0] + v[j][1] * v[j][1]) + (v[j][2] * v[j][2] + v[j][3] * v[j][3]);
            const float rstd = 1.0f / sqrtf(wave_sum(ss) * (1.0f / DM) + RMS_EPS);
            if (MODE == 1 || MODE == 2) { bf16* xw = WSP(bf16, WS_X) + (size_t)row * DM + 8 * lane;
#pragma unroll
                for (int j = 0; j < 4; ++j) { v4u o; o.x = pk2(v[2 * j][0], v[2 * j][1]); o.y = pk2(v[2 * j][2], v[2 * j][3]); o.z = pk2(v[2 * j + 1][0], v[2 * j + 1][1]); o.w = pk2(v[2 * j + 1][2], v[2 * j + 1][3]); *(v4u*)(xw + 512 * j) = o; } }
            if (MODE == 3) { float* ow = F.out + (size_t)row * DM + 8 * lane;
#pragma unroll
                for (int j = 0; j < 4; ++j) { *(f32x4*)(ow + 512 * j) = v[2 * j] * rstd * g[2 * j]; *(f32x4*)(ow + 512 * j + 4) = v[2 * j + 1] * rstd * g[2 * j + 1]; } }
            else { bf16* hw = HN + (size_t)row * DM + 8 * lane;
#pragma unroll
                for (int j = 0; j < 4; ++j) { const f32x4 a = v[2 * j] * rstd * g[2 * j], b = v[2 * j + 1] * rstd * g[2 * j + 1];
                    v4u o; o.x = pk2(a[0], a[1]); o.y = pk2(a[2], a[3]); o.z = pk2(b[0], b[1]); o.w = pk2(b[2], b[3]); *(v4u*)(hw + 512 * j) = o; } }
        }
        if (MODE == 1 || MODE == 2) {
            VM_WAIT(); __syncthreads();
            if (MODE == 1) small_gemm<2>(F, HN + (size_t)row0 * DM, WSP(bf16, WS_WR) + (size_t)layer * 64 * 2048, lg);
            else small_gemm<1>(F, HN + (size_t)row0 * DM, WSP(bf16, WS_WF), lg);
            if (MODE == 1) {
                int e0 = 0, e1 = 0, rk0 = 0, rk1 = 0; float w0 = 0.f, w1 = 0.f;
                if (tid < 64) {
                    const LAS float* l = lg + tid * 65; const float* gb = F.rg_b + layer * 4; const float* eb = F.re_b + layer * 32;
                    float gl[4]; for (int j = 0; j < 4; ++j) gl[j] = l[j] + gb[j];
                    int gs = 0; float gm = gl[0]; for (int j = 1; j < 4; ++j) if (gl[j] > gm) { gm = gl[j]; gs = j; }
                    float den = 0.f; for (int j = 0; j < 4; ++j) den += __expf(gl[j] - gm);
                    const float pg = 1.0f / den;
                    float el[8]; for (int j = 0; j < 8; ++j) el[j] = l[4 + gs * 8 + j] + eb[gs * 8 + j];
                    int i1 = 0; float v1 = el[0]; for (int j = 1; j < 8; ++j) if (el[j] > v1) { v1 = el[j]; i1 = j; }
                    int i2 = -1; float v2 = -3.0e38f; for (int j = 0; j < 8; ++j) if (j != i1 && el[j] > v2) { v2 = el[j]; i2 = j; }
                    const float s = 1.0f / (1.0f + __expf(v2 - v1));
                    w0 = pg * s; w1 = pg * (1.0f - s); e0 = gs * 8 + i1; e1 = gs * 8 + i2;
                    rk0 = __hip_atomic_fetch_add(hist + e0, 1, __ATOMIC_RELAXED, __HIP_MEMORY_SCOPE_WORKGROUP);
                    rk1 = __hip_atomic_fetch_add(hist + e1, 1, __ATOMIC_RELAXED, __HIP_MEMORY_SCOPE_WORKGROUP);
                    LDS_WAIT(); asm volatile("" ::: "memory");
                    if (tid < 32) { const int c = hist[tid]; hist[32 + tid] = c ? (int)__hip_atomic_fetch_add(F.ctl + CW_CNT + 32 * layer + tid, (unsigned)c, RLX_AGENT) : 0; }
                    LDS_WAIT(); asm volatile("" ::: "memory");
                    const int p0 = hist[32 + e0] + rk0, p1 = hist[32 + e1] + rk1, row = row0 + tid;
                    WSP(int, WS_SLOT)[e0 * CAP + p0] = row; WSP(int, WS_SLOT)[e1 * CAP + p1] = row;
                    WSP(unsigned, WS_TOKE)[row] = (unsigned)e0 | ((unsigned)e1 << 8);
                    WSP(int, WS_TOKP0)[row] = p0; WSP(int, WS_TOKP1)[row] = p1; WSP(float, WS_TOKW0)[row] = w0; WSP(float, WS_TOKW1)[row] = w1;
                }
            } else {
                if (tid < 16) {
                    const float bfh = F.attn_b_f[tid]; float run = 0.f; float* lc = WSP(float, WS_LC) + (size_t)row0 * 16 + tid;
                    for (int r = 0; r < 64; ++r) { const float xv = lg[r * 33 + tid] + bfh; const float ls = fminf(xv, 0.f) - log1pf(__expf(-fabsf(xv))); run += ls; lc[r * 16] = run; }
                    WSP(float, WS_CT)[chunk * 16 + tid] = run;
                }
            }
            __syncthreads();
        }
    }
}
__device__ __forceinline__ void c_finalize(Frame& F) {
    LAS float* part = (LAS float*)(F.lds + RING_OFF);
    const int tid = F.tid;
    for (int chunk = F.vcu; chunk < SEQ / 64; chunk += F.G) {
        __syncthreads();
        { const int h = tid & 15, p = tid >> 4; float s = 0.f; const float* ct = WSP(float, WS_CT);
            for (int c = p * 8; c < p * 8 + 8; ++c) if (c < chunk) s += ct[c * 16 + h];
            part[p * 16 + h] = s; }
        __syncthreads();
        if (tid < 16) { float s = 0.f; for (int p = 0; p < 32; ++p) s += part[p * 16 + tid]; part[512 + tid] = s; }
        __syncthreads();
        for (int i = tid; i < 64 * 16; i += 512) { const int r = i >> 4, h = i & 15, row = chunk * 64 + r;
            const float cv = WSP(float, WS_LC)[(size_t)row * 16 + h] + part[512 + h];
            WSP(float, WS_KX)[(size_t)h * SEQ + row] = -cv * 11.313708498984761f; }
    }
    __syncthreads();
}
__device__ __forceinline__ void conv_phase(Frame& F) {
    const int tid = F.tid, c8 = (tid & 255) * 8, half = tid >> 8;
    float w[3][8];
#pragma unroll
    for (int k = 0; k < 3; ++k)
#pragma unroll
        for (int j = 0; j < 8; ++j) w[k][j] = F.conv_w[k * DM + c8 + j];
    const bf16* Z = WSP(bf16, WS_Z); const bf16* GO = WSP(bf16, WS_GO); bf16* A = WSP(bf16, WS_HN);
    for (int chunk = F.vcu; chunk < SEQ / 64; chunk += F.G) {
        const int t0 = chunk * 64 + half * 32;
        v4u zm2 = (v4u){0u, 0u, 0u, 0u}, zm1 = zm2;
        if (t0 >= 2) { zm2 = *(const v4u*)(Z + (size_t)(t0 - 2) * DM + c8); zm1 = *(const v4u*)(Z + (size_t)(t0 - 1) * DM + c8); }
#pragma unroll 4
        for (int t = t0; t < t0 + 32; ++t) {
            const v4u z0 = *(const v4u*)(Z + (size_t)t * DM + c8), go = *(const v4u*)(GO + (size_t)t * DM + c8);
            v4u o;
#define CV(q, j) (w[0][j] * (((j) & 1) ? bf_hi(zm2.q) : bf_lo(zm2.q)) + w[1][j] * (((j) & 1) ? bf_hi(zm1.q) : bf_lo(zm1.q)) + w[2][j] * (((j) & 1) ? bf_hi(z0.q) : bf_lo(z0.q)))
            o.x = pk2(bf_lo(go.x) * CV(x, 0), bf_hi(go.x) * CV(x, 1)); o.y = pk2(bf_lo(go.y) * CV(y, 2), bf_hi(go.y) * CV(y, 3));
            o.z = pk2(bf_lo(go.z) * CV(z, 4), bf_hi(go.z) * CV(z, 5)); o.w = pk2(bf_lo(go.w) * CV(w, 6), bf_hi(go.w) * CV(w, 7));
#undef CV
            *(v4u*)(A + (size_t)t * DM + c8) = o;
            zm2 = zm1; zm1 = z0;
        }
    }
}
__device__ __forceinline__ void gather_phase(Frame& F, int layer) {
    const int ntile = build_tiles(F, layer);
    const LAS int* tile_e = (const LAS int*)(F.lds + TILE_OFF); const LAS int* tst = (const LAS int*)(F.lds + TST_OFF);
    const int gw = F.vcu * NWAVES + F.wave, NGW = F.G * NWAVES, lane = F.lane;
    const bf16* HN = WSP(bf16, WS_HN); bf16* XS = WSP(bf16, WS_XS);
    for (int r = gw; r < ntile * 256; r += NGW) {
        const int t = r >> 8, e = tile_e[t], pos = r - tst[e] * 256;
        if (pos < tst[32 + e]) { const int tok = WSP(int, WS_SLOT)[e * CAP + pos];
            const v4u* s = (const v4u*)(HN + (size_t)tok * DM) + lane; v4u* d = (v4u*)(XS + (size_t)r * DM) + lane;
            const v4u a = s[0], b = s[64], c = s[128], dd = s[192]; d[0] = a; d[64] = b; d[128] = c; d[192] = dd; }
    }
}


__device__ __forceinline__ void attn_phase(Frame& F, unsigned char* lds) {
    const unsigned lds32 = (unsigned)(size_t)F.lds;
    LAS float* qk = (LAS float*)(F.lds + RING_OFF + fox::QN2_OFF);
    LAS float* kn2 = (LAS float*)(F.lds + RING_OFF + fox::KN2_OFF);
    LAS int* nxt_id = (LAS int*)(F.lds + RING_OFF + fox::NXT_OFF);
    const int tid = F.tid;
    const float* NBp = WSP(float, WS_NB);
    for (int i = tid; i < 1024; i += 512) { const float* p = NBp + (size_t)(1024 + i) * 8;
        kn2[i] = fmaxf(fmaxf(fmaxf(p[0], p[1]), fmaxf(p[2], p[3])), fmaxf(fmaxf(p[4], p[5]), fmaxf(p[6], p[7]))); }
    __syncthreads();
    if (tid < 16) { float m = 0.f; for (int kb = 0; kb < 64; ++kb) { m = fmaxf(m, kn2[tid * 64 + kb]); kn2[tid * 64 + kb] = m; } }
    __syncthreads();
    for (int i = tid; i < 1024; i += 512) { const float* p = NBp + (size_t)i * 8;
        const float q2 = fmaxf(fmaxf(fmaxf(p[0], p[1]), fmaxf(p[2], p[3])), fmaxf(fmaxf(p[4], p[5]), fmaxf(p[6], p[7])));
        qk[i] = 1.02f * sqrtf(q2 * kn2[i]); }
    __syncthreads();
    const fox::Bases BS{WSP(fox::bf16, WS_Q), WSP(fox::bf16, WS_K), WSP(fox::bf16, WS_V), WSP(float, WS_KX), WSP(fox::bf16, WS_HN)};
    const int total = 1024;
    int id = blockIdx.x;
    if (id < total) {
        fox::BlockRef cur, nxt; cur.h = id & 15; cur.qb = 63 - (id >> 4);
        fox::Seam S;
        fox::fox_prime(BS, cur, (char*)lds + RING_OFF, lds32 + RING_OFF, S);
        for (;;) {
            if (tid == 0) *nxt_id = (int)F.G + (int)__hip_atomic_fetch_add(F.ctl + CW_ATT, 1u, RLX_AGENT);
            fox::fox_block(BS, cur, (char*)lds + RING_OFF, lds32 + RING_OFF, S, nxt);
            if (nxt.h < 0) break;
            cur = nxt;
        }
    }
}
#define IN(k) (lo <= (k) && (k) < hi)
#ifndef EN_MASK
#define EN_MASK 0xFFFF
#endif
#define EN(b) (((EN_MASK) >> (b)) & 1)
#ifndef DBL_MASK
#define DBL_MASK 0
#endif
#define REPS(b) ((((DBL_MASK) >> (b)) & 1) ? 2 : 1)
#define SEAM(k) do { if (MK_N_LAUNCHES == 1 && IN(k) && IN((k) + 1)) xcd_barrier(bar); } while (0)
template <int layer>
__device__ __forceinline__ void layer_phases(Frame& F, const XcdBarrier& bar, unsigned char* lds, const int lo, const int hi) {
    const unsigned lds32 = (unsigned)(size_t)F.lds;
        const int pb = 1 + 8 * layer;
        if (IN(pb + 0) && EN(1)) {
            if constexpr (layer == 0) {
                pg8::Gemm g{WSP(bf16, WS_HN), WSP(bf16, WS_WCIN), SEQ, 3 * DM, DM}; pg8::StaticOrder S; S.init(SEQ, 3 * DM, F.G, (int)blockIdx.x);
                pg8::EpiConvIn E{WSP(bf16, WS_Z), WSP(bf16, WS_GO)};
                for (int rep = 0; rep < REPS(1); ++rep) pg8::gemm_phase<pg8::EpiConvIn, pg8::StaticOrder, true, true>(F.lds + RING_OFF, g, S, E);
            } else {
                c_finalize(F);
                pg8::Gemm g{WSP(bf16, WS_HN), WSP(bf16, WS_WAIN), SEQ, 3 * DM, DM}; pg8::StaticOrder S; S.init(SEQ, 3 * DM, F.G, (int)blockIdx.x);
                pg8::EpiQKV E{WSP(bf16, WS_Q), (size_t)(WS_K - WS_Q) / 2, WSP(float, WS_NB), (LAS float*)(F.lds + NRM_OFF)};
                pg8::gemm_phase<pg8::EpiQKV, pg8::StaticOrder, true, true>(F.lds + RING_OFF, g, S, E);
            }
        }
        SEAM(pb + 0);
        if (IN(pb + 1)) {
            if constexpr (layer == 0) { if (EN(2)) for (int rep = 0; rep < REPS(2); ++rep) conv_phase(F); }
            else if (EN(3)) attn_phase(F, lds);
        }
        SEAM(pb + 1);
        if (IN(pb + 2) && EN(4)) {
            pg8::Gemm g{WSP(bf16, WS_HN), layer == 0 ? WSP(bf16, WS_WCOUT) : WSP(bf16, WS_WAOUT), SEQ, DM, DM}; pg8::StaticOrder S; S.init(SEQ, DM, F.G, (int)blockIdx.x);
            pg8::EpiDown E{WSP(bf16, WS_Y)};
            for (int rep = 0; rep < ((layer == 0) ? REPS(4) : 1); ++rep) pg8::gemm_phase<pg8::EpiDown, pg8::StaticOrder, true, true>(F.lds + RING_OFF, g, S, E);
        }
        SEAM(pb + 2);
        if (IN(pb + 3) && EN(5)) row_phase<1>(F, layer);
        SEAM(pb + 3);
        if (IN(pb + 5) && EN(7)) {
            const int ntile = build_tiles(F, layer);
            const LAS int* tile_e = (const LAS int*)(F.lds + TILE_OFF); const LAS int* tst = (const LAS int*)(F.lds + TST_OFF); LAS unsigned* rtok = (LAS unsigned*)(F.lds + RTOK_OFF);
            for (int idx = F.tid; idx < 4 * 256; idx += 512) { const int L = (idx >> 8) * F.G + F.vcu, r = idx & 255; unsigned off = 0u;
                if (L < ntile * 4) { const int t = L >> 2, e = tile_e[t], pos = (t - tst[e]) * 256 + r; if (pos < tst[32 + e]) off = (unsigned)WSP(int, WS_SLOT)[e * CAP + pos] * (unsigned)(DM * 2); }
                rtok[idx] = off; }
            __syncthreads();
            pg8::Gemm g{WSP(bf16, WS_HN), WSP(bf16, WS_WGU) + (size_t)layer * 32 * 1024 * 2048, MAXT * 256, 32 * 1024, DM};
            pg8::ExpertOrder S{tile_e, ntile * 4, 4, F.G, F.vcu};
            pg8::EpiGateUp E{WSP(bf16, WS_H)};
            for (int rep = 0; rep < REPS(7); ++rep) pg8::gemm_phase_gather<pg8::EpiGateUp, pg8::ExpertOrder>(F.lds + RING_OFF, g, S, E, rtok);
        }
        SEAM(pb + 5);
        if (IN(pb + 6) && EN(8)) {
            const int ntile = build_tiles(F, layer);
            pg8::Gemm g{WSP(bf16, WS_H), WSP(bf16, WS_WD) + (size_t)layer * 32 * 2048 * 512, MAXT * 256, 32 * 2048, DEXP};
            pg8::ExpertOrder S{(const LAS int*)(F.lds + TILE_OFF), ntile * 8, 8, F.G, F.vcu};
            pg8::EpiDown E{WSP(bf16, WS_XS)};
            for (int rep = 0; rep < REPS(8); ++rep) pg8::gemm_phase<pg8::EpiDown, pg8::ExpertOrder, true, true>(F.lds + RING_OFF, g, S, E);
        }
        SEAM(pb + 6);
        if (IN(pb + 7) && EN(9)) { if (layer == 0) row_phase<2>(F, 0); else row_phase<3>(F, 1); }
        if (layer == 0) SEAM(pb + 7);
}

struct Args { const float* in[17]; float* out; unsigned char* ws; int ph_lo, ph_hi; };
__global__ void __launch_bounds__(NWAVES * 64, 2) trunk_fwd(Args args) {
    extern __shared__ __attribute__((aligned(16))) unsigned char lds[];
    Frame F;
    F.lds = (LAS unsigned char*)lds;
    F.MISC = (volatile LAS unsigned*)(F.lds + MISC_OFF);
    F.tid = threadIdx.x; F.lane = F.tid & 63; F.wave = __builtin_amdgcn_readfirstlane(F.tid >> 6);
    F.G = gridDim.x; { const int bx = blockIdx.x; F.vcu = (F.G % 8 == 0) ? (bx % 8) * (F.G / 8) + bx / 8 : bx; }
    F.ws = args.ws; F.out = args.out; F.ctl = (gu32*)(args.ws + WS_CTL);
    F.x = args.in[0]; F.mix_norm = args.in[1]; F.ffn_norm = args.in[2]; F.final_norm = args.in[3]; F.conv_w_in = args.in[4]; F.conv_w = args.in[5]; F.conv_w_out = args.in[6];
    F.attn_w_in = args.in[7]; F.attn_b_f = args.in[8]; F.attn_w_out = args.in[9]; F.rg_w = args.in[10]; F.rg_b = args.in[11]; F.re_w = args.in[12]; F.re_b = args.in[13];
    F.w_gate = args.in[14]; F.w_up = args.in[15]; F.w_down = args.in[16];
    if (F.tid < 32) F.MISC[F.tid] = 0u;
    __syncthreads();
    XcdBarrier bar; bar.bar = (unsigned*)(F.ctl + CW_BAR); bar.x = 0; bar.st = nullptr;
    if (MK_N_LAUNCHES == 1) bar = xcd_barrier_post((unsigned*)(F.ctl + CW_BAR), F.MISC + 8);
    const int lo = args.ph_lo, hi = args.ph_hi;

    if (IN(0) && EN(0)) { for (int rep = 0; rep < REPS(0); ++rep) p0_prologue(F); for (int rep = 0; rep < REPS(9); ++rep) row_phase<0>(F, 0); }
    SEAM(0);
    layer_phases<0>(F, bar, lds, lo, hi);
    layer_phases<1>(F, bar, lds, lo, hi);
}
#undef IN
#undef SEAM

extern "C" void kernel_launch(void* const* d_in, const int* in_sizes, int n_in, void* d_out, int out_size, void* d_ws, size_t ws_size, hipStream_t stream) {
    static int grid = 0;
    if (grid == 0) {
        if (n_in != 17 || in_sizes[0] != SEQ * DM || out_size != SEQ * DM || ws_size < WS_END) { fprintf(stderr, "kernel_launch: unexpected shapes (n_in %d, in0 %d, out %d, ws %zu < %zu); nothing launched\n", n_in, n_in > 0 ? in_sizes[0] : -1, out_size, ws_size, (size_t)WS_END); grid = -1; return; }
        int dev = 0, cus = 0, per_cu = 0;
        if (hipGetDevice(&dev) != hipSuccess || hipDeviceGetAttribute(&cus, hipDeviceAttributeMultiprocessorCount, dev) != hipSuccess) { fprintf(stderr, "kernel_launch: device query failed\n"); grid = -1; return; }
        if (hipFuncSetAttribute((const void*)trunk_fwd, hipFuncAttributeMaxDynamicSharedMemorySize, LDS_BYTES) != hipSuccess) { fprintf(stderr, "kernel_launch: hipFuncSetAttribute failed\n"); grid = -1; return; }
        if (hipOccupancyMaxActiveBlocksPerMultiprocessor(&per_cu, (const void*)trunk_fwd, NWAVES * 64, LDS_BYTES) != hipSuccess || per_cu < 1) { fprintf(stderr, "kernel_launch: occupancy query reports %d workgroups per CU\n", per_cu); (void)hipGetLastError(); grid = -1; return; }
        grid = cus;
    }
    if (grid < 0) return;
    if (hipMemsetAsync((char*)d_ws + WS_CTL, 0, CTL_ZERO_BYTES, stream) != hipSuccess) { fprintf(stderr, "kernel_launch: hipMemsetAsync failed\n"); return; }
    Args a{};
    for (int i = 0; i < 17; ++i) a.in[i] = (const float*)d_in[i];
    a.out = (float*)d_out; a.ws = (unsigned char*)d_ws;
#if MK_N_LAUNCHES == 1
    a.ph_lo = 0; a.ph_hi = N_PHASES;
    hipLaunchKernelGGL(trunk_fwd, dim3(grid), dim3(NWAVES * 64), LDS_BYTES, stream, a);
#ifdef PROBE_PHASE
    (void)hipMemsetAsync((char*)d_ws + WS_CTL + CW_ATT * 4, 0, 4, stream);
    a.ph_lo = PROBE_PHASE; a.ph_hi = PROBE_PHASE + 1;
    hipLaunchKernelGGL(trunk_fwd, dim3(grid), dim3(NWAVES * 64), LDS_BYTES, stream, a);
#endif
#else
    for (int p = 0; p < N_PHASES; ++p) { a.ph_lo = p; a.ph_hi = p + 1; hipLaunchKernelGGL(trunk_fwd, dim3(grid), dim3(NWAVES * 64), LDS_BYTES, stream, a); }
#endif
    const hipError_t le = hipPeekAtLastError();
    if (le != hipSuccess) fprintf(stderr, "kernel_launch: launch failed: %s\n", hipGetErrorName(le));
}
```
